# Optimizing an MI355X kernel written in HIP

```python
import math
import jax
import jax.numpy as jnp
from jax import lax
import numpy as np

D_MODEL = 2048
BATCH = 4
SEQ = 2048
DEPTH = 1

ATTN_HEAD_DIM = 128
ATTN_WIDTH = D_MODEL // 2
N_ATTN_HEADS = ATTN_WIDTH // ATTN_HEAD_DIM
Q_BLOCK = 128
GMLP_GROUP_DIM = 128
GMLP_WIDTH = D_MODEL // 2
N_GMLP_GROUPS = GMLP_WIDTH // GMLP_GROUP_DIM
CHUNK = 128
PROJ_SIZES = (ATTN_WIDTH, ATTN_WIDTH, ATTN_WIDTH, N_ATTN_HEADS, 2 * GMLP_WIDTH, 2 * D_MODEL)
PROJ_WIDTH = sum(PROJ_SIZES)
N_EXPERTS = 32
TOP_K = 4
D_FF = D_MODEL
SWIGLU_ALPHA = 1.702
SWIGLU_LIMIT = 7.0
MOE_BLOCK = 128
NORM_EPS = 1e-5

kernel_name = "fox_gmlp_gated_hybrid_moe"


def rms_norm(x, g):
    xf = x.astype(jnp.float32)
    y = xf * lax.rsqrt(jnp.mean(xf * xf, axis=-1, keepdims=True) + NORM_EPS)
    return (y * g.astype(jnp.float32)).astype(x.dtype)


def layer_norm(x, g, b):
    xf = x.astype(jnp.float32)
    mu = jnp.mean(xf, axis=-1, keepdims=True)
    var = jnp.mean(jnp.square(xf - mu), axis=-1, keepdims=True)
    y = (xf - mu) * lax.rsqrt(var + NORM_EPS)
    return (y * g.astype(jnp.float32) + b.astype(jnp.float32)).astype(x.dtype)


def forgetting_attention(q, k, v, f_logit):
    B, S, H, Dh = q.shape
    scale = 1.0 / math.sqrt(Dh)
    c = jnp.cumsum(jax.nn.log_sigmoid(f_logit.astype(jnp.float32)), axis=1)
    c = c.transpose(0, 2, 1)
    qh = q.transpose(0, 2, 1, 3)
    kh = k.transpose(0, 2, 1, 3)
    vh = v.transpose(0, 2, 1, 3)
    nq = S // Q_BLOCK
    qb = qh.reshape(B, H, nq, Q_BLOCK, Dh).transpose(2, 0, 1, 3, 4)
    cb = c.reshape(B, H, nq, Q_BLOCK).transpose(2, 0, 1, 3)
    kpos = jnp.arange(S)

    def one_block(args):
        qi, ci, i = args
        qpos = i * Q_BLOCK + jnp.arange(Q_BLOCK)
        s = jnp.einsum('bhqd,bhkd->bhqk', qi, kh).astype(jnp.float32) * scale
        s = s + (ci[..., :, None] - c[:, :, None, :])
        s = jnp.where(kpos[None, :] <= qpos[:, None], s, -jnp.inf)
        p = jax.nn.softmax(s, axis=-1)
        return jnp.einsum('bhqk,bhkd->bhqd', p.astype(vh.dtype), vh)

    o = lax.map(one_block, (qb, cb, jnp.arange(nq)))
    return o.transpose(1, 0, 3, 2, 4).reshape(B, S, H * Dh)


def chunked_spatial_gating(z, ln_g, ln_b, w_s, b_s):
    u, v = jnp.split(z, 2, axis=-1)
    v = layer_norm(v, ln_g, ln_b)
    B, S, _ = v.shape
    nc = S // CHUNK
    vg = v.reshape(B, nc, CHUNK, N_GMLP_GROUPS, GMLP_GROUP_DIM)
    causal = jnp.tril(jnp.ones((CHUNK, CHUNK), dtype=bool))
    w = jnp.where(causal[None], w_s, jnp.zeros_like(w_s))
    mixed = jnp.einsum('gts,bcsgd->bctgd', w, vg) + b_s.T[None, None, :, :, None]
    return u * mixed.reshape(B, S, GMLP_WIDTH)


def clamped_swiglu(gu):
    x_glu = jnp.minimum(gu[..., ::2], SWIGLU_LIMIT)
    x_lin = jnp.clip(gu[..., 1::2], -SWIGLU_LIMIT, SWIGLU_LIMIT)
    return x_glu * jax.nn.sigmoid(SWIGLU_ALPHA * x_glu) * (x_lin + 1.0)


def moe_ffn(h, w_router, b_router, w_up, b_up, w_down, b_down):
    B, S, D = h.shape
    T = B * S
    hf = h.reshape(T, D)
    logits = (hf @ w_router + b_router).astype(jnp.float32)
    top_vals, top_idx = lax.top_k(logits, TOP_K)
    gates = jax.nn.softmax(top_vals, axis=-1).astype(h.dtype)

    n_assign = T * TOP_K
    e_flat = top_idx.reshape(-1).astype(jnp.int32)
    tok_flat = jnp.arange(n_assign, dtype=jnp.int32) // TOP_K
    g_flat = gates.reshape(-1)
    order = jnp.argsort(e_flat)
    e_sorted = e_flat[order]
    counts = jnp.bincount(e_flat, length=N_EXPERTS).astype(jnp.int32)
    padded = (counts + MOE_BLOCK - 1) // MOE_BLOCK * MOE_BLOCK
    pad_end = jnp.cumsum(padded)
    pad_start = pad_end - padded
    start = jnp.cumsum(counts) - counts
    rank = jnp.arange(n_assign, dtype=jnp.int32) - start[e_sorted]
    dest = pad_start[e_sorted] + rank
    n_rows = n_assign + N_EXPERTS * MOE_BLOCK
    n_blocks = n_rows // MOE_BLOCK
    row_tok = jnp.full((n_rows,), T, dtype=jnp.int32).at[dest].set(tok_flat[order])
    row_gate = jnp.zeros((n_rows,), dtype=h.dtype).at[dest].set(g_flat[order])
    blk_start = jnp.arange(n_blocks, dtype=jnp.int32) * MOE_BLOCK
    blk_exp = jnp.minimum(jnp.searchsorted(pad_end, blk_start, side='right'), N_EXPERTS - 1)
    h_pad = jnp.concatenate([hf, jnp.zeros((1, D), dtype=hf.dtype)], axis=0)

    def expert_block(args):
        toks, e = args
        xb = h_pad[toks]
        gu = xb @ w_up[e] + b_up[e]
        return clamped_swiglu(gu) @ w_down[e] + b_down[e]

    y = lax.map(expert_block, (row_tok.reshape(n_blocks, MOE_BLOCK), blk_exp))
    y = y.reshape(n_rows, D) * row_gate[:, None]
    out = jnp.zeros((T + 1, D), dtype=y.dtype).at[row_tok].add(y)[:T]
    return out.reshape(B, S, D)


def setup_inputs(seed: int = 0) -> dict:
    key = jax.random.key(seed)
    ks = jax.random.split(key, 24)
    n = lambda k, shape, s: jax.random.normal(k, shape, jnp.float32) * s
    D = D_MODEL
    return {
        "x": n(ks[0], (BATCH, SEQ, D), 1.0),
        "g_mix": 1.0 + n(ks[1], (D,), 0.02),
        "w_in": n(ks[2], (D, PROJ_WIDTH), D ** -0.5),
        "b_forget": 2.0 + n(ks[3], (N_ATTN_HEADS,), 0.5),
        "g_v_ln": 1.0 + n(ks[4], (GMLP_WIDTH,), 0.02),
        "b_v_ln": n(ks[5], (GMLP_WIDTH,), 0.02),
        "w_spatial": n(ks[6], (N_GMLP_GROUPS, CHUNK, CHUNK), CHUNK ** -0.5),
        "b_spatial": 1.0 + n(ks[7], (N_GMLP_GROUPS, CHUNK), 0.02),
        "w_branch_attn": n(ks[8], (ATTN_WIDTH, D), ATTN_WIDTH ** -0.5),
        "w_branch_gmlp": n(ks[9], (GMLP_WIDTH, D), GMLP_WIDTH ** -0.5),
        "w_out": n(ks[10], (D, D), D ** -0.5),
        "g_ffn": 1.0 + n(ks[11], (D,), 0.02),
        "w_router": n(ks[12], (D, N_EXPERTS), D ** -0.5),
        "b_router": n(ks[13], (N_EXPERTS,), 0.01),
        "w_expert_up": n(ks[14], (N_EXPERTS, D, 2 * D_FF), D ** -0.5),
        "b_expert_up": n(ks[15], (N_EXPERTS, 2 * D_FF), 0.01),
        "w_expert_down": n(ks[16], (N_EXPERTS, D_FF, D), D_FF ** -0.5),
        "b_expert_down": n(ks[17], (N_EXPERTS, D), 0.01),
        "g_final": 1.0 + n(ks[18], (D,), 0.02),
    }


def reference(x, g_mix, w_in, b_forget, g_v_ln, b_v_ln, w_spatial, b_spatial,
              w_branch_attn, w_branch_gmlp, w_out, g_ffn, w_router, b_router,
              w_expert_up, b_expert_up, w_expert_down, b_expert_down, g_final):
    B, S, D = x.shape
    split_at = list(np.cumsum(PROJ_SIZES)[:-1])
    for _ in range(DEPTH):
        h = rms_norm(x, g_mix)
        proj = h @ w_in
        q, k, v, f_logit, z, gate_logits = jnp.split(proj, split_at, axis=-1)
        q = q.reshape(B, S, N_ATTN_HEADS, ATTN_HEAD_DIM)
        k = k.reshape(B, S, N_ATTN_HEADS, ATTN_HEAD_DIM)
        v = v.reshape(B, S, N_ATTN_HEADS, ATTN_HEAD_DIM)
        attn = forgetting_attention(q, k, v, f_logit + b_forget)
        sg = chunked_spatial_gating(jax.nn.gelu(z, approximate=False),
                                    g_v_ln, b_v_ln, w_spatial, b_spatial)
        gate_a, gate_b = jnp.split(gate_logits, 2, axis=-1)
        merged = (jax.nn.sigmoid(gate_a) * (attn @ w_branch_attn)
                  + jax.nn.sigmoid(gate_b) * (sg @ w_branch_gmlp))
        x = x + merged @ w_out
        h2 = rms_norm(x, g_ffn)
        x = x + moe_ffn(h2, w_router, b_router, w_expert_up, b_expert_up,
                        w_expert_down, b_expert_down)
    return rms_norm(x, g_final)
```

```cpp
#include <hip/hip_runtime.h>
#include <stdint.h>
#include <string.h>
#include <stdio.h>

#ifndef MK_SINGLE
#define MK_SINGLE 0
#endif

typedef unsigned short bf16_t;
typedef short bf16x8 __attribute__((ext_vector_type(8)));
typedef float f32x4 __attribute__((ext_vector_type(4)));
typedef float f32x2 __attribute__((ext_vector_type(2)));
typedef unsigned u32x4 __attribute__((ext_vector_type(4)));
typedef unsigned u32x2 __attribute__((ext_vector_type(2)));

constexpr int D = 2048, NB = 4, S = 2048, T = NB * S, H = 8, DH = 128, AW = 1024, GW = 1024, PW = 9224, NE = 32, DFF = 2048;
constexpr int NCHUNK = 256;
constexpr int MAXTILES = 192;
constexpr int NTHREADS = 512;
constexpr int LDS_BYTES = 132 * 1024;

#define XB_TMO      128
#define XB_XCNT(j)  (256  + 64 * (j))
#define XB_XSUB(j)  (1280 + 64 * (j))
#define XB_XGEN(j)  (2304 + 64 * (j))
#define XB_TOP      3328
#define XB_TOPGEN   3392
#define XCD_BAR_WORDS 3456
#define XB_SPIN_CAP (1u << 22)
#define LAS __attribute__((address_space(3)))

__device__ __forceinline__ unsigned xb_ld(unsigned* p)              { return __hip_atomic_load(p, __ATOMIC_RELAXED, __HIP_MEMORY_SCOPE_AGENT); }
__device__ __forceinline__ unsigned xb_add(unsigned* p, unsigned v) { return __hip_atomic_fetch_add(p, v, __ATOMIC_RELAXED, __HIP_MEMORY_SCOPE_AGENT); }
__device__ __forceinline__ unsigned xb_xcc_id() { return (unsigned)__builtin_amdgcn_s_getreg((3 << 11) | 20) & 0xFu; }
#define XB_SPIN(cond, bar) do { unsigned _sp = 0; while (cond) { __builtin_amdgcn_s_sleep(1); \
    if ((++_sp & 255u) == 0u) { if (xb_ld(&(bar)[XB_TMO])) break; if (_sp > XB_SPIN_CAP) { atomicAdd(&(bar)[XB_TMO], 1u); break; } } } } while (0)

struct XcdBarrier { unsigned* bar; unsigned x; volatile LAS unsigned* st; };

__device__ __forceinline__ XcdBarrier xcd_barrier_post(unsigned* bar, volatile LAS unsigned* st) {
    XcdBarrier b; b.bar = bar; b.x = xb_xcc_id(); b.st = st;
    if (threadIdx.x == 0) (void)xb_add(&bar[XB_XCNT(b.x)], 1u);
    return b;
}
__device__ __forceinline__ void xcd_barrier_complete(unsigned* bar, unsigned x, unsigned& nloc, unsigned& nx) {
    const unsigned G = gridDim.x * gridDim.y * gridDim.z;
    unsigned sum, cnt, mine, sp = 0u;
    for (;;) {
        sum = 0u; cnt = 0u; mine = 0u;
#pragma unroll
        for (unsigned j = 0; j < 16; ++j) { const unsigned c = xb_ld(&bar[XB_XCNT(j)]); sum += c; cnt += (c > 0u) ? 1u : 0u; mine = (j == x) ? c : mine; }
        if (sum == G) break;
        __builtin_amdgcn_s_sleep(1);
        if ((++sp & 255u) == 0u) { if (xb_ld(&bar[XB_TMO])) break; if (sp > XB_SPIN_CAP) { atomicAdd(&bar[XB_TMO], 1u); break; } }
    }
    nloc = mine > 0u ? mine : 1u; nx = cnt > 0u ? cnt : 1u;
}
__device__ __forceinline__ void xcd_barrier(const XcdBarrier& b) {
    asm volatile("s_waitcnt vmcnt(0)" ::: "memory");
    __syncthreads();
    if (threadIdx.x == 0) {
        unsigned* bar = b.bar;
        __builtin_amdgcn_s_waitcnt(0);
        unsigned nloc = b.st[0], nx = b.st[1];
        if (nloc == 0u) { xcd_barrier_complete(bar, b.x, nloc, nx); b.st[0] = nloc; b.st[1] = nx; }
        const unsigned old = xb_add(&bar[XB_XSUB(b.x)], 1u);
        const unsigned gen = old / nloc;
        if (old + 1u == (gen + 1u) * nloc) {
            __builtin_amdgcn_fence(__ATOMIC_RELEASE, "agent");
            asm volatile("s_waitcnt vmcnt(0)" ::: "memory");
            const unsigned og = xb_add(&bar[XB_TOP], 1u);
            const unsigned tg = og / nx;
            if (og + 1u == (tg + 1u) * nx) xb_add(&bar[XB_TOPGEN], 1u);
            else XB_SPIN(xb_ld(&bar[XB_TOPGEN]) == tg, bar);
            __builtin_amdgcn_fence(__ATOMIC_ACQUIRE, "agent");
            xb_add(&bar[XB_XGEN(b.x)], 1u);
            asm volatile("s_waitcnt vmcnt(0)" ::: "memory");
        } else {
            XB_SPIN(xb_ld(&bar[XB_XGEN(b.x)]) == gen, bar);
            __builtin_amdgcn_fence(__ATOMIC_ACQUIRE, "agent");
            asm volatile("s_waitcnt vmcnt(0)" ::: "memory");
        }
    }
    __syncthreads();
}

struct Params {
    const float *x, *g_mix, *w_in, *b_forget, *g_v_ln, *b_v_ln, *w_spatial, *b_spatial, *w_ba, *w_bg, *w_out, *g_ffn, *w_router, *b_router,
                *w_up, *b_up, *w_down, *b_down, *g_final;
    float* out;
    bf16_t *h, *q, *k, *v, *zg, *gates, *attn, *sg, *merged, *h2, *act, *y;
    float *ls, *x1, *top_gate, *row_gate;
    int *top_idx, *blk_cnt, *row_tok, *row_dst, *tile_e, *tile_row0, *tile_nrows, *ntiles;
    unsigned* bar;
};

__device__ __forceinline__ unsigned cvt_pk_bf16(float lo, float hi) { unsigned r; asm("v_cvt_pk_bf16_f32 %0, %1, %2" : "=v"(r) : "v"(lo), "v"(hi)); return r; }
__device__ __forceinline__ float bf_lo(unsigned u) { return __uint_as_float(u << 16); }
__device__ __forceinline__ float bf_hi(unsigned u) { return __uint_as_float(u & 0xffff0000u); }
__device__ __forceinline__ float wave_sum(float v) {
#pragma unroll
    for (int o = 32; o; o >>= 1) v += __shfl_xor(v, o);
    return v; }
__device__ __forceinline__ float wave_max(float v) {
#pragma unroll
    for (int o = 32; o; o >>= 1) v = fmaxf(v, __shfl_xor(v, o));
    return v; }
__device__ __forceinline__ float sigmoidf_(float x) { return 1.0f / (1.0f + __expf(-x)); }
__device__ __forceinline__ float log_sigmoid(float x) { return fminf(x, 0.f) - log1pf(__expf(-fabsf(x))); }
__device__ __forceinline__ float gelu_erf(float v) { return 0.5f * v * (1.0f + erff(v * 0.70710678118654752f)); }

template <class Epi>
__device__ __forceinline__ void gemm_tile_naive(const bf16_t* __restrict__ A, int lda, const int* __restrict__ rowmap, int row0, int nvalid,
                                                const float* __restrict__ Bm, int ldb, int K, Epi&& epi) {
    const int tid = threadIdx.x, wid = tid >> 6, lane = tid & 63, wr = wid >> 2, wc = wid & 3, fr = lane & 15, fq = lane >> 4;
    const bf16_t* arow[8];
#pragma unroll
    for (int m = 0; m < 8; ++m) {
        int r = wr * 128 + m * 16 + fr; if (r >= nvalid) r = 0;
        const int gr = rowmap ? rowmap[row0 + r] : row0 + r;
        arow[m] = A + (size_t)gr * lda + fq * 8;
    }
    f32x4 acc[8][4];
#pragma unroll
    for (int m = 0; m < 8; ++m)
#pragma unroll
        for (int n = 0; n < 4; ++n) acc[m][n] = (f32x4){0.f, 0.f, 0.f, 0.f};
    for (int k0 = 0; k0 < K; k0 += 32) {
        bf16x8 At[8], Bf[4];
#pragma unroll
        for (int m = 0; m < 8; ++m) At[m] = *(const bf16x8*)(arow[m] + k0);
#pragma unroll
        for (int n = 0; n < 4; ++n) {
            const float* bp = Bm + (size_t)(k0 + fq * 8) * ldb + wc * 64 + n * 16 + fr;
            float v[8];
#pragma unroll
            for (int i = 0; i < 8; ++i) v[i] = bp[(size_t)i * ldb];
            u32x4 w; w.x = cvt_pk_bf16(v[0], v[1]); w.y = cvt_pk_bf16(v[2], v[3]); w.z = cvt_pk_bf16(v[4], v[5]); w.w = cvt_pk_bf16(v[6], v[7]);
            Bf[n] = __builtin_bit_cast(bf16x8, w);
        }
#pragma unroll
        for (int m = 0; m < 8; ++m)
#pragma unroll
            for (int n = 0; n < 4; ++n) acc[m][n] = __builtin_amdgcn_mfma_f32_16x16x32_bf16(Bf[n], At[m], acc[m][n], 0, 0, 0);
    }
    epi(acc, wr, wc, fr, fq);
}

__device__ __forceinline__ void phase_prologue(const Params& p, char* lds, int vb, int nvb) {
    float* wf = (float*)lds;
    for (int i = threadIdx.x; i < D * 2; i += NTHREADS) { const int d = i >> 1, hf = i & 1; *(f32x4*)(wf + d * 8 + hf * 4) = *(const f32x4*)(p.w_in + (size_t)d * PW + 3072 + hf * 4); }
    __syncthreads();
    const int wid = threadIdx.x >> 6, lane = threadIdx.x & 63;
    for (int tok = vb * 8 + wid; tok < T; tok += nvb * 8) {
        const float* xr = p.x + (size_t)tok * D;
        f32x4 xv[8]; float ss = 0.f;
#pragma unroll
        for (int i = 0; i < 8; ++i) { xv[i] = *(const f32x4*)(xr + i * 256 + lane * 4); ss += xv[i][0] * xv[i][0] + xv[i][1] * xv[i][1] + xv[i][2] * xv[i][2] + xv[i][3] * xv[i][3]; }
        ss = wave_sum(ss);
        const float rstd = rsqrtf(ss * (1.0f / D) + 1e-5f);
        float fa[8];
#pragma unroll
        for (int j = 0; j < 8; ++j) fa[j] = 0.f;
#pragma unroll
        for (int i = 0; i < 8; ++i) {
            const f32x4 g = *(const f32x4*)(p.g_mix + i * 256 + lane * 4);
            const f32x4 hv = xv[i] * rstd * g;
            u32x2 w; w.x = cvt_pk_bf16(hv[0], hv[1]); w.y = cvt_pk_bf16(hv[2], hv[3]);
            *(u32x2*)(p.h + (size_t)tok * D + i * 256 + lane * 4) = w;
#pragma unroll
            for (int j = 0; j < 4; ++j) {
                const int d = i * 256 + lane * 4 + j;
                const f32x4 w0 = *(const f32x4*)(wf + d * 8), w1 = *(const f32x4*)(wf + d * 8 + 4);
                fa[0] += hv[j] * w0[0]; fa[1] += hv[j] * w0[1]; fa[2] += hv[j] * w0[2]; fa[3] += hv[j] * w0[3];
                fa[4] += hv[j] * w1[0]; fa[5] += hv[j] * w1[1]; fa[6] += hv[j] * w1[2]; fa[7] += hv[j] * w1[3];
            }
        }
        float mine = 0.f;
#pragma unroll
        for (int j = 0; j < 8; ++j) { const float s = wave_sum(fa[j]); if (lane == j) mine = s; }
        if (lane < 8) p.ls[(size_t)tok * 8 + lane] = log_sigmoid(mine + p.b_forget[lane]);
    }
    __syncthreads();
}

__device__ __forceinline__ void phase_inproj(const Params& p, char* lds, int vb, int nvb) {
    for (int u = vb; u < 32 * 36; u += nvb) {
        const int pm = u / 36, pn = u % 36;
        const int bcol = pn < 12 ? pn * 256 : pn * 256 + 8;
        gemm_tile_naive(p.h, D, nullptr, pm * 256, 256, p.w_in + bcol, PW, D,
            [&](const f32x4 (&acc)[8][4], int wr, int wc, int fr, int fq) {
#pragma unroll
                for (int m = 0; m < 8; ++m) {
                    const size_t row = (size_t)pm * 256 + wr * 128 + m * 16 + fr;
#pragma unroll
                    for (int n = 0; n < 4; ++n) {
                        const int c = wc * 64 + n * 16 + fq * 4;
                        f32x4 v = acc[m][n];
                        bf16_t* dst;
                        if (pn < 4) dst = p.q + row * AW + pn * 256 + c;
                        else if (pn < 8) dst = p.k + row * AW + (pn - 4) * 256 + c;
                        else if (pn < 12) dst = p.v + row * AW + (pn - 8) * 256 + c;
                        else if (pn < 20) { dst = p.zg + row * 2048 + (pn - 12) * 256 + c;
#pragma unroll
                            for (int j = 0; j < 4; ++j) v[j] = gelu_erf(v[j]); }
                        else { dst = p.gates + row * 4096 + (pn - 20) * 256 + c;
#pragma unroll
                            for (int j = 0; j < 4; ++j) v[j] = sigmoidf_(v[j]); }
                        u32x2 w; w.x = cvt_pk_bf16(v[0], v[1]); w.y = cvt_pk_bf16(v[2], v[3]);
                        *(u32x2*)dst = w;
                    }
                }
            });
    }
}

__device__ __forceinline__ void phase_attn_naive(const Params& p, char* lds, int vb, int nvb) {
    float* cs = (float*)lds;
    float* wtot = cs + 2048;
    float* qs = wtot + 64;
    const int tid = threadIdx.x, wid = tid >> 6, lane = tid & 63;
    for (int u = vb; u < 512; u += nvb) {
        const int qb = 15 - (u >> 5), bh = u & 31, b = bh >> 3, hh = bh & 7;
        const int nkeys = (qb + 1) * 128;
        __syncthreads();
        {
            float v[4];
#pragma unroll
            for (int j = 0; j < 4; ++j) { const int s = tid * 4 + j; v[j] = s < nkeys ? p.ls[((size_t)b * S + s) * 8 + hh] : 0.f; }
            v[1] += v[0]; v[2] += v[1]; v[3] += v[2];
            float incl = v[3];
#pragma unroll
            for (int o = 1; o < 64; o <<= 1) { const float t = __shfl_up(incl, o); if (lane >= o) incl += t; }
            if (lane == 63) wtot[wid] = incl;
            __syncthreads();
            float base = incl - v[3];
            for (int w = 0; w < wid; ++w) base += wtot[w];
#pragma unroll
            for (int j = 0; j < 4; ++j) cs[tid * 4 + j] = base + v[j];
            __syncthreads();
        }
        float* myq = qs + wid * 128;
        for (int rr = 0; rr < 16; ++rr) {
            const int t = qb * 128 + wid * 16 + rr;
            const size_t qoff = ((size_t)b * S + t) * AW + hh * 128;
            { const unsigned qq = *(const unsigned*)(p.q + qoff + lane * 2); myq[lane * 2] = bf_lo(qq) * 0.08838834764831845f; myq[lane * 2 + 1] = bf_hi(qq) * 0.08838834764831845f; }
            __builtin_amdgcn_wave_barrier();
            const float ct = cs[t];
            float mrun = -INFINITY, lrun = 0.f, o0 = 0.f, o1 = 0.f;
            for (int s0 = 0; s0 <= t; s0 += 64) {
                const int s = s0 + lane; const bool valid = s <= t; const int sl = valid ? s : t;
                const bf16_t* kp = p.k + ((size_t)b * S + sl) * AW + hh * 128;
                float acc = 0.f;
#pragma unroll
                for (int c = 0; c < 16; ++c) {
                    const u32x4 kk = *(const u32x4*)(kp + c * 8);
                    const f32x4 qa = *(const f32x4*)(myq + c * 8), qb4 = *(const f32x4*)(myq + c * 8 + 4);
                    acc += bf_lo(kk.x) * qa[0] + bf_hi(kk.x) * qa[1] + bf_lo(kk.y) * qa[2] + bf_hi(kk.y) * qa[3]
                         + bf_lo(kk.z) * qb4[0] + bf_hi(kk.z) * qb4[1] + bf_lo(kk.w) * qb4[2] + bf_hi(kk.w) * qb4[3];
                }
                const float sc = valid ? acc + (ct - cs[sl]) : -INFINITY;
                const float mnew = fmaxf(mrun, wave_max(sc));
                const float alpha = __expf(mrun - mnew);
                const float pj = valid ? __expf(sc - mnew) : 0.f;
                lrun = lrun * alpha + wave_sum(pj);
                o0 *= alpha; o1 *= alpha;
                const int nj = min(64, t - s0 + 1);
                const bf16_t* vp = p.v + ((size_t)b * S + s0) * AW + hh * 128 + lane * 2;
                for (int j = 0; j < nj; ++j) {
                    const float pjj = __shfl(pj, j);
                    const unsigned vv = *(const unsigned*)(vp + (size_t)j * AW);
                    o0 += pjj * bf_lo(vv); o1 += pjj * bf_hi(vv);
                }
                mrun = mnew;
            }
            const float inv = 1.0f / lrun;
            *(unsigned*)(p.attn + qoff + lane * 2) = cvt_pk_bf16(o0 * inv, o1 * inv);
            __builtin_amdgcn_wave_barrier();
        }
    }
    __syncthreads();
}

__device__ __forceinline__ void phase_gmlp_naive(const Params& p, char* lds, int vb, int nvb) {
    float* vn = (float*)lds;
    float* st = vn + 128 * 128;
    const int tid = threadIdx.x, wid = tid >> 6, lane = tid & 63;
    for (int u = vb; u < 512; u += nvb) {
        const int g = u & 7, bc = u >> 3;
        const size_t tok0 = (size_t)bc * 128;
        __syncthreads();
        for (int rr = 0; rr < 16; ++rr) {
            const int s = wid * 16 + rr;
            const bf16_t* vp = p.zg + (tok0 + s) * 2048 + 1024 + lane * 16;
            const u32x4 a = *(const u32x4*)vp, b = *(const u32x4*)(vp + 8);
            float sum = 0.f, sq = 0.f;
            const unsigned ww[8] = {a.x, a.y, a.z, a.w, b.x, b.y, b.z, b.w};
#pragma unroll
            for (int j = 0; j < 8; ++j) { const float lo = bf_lo(ww[j]), hi = bf_hi(ww[j]); sum += lo + hi; sq += lo * lo + hi * hi; }
            sum = wave_sum(sum); sq = wave_sum(sq);
            const float mean = sum * (1.0f / 1024.f); const float var = fmaxf(sq * (1.0f / 1024.f) - mean * mean, 0.f);
            if (lane == 0) { st[s * 2] = mean; st[s * 2 + 1] = rsqrtf(var + 1e-5f); }
        }
        __syncthreads();
        for (int idx = tid; idx < 128 * 16; idx += NTHREADS) {
            const int s = idx >> 4, dc = idx & 15;
            const u32x4 a = *(const u32x4*)(p.zg + (tok0 + s) * 2048 + 1024 + g * 128 + dc * 8);
            const float mean = st[s * 2], rstd = st[s * 2 + 1];
            const unsigned ww[4] = {a.x, a.y, a.z, a.w};
#pragma unroll
            for (int j = 0; j < 4; ++j) {
                const int c = g * 128 + dc * 8 + j * 2;
                vn[s * 128 + dc * 8 + j * 2]     = (bf_lo(ww[j]) - mean) * rstd * p.g_v_ln[c]     + p.b_v_ln[c];
                vn[s * 128 + dc * 8 + j * 2 + 1] = (bf_hi(ww[j]) - mean) * rstd * p.g_v_ln[c + 1] + p.b_v_ln[c + 1];
            }
        }
        __syncthreads();
        for (int rr = 0; rr < 16; ++rr) {
            const int t = wid * 16 + rr;
            const float* wrow = p.w_spatial + ((size_t)g * 128 + t) * 128;
            float a0 = 0.f, a1 = 0.f;
            for (int s = 0; s <= t; ++s) { const float w = wrow[s]; a0 += w * vn[s * 128 + lane]; a1 += w * vn[s * 128 + lane + 64]; }
            const float bs = p.b_spatial[g * 128 + t];
            const bf16_t* up = p.zg + (tok0 + t) * 2048 + g * 128;
            const float u0 = __uint_as_float((unsigned)up[lane] << 16), u1 = __uint_as_float((unsigned)up[lane + 64] << 16);
            bf16_t* op = p.sg + (tok0 + t) * GW + g * 128;
            op[lane] = (bf16_t)(cvt_pk_bf16(u0 * (a0 + bs), 0.f) & 0xffffu);
            op[lane + 64] = (bf16_t)(cvt_pk_bf16(u1 * (a1 + bs), 0.f) & 0xffffu);
        }
    }
    __syncthreads();
}

__device__ __forceinline__ void phase_branch(const Params& p, char* lds, int vb, int nvb) {
    for (int u = vb; u < 32 * 8; u += nvb) {
        const int pm = u >> 3, pn = u & 7;
        gemm_tile_naive(p.attn, AW, nullptr, pm * 256, 256, p.w_ba + pn * 256, D, AW,
            [&](const f32x4 (&acc)[8][4], int wr, int wc, int fr, int fq) {
#pragma unroll
                for (int m = 0; m < 8; ++m) {
                    const size_t row = (size_t)pm * 256 + wr * 128 + m * 16 + fr;
#pragma unroll
                    for (int n = 0; n < 4; ++n) {
                        const int c = pn * 256 + wc * 64 + n * 16 + fq * 4;
                        const u32x2 gg = *(const u32x2*)(p.gates + row * 4096 + c);
                        f32x4 v = acc[m][n];
                        v[0] *= bf_lo(gg.x); v[1] *= bf_hi(gg.x); v[2] *= bf_lo(gg.y); v[3] *= bf_hi(gg.y);
                        *(f32x4*)(p.x1 + row * D + c) = v;
                    }
                }
            });
        gemm_tile_naive(p.sg, GW, nullptr, pm * 256, 256, p.w_bg + pn * 256, D, GW,
            [&](const f32x4 (&acc)[8][4], int wr, int wc, int fr, int fq) {
#pragma unroll
                for (int m = 0; m < 8; ++m) {
                    const size_t row = (size_t)pm * 256 + wr * 128 + m * 16 + fr;
#pragma unroll
                    for (int n = 0; n < 4; ++n) {
                        const int c = pn * 256 + wc * 64 + n * 16 + fq * 4;
                        const u32x2 gg = *(const u32x2*)(p.gates + row * 4096 + 2048 + c);
                        const f32x4 prev = *(const f32x4*)(p.x1 + row * D + c);
                        f32x4 v = acc[m][n];
                        v[0] = prev[0] + v[0] * bf_lo(gg.x); v[1] = prev[1] + v[1] * bf_hi(gg.x); v[2] = prev[2] + v[2] * bf_lo(gg.y); v[3] = prev[3] + v[3] * bf_hi(gg.y);
                        u32x2 w; w.x = cvt_pk_bf16(v[0], v[1]); w.y = cvt_pk_bf16(v[2], v[3]);
                        *(u32x2*)(p.merged + row * D + c) = w;
                    }
                }
            });
    }
}

__device__ __forceinline__ void phase_outproj(const Params& p, char* lds, int vb, int nvb) {
    for (int u = vb; u < 32 * 8; u += nvb) {
        const int pm = u >> 3, pn = u & 7;
        gemm_tile_naive(p.merged, D, nullptr, pm * 256, 256, p.w_out + pn * 256, D, D,
            [&](const f32x4 (&acc)[8][4], int wr, int wc, int fr, int fq) {
#pragma unroll
                for (int m = 0; m < 8; ++m) {
                    const size_t row = (size_t)pm * 256 + wr * 128 + m * 16 + fr;
#pragma unroll
                    for (int n = 0; n < 4; ++n) {
                        const int c = pn * 256 + wc * 64 + n * 16 + fq * 4;
                        const f32x4 xr = *(const f32x4*)(p.x + row * D + c);
                        *(f32x4*)(p.x1 + row * D + c) = xr + acc[m][n];
                    }
                }
            });
    }
}

__device__ __forceinline__ void phase_router(const Params& p, char* lds, int vb, int nvb) {
    float* hrow = (float*)lds;
    int* cnt = (int*)(lds + 8 * 2048 * 4);
    const int tid = threadIdx.x, wid = tid >> 6, lane = tid & 63;
    for (int c = vb; c < NCHUNK; c += nvb) {
        __syncthreads();
        if (tid < 32) cnt[tid] = 0;
        __syncthreads();
        float* hr = hrow + wid * 2048;
        for (int i4 = 0; i4 < 4; ++i4) {
            const int tok = c * 32 + wid * 4 + i4;
            const float* xr = p.x1 + (size_t)tok * D;
            f32x4 xv[8]; float ss = 0.f;
#pragma unroll
            for (int i = 0; i < 8; ++i) { xv[i] = *(const f32x4*)(xr + i * 256 + lane * 4); ss += xv[i][0] * xv[i][0] + xv[i][1] * xv[i][1] + xv[i][2] * xv[i][2] + xv[i][3] * xv[i][3]; }
            ss = wave_sum(ss);
            const float rstd = rsqrtf(ss * (1.0f / D) + 1e-5f);
#pragma unroll
            for (int i = 0; i < 8; ++i) {
                const f32x4 g = *(const f32x4*)(p.g_ffn + i * 256 + lane * 4);
                const f32x4 hv = xv[i] * rstd * g;
                u32x2 w; w.x = cvt_pk_bf16(hv[0], hv[1]); w.y = cvt_pk_bf16(hv[2], hv[3]);
                *(u32x2*)(p.h2 + (size_t)tok * D + i * 256 + lane * 4) = w;
                *(f32x4*)(hr + i * 256 + lane * 4) = hv;
            }
            __builtin_amdgcn_wave_barrier();
            const int e = lane & 31, half = lane >> 5;
            float acc = 0.f;
            const float* wp = p.w_router + (size_t)half * 1024 * NE + e;
            const float* hp = hr + half * 1024;
#pragma unroll 8
            for (int d = 0; d < 1024; ++d) acc += hp[d] * wp[(size_t)d * NE];
            acc += __shfl_xor(acc, 32);
            acc += p.b_router[e];
            float val = lane < 32 ? acc : -INFINITY;
            float sv[4]; int si[4];
#pragma unroll
            for (int r = 0; r < 4; ++r) {
                const float mx = wave_max(val);
                const unsigned long long bal = __ballot(val == mx);
                const int idx = __ffsll((long long)bal) - 1;
                sv[r] = mx; si[r] = idx;
                if (lane == idx) val = -INFINITY;
            }
            const float e1 = __expf(sv[1] - sv[0]), e2 = __expf(sv[2] - sv[0]), e3 = __expf(sv[3] - sv[0]);
            const float inv = 1.0f / (1.0f + e1 + e2 + e3);
            if (lane < 4) {
                const int myi = lane == 0 ? si[0] : lane == 1 ? si[1] : lane == 2 ? si[2] : si[3];
                const float myg = (lane == 0 ? 1.0f : lane == 1 ? e1 : lane == 2 ? e2 : e3) * inv;
                p.top_idx[tok * 4 + lane] = myi; p.top_gate[tok * 4 + lane] = myg;
                atomicAdd(&cnt[myi], 1);
            }
            __builtin_amdgcn_wave_barrier();
        }
        __syncthreads();
        if (tid < 32) p.blk_cnt[c * 32 + tid] = cnt[tid];
    }
    __syncthreads();
}

__device__ __forceinline__ void phase_dispatch(const Params& p, char* lds, int vb, int nvb) {
    int* base = (int*)lds;
    int* tot = base + 32;
    int* start = tot + 32;
    const int tid = threadIdx.x;
    for (int c = vb; c < NCHUNK; c += nvb) {
        __syncthreads();
        if (tid < 32) {
            int total = 0, before = 0;
            for (int cc = 0; cc < NCHUNK; ++cc) { const int v = p.blk_cnt[cc * 32 + tid]; total += v; if (cc < c) before += v; }
            int incl = total;
#pragma unroll
            for (int o = 1; o < 32; o <<= 1) { const int t = __shfl_up(incl, o); if (tid >= o) incl += t; }
            const int st = incl - total;
            base[tid] = st + before; tot[tid] = total; start[tid] = st;
        }
        __syncthreads();
        if (c == 0 && tid == 0) {
            int n = 0;
            for (int e = 0; e < NE; ++e) {
                const int cnt = tot[e];
                for (int t0 = 0; t0 < cnt; t0 += 256) { p.tile_e[n] = e; p.tile_row0[n] = start[e] + t0; p.tile_nrows[n] = min(256, cnt - t0); ++n; }
            }
            p.ntiles[0] = n;
        }
        if (tid < 32) {
            int run = base[tid];
            for (int i = 0; i < 128; ++i) {
                const int a = c * 128 + i;
                if (p.top_idx[a] == tid) { p.row_tok[run] = a >> 2; p.row_dst[run] = a; p.row_gate[run] = p.top_gate[a]; ++run; }
            }
        }
    }
    __syncthreads();
}

__device__ __forceinline__ void phase_moe_up(const Params& p, char* lds, int vb, int nvb) {
    const int nt = p.ntiles[0];
    for (int u = vb; u < nt * 16; u += nvb) {
        const int tile = u >> 4, pn = u & 15;
        const int e = p.tile_e[tile], row0 = p.tile_row0[tile], nv = p.tile_nrows[tile];
        gemm_tile_naive(p.h2, D, p.row_tok, row0, nv, p.w_up + (size_t)e * D * (2 * DFF) + pn * 256, 2 * DFF, D,
            [&](const f32x4 (&acc)[8][4], int wr, int wc, int fr, int fq) {
#pragma unroll
                for (int m = 0; m < 8; ++m) {
                    const int r = wr * 128 + m * 16 + fr;
                    if (r < nv) {
#pragma unroll
                        for (int n = 0; n < 4; ++n) {
                            const int c = pn * 256 + wc * 64 + n * 16 + fq * 4;
                            const f32x4 bb = *(const f32x4*)(p.b_up + (size_t)e * (2 * DFF) + c);
                            const f32x4 v = acc[m][n] + bb;
                            const float g0 = fminf(v[0], 7.f), l0 = fminf(fmaxf(v[1], -7.f), 7.f);
                            const float g1 = fminf(v[2], 7.f), l1 = fminf(fmaxf(v[3], -7.f), 7.f);
                            const float a0 = g0 * sigmoidf_(1.702f * g0) * (l0 + 1.0f), a1 = g1 * sigmoidf_(1.702f * g1) * (l1 + 1.0f);
                            *(unsigned*)(p.act + (size_t)(row0 + r) * DFF + (c >> 1)) = cvt_pk_bf16(a0, a1);
                        }
                    }
                }
            });
    }
}

__device__ __forceinline__ void phase_moe_down(const Params& p, char* lds, int vb, int nvb) {
    const int nt = p.ntiles[0];
    for (int u = vb; u < nt * 8; u += nvb) {
        const int tile = u >> 3, pn = u & 7;
        const int e = p.tile_e[tile], row0 = p.tile_row0[tile], nv = p.tile_nrows[tile];
        gemm_tile_naive(p.act, DFF, nullptr, row0, nv, p.w_down + (size_t)e * DFF * D + pn * 256, D, DFF,
            [&](const f32x4 (&acc)[8][4], int wr, int wc, int fr, int fq) {
#pragma unroll
                for (int m = 0; m < 8; ++m) {
                    const int r = wr * 128 + m * 16 + fr;
                    if (r < nv) {
                        const float gate = p.row_gate[row0 + r];
                        const size_t dst = (size_t)p.row_dst[row0 + r] * D;
#pragma unroll
                        for (int n = 0; n < 4; ++n) {
                            const int c = pn * 256 + wc * 64 + n * 16 + fq * 4;
                            const f32x4 bb = *(const f32x4*)(p.b_down + (size_t)e * D + c);
                            const f32x4 v = (acc[m][n] + bb) * gate;
                            u32x2 w; w.x = cvt_pk_bf16(v[0], v[1]); w.y = cvt_pk_bf16(v[2], v[3]);
                            *(u32x2*)(p.y + dst + c) = w;
                        }
                    }
                }
            });
    }
}

__device__ __forceinline__ void phase_final(const Params& p, char* lds, int vb, int nvb) {
    const int wid = threadIdx.x >> 6, lane = threadIdx.x & 63;
    for (int tok = vb * 8 + wid; tok < T; tok += nvb * 8) {
        f32x4 xv[8]; float ss = 0.f;
#pragma unroll
        for (int i = 0; i < 8; ++i) {
            f32x4 v = *(const f32x4*)(p.x1 + (size_t)tok * D + i * 256 + lane * 4);
#pragma unroll
            for (int j = 0; j < 4; ++j) {
                const u32x2 yy = *(const u32x2*)(p.y + ((size_t)tok * 4 + j) * D + i * 256 + lane * 4);
                v[0] += bf_lo(yy.x); v[1] += bf_hi(yy.x); v[2] += bf_lo(yy.y); v[3] += bf_hi(yy.y);
            }
            xv[i] = v; ss += v[0] * v[0] + v[1] * v[1] + v[2] * v[2] + v[3] * v[3];
        }
        ss = wave_sum(ss);
        const float rstd = rsqrtf(ss * (1.0f / D) + 1e-5f);
#pragma unroll
        for (int i = 0; i < 8; ++i) {
            const f32x4 g = *(const f32x4*)(p.g_final + i * 256 + lane * 4);
            *(f32x4*)(p.out + (size_t)tok * D + i * 256 + lane * 4) = xv[i] * rstd * g;
        }
    }
}

template <int MODE>
__global__ void __launch_bounds__(NTHREADS, 2) k_fwd(Params p) {
    extern __shared__ __attribute__((aligned(1024))) char lds[];
    const int vb = blockIdx.x, nvb = gridDim.x;
    XcdBarrier bar;
    if (MODE < 0) {
        volatile LAS unsigned* st = (volatile LAS unsigned*)(lds + LDS_BYTES - 16);
        if (threadIdx.x == 0) { st[0] = 0u; st[1] = 0u; st[2] = 0u; st[3] = 0u; }
        __syncthreads();
        bar = xcd_barrier_post(p.bar, st);
    }
#define PHASE(i, call) if (MODE < 0 || MODE == (i)) { call; } if (MODE < 0) xcd_barrier(bar);
    PHASE(0, phase_prologue(p, lds, vb, nvb))
    PHASE(1, phase_inproj(p, lds, vb, nvb))
    PHASE(2, (phase_attn_naive(p, lds, vb, nvb), phase_gmlp_naive(p, lds, vb, nvb)))
    PHASE(3, phase_branch(p, lds, vb, nvb))
    PHASE(4, phase_outproj(p, lds, vb, nvb))
    PHASE(5, phase_router(p, lds, vb, nvb))
    PHASE(6, phase_dispatch(p, lds, vb, nvb))
    PHASE(7, phase_moe_up(p, lds, vb, nvb))
    PHASE(8, phase_moe_down(p, lds, vb, nvb))
    if (MODE < 0 || MODE == 9) phase_final(p, lds, vb, nvb);
}

template <int MODE> static void launch_phase(const Params& p, int grid, hipStream_t stream) {
    static bool attr = false;
    if (!attr) { (void)hipFuncSetAttribute((const void*)k_fwd<MODE>, hipFuncAttributeMaxDynamicSharedMemorySize, LDS_BYTES); attr = true; }
    hipLaunchKernelGGL(k_fwd<MODE>, dim3(grid), dim3(NTHREADS), LDS_BYTES, stream, p);
}

extern "C" void kernel_launch(void* const* d_in, const int* in_sizes, int n_in, void* d_out, int out_size, void* d_ws, size_t ws_size, hipStream_t stream) {
    Params p; memset(&p, 0, sizeof(p));
    const float* const* in = (const float* const*)d_in;
    p.x = in[0]; p.g_mix = in[1]; p.w_in = in[2]; p.b_forget = in[3]; p.g_v_ln = in[4]; p.b_v_ln = in[5]; p.w_spatial = in[6]; p.b_spatial = in[7];
    p.w_ba = in[8]; p.w_bg = in[9]; p.w_out = in[10]; p.g_ffn = in[11]; p.w_router = in[12]; p.b_router = in[13];
    p.w_up = in[14]; p.b_up = in[15]; p.w_down = in[16]; p.b_down = in[17]; p.g_final = in[18];
    p.out = (float*)d_out;
    char* w = (char*)d_ws; size_t off = 0;
    auto take = [&](size_t bytes) { char* r = w + off; off += (bytes + 255) & ~(size_t)255; return r; };
    p.bar = (unsigned*)take(XCD_BAR_WORDS * 4);
    p.h = (bf16_t*)take((size_t)T * D * 2);
    p.q = (bf16_t*)take((size_t)T * AW * 2); p.k = (bf16_t*)take((size_t)T * AW * 2); p.v = (bf16_t*)take((size_t)T * AW * 2);
    p.zg = (bf16_t*)take((size_t)T * 2048 * 2); p.gates = (bf16_t*)take((size_t)T * 4096 * 2);
    p.attn = (bf16_t*)take((size_t)T * AW * 2); p.sg = (bf16_t*)take((size_t)T * GW * 2);
    p.merged = (bf16_t*)take((size_t)T * D * 2); p.h2 = (bf16_t*)take((size_t)T * D * 2);
    p.act = (bf16_t*)take((size_t)T * 4 * DFF * 2); p.y = (bf16_t*)take((size_t)T * 4 * D * 2);
    p.ls = (float*)take((size_t)T * 8 * 4); p.x1 = (float*)take((size_t)T * D * 4);
    p.top_gate = (float*)take((size_t)T * 4 * 4); p.row_gate = (float*)take((size_t)T * 4 * 4);
    p.top_idx = (int*)take((size_t)T * 4 * 4); p.blk_cnt = (int*)take((size_t)NCHUNK * 32 * 4);
    p.row_tok = (int*)take((size_t)T * 4 * 4); p.row_dst = (int*)take((size_t)T * 4 * 4);
    p.tile_e = (int*)take(MAXTILES * 4); p.tile_row0 = (int*)take(MAXTILES * 4); p.tile_nrows = (int*)take(MAXTILES * 4); p.ntiles = (int*)take(256);
#if MK_SINGLE
    hipMemsetAsync(p.bar, 0, XCD_BAR_WORDS * 4, stream);
    launch_phase<-1>(p, 256, stream);
#else
    launch_phase<0>(p, 256, stream); launch_phase<1>(p, 256, stream); launch_phase<2>(p, 256, stream); launch_phase<3>(p, 256, stream);
    launch_phase<4>(p, 256, stream); launch_phase<5>(p, 256, stream); launch_phase<6>(p, 256, stream); launch_phase<7>(p, 256, stream);
    launch_phase<8>(p, 256, stream); launch_phase<9>(p, 256, stream);
#endif
}
```

```cpp
#include <hip/hip_runtime.h>
#include <stdint.h>
#include <string.h>
#include <stdio.h>

#ifndef MK_SINGLE
#define MK_SINGLE 1
#endif

typedef unsigned short bf16_t;
typedef short bf16x8 __attribute__((ext_vector_type(8)));
typedef float f32x4 __attribute__((ext_vector_type(4)));
typedef float f32x2 __attribute__((ext_vector_type(2)));
typedef unsigned u32x4 __attribute__((ext_vector_type(4)));
typedef unsigned u32x2 __attribute__((ext_vector_type(2)));
typedef int i32x4 __attribute__((ext_vector_type(4)));
typedef int i32x8 __attribute__((ext_vector_type(8)));

constexpr int D = 2048, NB = 4, S = 2048, T = NB * S, H = 8, DH = 128, AW = 1024, GW = 1024, PW = 9224, NE = 32, DFF = 2048;
constexpr int PN_SPLIT = 20;
constexpr int NCHUNK = 256;
constexpr int MAXTILES = 192;
constexpr int NTHREADS = 512;
constexpr int LDS_BYTES = 144 * 1024;

#define XB_TMO      128
#define XB_XCNT(j)  (256  + 64 * (j))
#define XB_XSUB(j)  (1280 + 64 * (j))
#define XB_XGEN(j)  (2304 + 64 * (j))
#define XB_TOP      3328
#define XB_TOPGEN   3392
#define XCD_BAR_WORDS 3456
#define XB_SPIN_CAP (1u << 22)
#define LAS __attribute__((address_space(3)))

__device__ __forceinline__ unsigned xb_ld(unsigned* p)              { return __hip_atomic_load(p, __ATOMIC_RELAXED, __HIP_MEMORY_SCOPE_AGENT); }
__device__ __forceinline__ unsigned xb_add(unsigned* p, unsigned v) { return __hip_atomic_fetch_add(p, v, __ATOMIC_RELAXED, __HIP_MEMORY_SCOPE_AGENT); }
__device__ __forceinline__ unsigned xb_xcc_id() { return (unsigned)__builtin_amdgcn_s_getreg((3 << 11) | 20) & 0xFu; }
#define XB_SPIN(cond, bar) do { unsigned _sp = 0; while (cond) { __builtin_amdgcn_s_sleep(1); \
    if ((++_sp & 255u) == 0u) { if (xb_ld(&(bar)[XB_TMO])) break; if (_sp > XB_SPIN_CAP) { atomicAdd(&(bar)[XB_TMO], 1u); break; } } } } while (0)

struct XcdBarrier { unsigned* bar; unsigned x; volatile LAS unsigned* st; };

__device__ __forceinline__ XcdBarrier xcd_barrier_post(unsigned* bar, volatile LAS unsigned* st) {
    XcdBarrier b; b.bar = bar; b.x = xb_xcc_id(); b.st = st;
    if (threadIdx.x == 0) (void)xb_add(&bar[XB_XCNT(b.x)], 1u);
    return b;
}
__device__ __forceinline__ void xcd_barrier_complete(unsigned* bar, unsigned x, unsigned& nloc, unsigned& nx) {
    const unsigned G = gridDim.x * gridDim.y * gridDim.z;
    unsigned sum, cnt, mine, sp = 0u;
    for (;;) {
        sum = 0u; cnt = 0u; mine = 0u;
#pragma unroll
        for (unsigned j = 0; j < 16; ++j) { const unsigned c = xb_ld(&bar[XB_XCNT(j)]); sum += c; cnt += (c > 0u) ? 1u : 0u; mine = (j == x) ? c : mine; }
        if (sum == G) break;
        __builtin_amdgcn_s_sleep(1);
        if ((++sp & 255u) == 0u) { if (xb_ld(&bar[XB_TMO])) break; if (sp > XB_SPIN_CAP) { atomicAdd(&bar[XB_TMO], 1u); break; } }
    }
    nloc = mine > 0u ? mine : 1u; nx = cnt > 0u ? cnt : 1u;
}
__device__ __forceinline__ void xcd_barrier(const XcdBarrier& b) {
    asm volatile("s_waitcnt vmcnt(0)" ::: "memory");
    __syncthreads();
    if (threadIdx.x == 0) {
        unsigned* bar = b.bar;
        __builtin_amdgcn_s_waitcnt(0);
        unsigned nloc = b.st[0], nx = b.st[1];
        if (nloc == 0u) { xcd_barrier_complete(bar, b.x, nloc, nx); b.st[0] = nloc; b.st[1] = nx; }
        const unsigned old = xb_add(&bar[XB_XSUB(b.x)], 1u);
        const unsigned gen = old / nloc;
        if (old + 1u == (gen + 1u) * nloc) {
            __builtin_amdgcn_fence(__ATOMIC_RELEASE, "agent");
            asm volatile("s_waitcnt vmcnt(0)" ::: "memory");
            const unsigned og = xb_add(&bar[XB_TOP], 1u);
            const unsigned tg = og / nx;
            if (og + 1u == (tg + 1u) * nx) xb_add(&bar[XB_TOPGEN], 1u);
            else XB_SPIN(xb_ld(&bar[XB_TOPGEN]) == tg, bar);
            __builtin_amdgcn_fence(__ATOMIC_ACQUIRE, "agent");
            xb_add(&bar[XB_XGEN(b.x)], 1u);
            asm volatile("s_waitcnt vmcnt(0)" ::: "memory");
        } else {
            XB_SPIN(xb_ld(&bar[XB_XGEN(b.x)]) == gen, bar);
            __builtin_amdgcn_fence(__ATOMIC_ACQUIRE, "agent");
            asm volatile("s_waitcnt vmcnt(0)" ::: "memory");
        }
    }
    __syncthreads();
}

struct Params {
    const float *x, *g_mix, *w_in, *b_forget, *g_v_ln, *b_v_ln, *w_spatial, *b_spatial, *w_ba, *w_bg, *w_out, *g_ffn, *w_router, *b_router,
                *w_up, *b_up, *w_down, *b_down, *g_final;
    float* out;
    bf16_t *h, *q, *k, *v, *zg, *gates, *attn, *sg, *merged, *h2, *act, *y;
    bf16_t *wb_in, *wb_ba, *wb_bg, *wb_out, *wb_up, *wb_down, *wr_hi, *wr_lo;
    unsigned char *h8, *wb_in8;
    float *ls, *x1, *top_gate, *row_gate, *lnpart;
    int *top_idx, *blk_cnt, *row_tok, *row_dst, *tile_e, *tile_row0, *tile_nrows, *ntiles, *unit_up, *unit_down;
    unsigned* bar;
};

typedef __bf16 bf16x2_t __attribute__((ext_vector_type(2)));
__device__ __forceinline__ unsigned cvt_pk_bf16_mfma(float lo, float hi) { const f32x2 v = {lo, hi}; return __builtin_bit_cast(unsigned, __builtin_convertvector(v, bf16x2_t)); }
__device__ __forceinline__ unsigned cvt_pk_bf16(float lo, float hi) { unsigned r; asm("v_cvt_pk_bf16_f32 %0, %1, %2" : "=v"(r) : "v"(lo), "v"(hi)); return r; }
__device__ __forceinline__ int tid_opaque() { int t = threadIdx.x; asm volatile("" : "+v"(t)); return t; }
__device__ __forceinline__ float bf_lo(unsigned u) { return __uint_as_float(u << 16); }
__device__ __forceinline__ float bf_hi(unsigned u) { return __uint_as_float(u & 0xffff0000u); }
__device__ __forceinline__ float wave_sum(float v) {
#pragma unroll
    for (int o = 32; o; o >>= 1) v += __shfl_xor(v, o);
    return v; }
__device__ __forceinline__ float wave_max(float v) {
#pragma unroll
    for (int o = 32; o; o >>= 1) v = fmaxf(v, __shfl_xor(v, o));
    return v; }
__device__ __forceinline__ float sigmoidf_(float x) { return 1.0f / (1.0f + __expf(-x)); }
__device__ __forceinline__ float log_sigmoid(float x) { return fminf(x, 0.f) - log1pf(__expf(-fabsf(x))); }
__device__ __forceinline__ float gelu_erf(float v) { return 0.5f * v * (1.0f + erff(v * 0.70710678118654752f)); }

template <class Epi>
__device__ __forceinline__ void gemm_tile_naive(const bf16_t* __restrict__ A, int lda, const int* __restrict__ rowmap, int row0, int nvalid,
                                                const float* __restrict__ Bm, int ldb, int K, Epi&& epi) {
    const int tid = tid_opaque(), wid = tid >> 6, lane = tid & 63, wr = wid >> 2, wc = wid & 3, fr = lane & 15, fq = lane >> 4;
    const bf16_t* arow[8];
#pragma unroll
    for (int m = 0; m < 8; ++m) {
        int r = wr * 128 + m * 16 + fr; if (r >= nvalid) r = 0;
        const int gr = rowmap ? rowmap[row0 + r] : row0 + r;
        arow[m] = A + (size_t)gr * lda + fq * 8;
    }
    f32x4 acc[8][4];
#pragma unroll
    for (int m = 0; m < 8; ++m)
#pragma unroll
        for (int n = 0; n < 4; ++n) acc[m][n] = (f32x4){0.f, 0.f, 0.f, 0.f};
    for (int k0 = 0; k0 < K; k0 += 32) {
        bf16x8 At[8], Bf[4];
#pragma unroll
        for (int m = 0; m < 8; ++m) At[m] = *(const bf16x8*)(arow[m] + k0);
#pragma unroll
        for (int n = 0; n < 4; ++n) {
            const float* bp = Bm + (size_t)(k0 + fq * 8) * ldb + wc * 64 + n * 16 + fr;
            float v[8];
#pragma unroll
            for (int i = 0; i < 8; ++i) v[i] = bp[(size_t)i * ldb];
            u32x4 w; w.x = cvt_pk_bf16_mfma(v[0], v[1]); w.y = cvt_pk_bf16_mfma(v[2], v[3]); w.z = cvt_pk_bf16_mfma(v[4], v[5]); w.w = cvt_pk_bf16_mfma(v[6], v[7]);
            Bf[n] = __builtin_bit_cast(bf16x8, w);
        }
#pragma unroll
        for (int m = 0; m < 8; ++m)
#pragma unroll
            for (int n = 0; n < 4; ++n) acc[m][n] = __builtin_amdgcn_mfma_f32_16x16x32_bf16(Bf[n], At[m], acc[m][n], 0, 0, 0);
    }
    epi(acc, wr, wc, fr, fq);
}

template <bool MASKM> __device__ __forceinline__ int tile_row(int wr, int m, int fr) { return MASKM ? m * 32 + wr * 16 + fr : wr * 128 + m * 16 + fr; }
__device__ __forceinline__ int lds_byte(int r, int c) { const int st = (r >> 4) * 2 + (c >> 5), ob = (r & 15) * 64 + (c & 31) * 2; return st * 1024 + (ob ^ (((ob >> 9) & 1) << 5)); }
#define SCHED() __builtin_amdgcn_sched_barrier(0)

template <int LDB, bool GATHER, bool MASKM, class Epi>
__device__ __forceinline__ void gemm_tile(char* lds, const bf16_t* __restrict__ A, int lda, const int* __restrict__ rowmap, int row0, int nvalid,
                                          const float* __restrict__ Bm, int K, Epi&& epi) {
    constexpr int TILE_B = 256 * 64 * 2, STAGE_B = 2 * TILE_B;
    const int tid = tid_opaque(), wid = tid >> 6, lane = tid & 63, wr = wid >> 2, wc = wid & 3, fr = lane & 15, fq = lane >> 4;
    const int a_col = (wid & 1) * 32 + (((lane & 3) ^ ((lane >> 5) << 1)) << 3);
    unsigned aoff[4];
#pragma unroll
    for (int i = 0; i < 4; ++i) {
        const int R = ((wid >> 1) + 4 * i) * 16 + (lane >> 2);
        int r = MASKM ? ((R >> 4) & 7) * 32 + (R >> 7) * 16 + (R & 15) : R;
        if (MASKM && r >= nvalid) r = 0;
        const int gr = GATHER ? rowmap[row0 + r] : row0 + r;
        aoff[i] = (unsigned)gr * (unsigned)lda + (unsigned)a_col;
    }
    const int kq = lane & 3, nl = lane >> 2, kh = wid & 1, ng = wid >> 1;
    const unsigned bofs = (unsigned)((kh * 32 + kq * 8) * LDB + ng * 64 + nl * 4);
    const int boff0 = ((4 * ng + (nl >> 2)) * 2 + kh) * 1024 + ((((nl & 3) * 4) * 64 + kq * 16) ^ (((nl & 3) >> 1) << 5));
    const int mvalid = MASKM ? max(0, min(8, (nvalid - wr * 16 + 31) >> 5)) : 8;
    f32x4 acc[8][4];
#pragma unroll
    for (int m = 0; m < 8; ++m)
#pragma unroll
        for (int n = 0; n < 4; ++n) acc[m][n] = (f32x4){0.f, 0.f, 0.f, 0.f};
    u32x4 sa[4]; f32x4 sb[8];
#define G_ISSUE(kt) do { const bf16_t* Ak_ = A + (kt) * 64; const float* Bk_ = Bm + (size_t)(kt) * 64 * LDB; unsigned bo_ = bofs; asm volatile("" : "+v"(bo_)); \
        _Pragma("unroll") for (int i = 0; i < 4; ++i) sa[i] = *(const u32x4*)(Ak_ + aoff[i]); \
        _Pragma("unroll") for (int i = 0; i < 8; ++i) sb[i] = *(const f32x4*)(Bk_ + (bo_ + (unsigned)(i * LDB))); SCHED(); } while (0)
#define G_WRITE(buf) do { char* sA_ = lds + (buf) * STAGE_B; char* sB_ = sA_ + TILE_B; \
        _Pragma("unroll") for (int i = 0; i < 4; ++i) *(u32x4*)(sA_ + wid * 1024 + i * 8192 + lane * 16) = sa[i]; \
        _Pragma("unroll") for (int j = 0; j < 4; ++j) { u32x4 w_; w_.x = cvt_pk_bf16(sb[0][j], sb[1][j]); w_.y = cvt_pk_bf16(sb[2][j], sb[3][j]); \
            w_.z = cvt_pk_bf16(sb[4][j], sb[5][j]); w_.w = cvt_pk_bf16(sb[6][j], sb[7][j]); *(u32x4*)(sB_ + boff0 + j * 64) = w_; } } while (0)
#define G_KSTEP(buf, ks) do { const char* sA_ = lds + (buf) * STAGE_B; const char* sB_ = sA_ + TILE_B; bf16x8 Bf[4]; \
        _Pragma("unroll") for (int n = 0; n < 4; ++n) Bf[n] = *(const bf16x8*)(sB_ + lds_byte(wc * 64 + n * 16 + fr, (ks) * 32 + fq * 8)); \
        _Pragma("unroll") for (int mh = 0; mh < 2; ++mh) { if (!MASKM || mh * 4 < mvalid) { bf16x8 At[4]; \
            _Pragma("unroll") for (int m = 0; m < 4; ++m) At[m] = *(const bf16x8*)(sA_ + lds_byte(wr * 128 + (mh * 4 + m) * 16 + fr, (ks) * 32 + fq * 8)); \
            _Pragma("unroll") for (int m = 0; m < 4; ++m) { \
                _Pragma("unroll") for (int n = 0; n < 4; ++n) acc[mh * 4 + m][n] = __builtin_amdgcn_mfma_f32_16x16x32_bf16(Bf[n], At[m], acc[mh * 4 + m][n], 0, 0, 0); } } \
            SCHED(); } } while (0)
    const int nt = K / 64;
    G_ISSUE(0); G_WRITE(0); G_ISSUE(1); __syncthreads();
    for (int t = 0; t < nt; ++t) {
        const int cur = t & 1;
        if (t + 1 < nt) G_WRITE(cur ^ 1);
        if (t + 2 < nt) G_ISSUE(t + 2);
        G_KSTEP(cur, 0); G_KSTEP(cur, 1);
        __syncthreads();
    }
#undef G_ISSUE
#undef G_WRITE
#undef G_KSTEP
    epi(acc, wr, wc, fr, fq);
}

__device__ __forceinline__ void conv_tiles(char* lds, const float* __restrict__ src, int ldsrc, bf16_t* __restrict__ dst, int K, int nkt, int t_begin, int t_end, bool shift8, int vb, int nvb, int nnt = 1 << 30, size_t mstride = 0) {
    const int tid = tid_opaque(), w = tid >> 6, lane = tid & 63;
    f32x4 v0[8], v1[8], n0[8], n1[8], m0[8], m1[8];
    int t = t_begin + vb;
    if (t >= t_end) return;
#define CV_LOAD(dstv, tt) do { const int kt_ = (tt) % nkt, nt_ = (tt) / nkt, e_ = nt_ / nnt, ntl_ = nt_ % nnt; \
        const float* s_ = src + (size_t)e_ * mstride + (size_t)(kt_ * 64 + w * 8) * ldsrc + ntl_ * 256 + ((shift8 && nt_ >= 12) ? 8 : 0) + lane * 4; \
        _Pragma("unroll") for (int i = 0; i < 8; ++i) dstv[i] = __builtin_nontemporal_load((const f32x4*)(s_ + (size_t)i * ldsrc)); } while (0)
#define CV_PUT(srcv, buf) do { _Pragma("unroll") for (int j = 0; j < 4; ++j) { u32x4 pk; pk.x = cvt_pk_bf16(srcv[0][j], srcv[1][j]); pk.y = cvt_pk_bf16(srcv[2][j], srcv[3][j]); \
        pk.z = cvt_pk_bf16(srcv[4][j], srcv[5][j]); pk.w = cvt_pk_bf16(srcv[6][j], srcv[7][j]); *(u32x4*)(lds + (buf) * 32768 + (lane * 4 + j) * 128 + ((w ^ (lane & 7)) << 4)) = pk; } } while (0)
#define CV_OUT(tt, buf) do { const int kt_ = (tt) % nkt, nt_ = (tt) / nkt; bf16_t* d_ = dst + (size_t)nt_ * 256 * K + kt_ * 64; \
        _Pragma("unroll") for (int r = 0; r < 4; ++r) { const int c_ = r * 512 + tid, n_ = c_ >> 3, kc_ = c_ & 7; \
            __builtin_nontemporal_store(*(const u32x4*)(lds + (buf) * 32768 + n_ * 128 + ((kc_ ^ ((n_ >> 2) & 7)) << 4)), (u32x4*)(d_ + (size_t)n_ * K + kc_ * 8)); } } while (0)
    CV_LOAD(v0, t); if (t + nvb < t_end) CV_LOAD(v1, t + nvb);
    if (t + 2 * nvb < t_end) CV_LOAD(n0, t + 2 * nvb);
    if (t + 3 * nvb < t_end) CV_LOAD(n1, t + 3 * nvb);
    for (; t < t_end; t += 2 * nvb) {
        const bool two = t + nvb < t_end;
        if (t + 4 * nvb < t_end) CV_LOAD(m0, t + 4 * nvb);
        if (t + 5 * nvb < t_end) CV_LOAD(m1, t + 5 * nvb);
        __syncthreads();
        CV_PUT(v0, 0); if (two) CV_PUT(v1, 1);
        __syncthreads();
        CV_OUT(t, 0); if (two) CV_OUT(t + nvb, 1);
#pragma unroll
        for (int i = 0; i < 8; ++i) { v0[i] = n0[i]; v1[i] = n1[i]; n0[i] = m0[i]; n1[i] = m1[i]; }
    }
#undef CV_LOAD
#undef CV_PUT
#undef CV_OUT
    __syncthreads();
}

__device__ __forceinline__ unsigned pack_fp8x4(float a, float b, float c, float d) {
    a = fminf(fmaxf(a, -448.f), 448.f); b = fminf(fmaxf(b, -448.f), 448.f); c = fminf(fmaxf(c, -448.f), 448.f); d = fminf(fmaxf(d, -448.f), 448.f);
    int r = 0; r = __builtin_amdgcn_cvt_pk_fp8_f32(a, b, r, false); r = __builtin_amdgcn_cvt_pk_fp8_f32(c, d, r, true); return (unsigned)r;
}
__device__ __forceinline__ void conv_tiles_f8(char* lds, const float* __restrict__ src, int ldsrc, unsigned char* __restrict__ dst, int K, int nkt, int t_begin, int t_end, int vb, int nvb, int nnt, size_t mstride, bool shift8 = false) {
    const int tid = tid_opaque(), w = tid >> 6, lane = tid & 63, n4 = lane & 31, kg = w * 2 + (lane >> 5);
    f32x4 v0[8], v1[8], n0[8], n1[8], m0[8], m1[8];
    int t = t_begin + vb;
    if (t >= t_end) return;
#define C8_LOAD(dstv, tt) do { const int kt_ = (tt) % nkt, nt_ = (tt) / nkt, e_ = nt_ / nnt, ntl_ = nt_ % nnt; \
        const float* s_ = src + (size_t)e_ * mstride + (size_t)(kt_ * 128 + kg * 8) * ldsrc + ntl_ * 128 + ((shift8 && nt_ >= 24) ? 8 : 0) + n4 * 4; \
        _Pragma("unroll") for (int i = 0; i < 8; ++i) dstv[i] = __builtin_nontemporal_load((const f32x4*)(s_ + (size_t)i * ldsrc)); } while (0)
#define C8_PUT(srcv, buf) do { _Pragma("unroll") for (int j = 0; j < 4; ++j) { u32x2 pk; pk.x = pack_fp8x4(srcv[0][j] * 64.f, srcv[1][j] * 64.f, srcv[2][j] * 64.f, srcv[3][j] * 64.f); \
        pk.y = pack_fp8x4(srcv[4][j] * 64.f, srcv[5][j] * 64.f, srcv[6][j] * 64.f, srcv[7][j] * 64.f); \
        *(u32x2*)(lds + (buf) * 16384 + (n4 * 4 + j) * 128 + ((((kg >> 1) ^ (n4 & 7))) << 4) + (kg & 1) * 8) = pk; } } while (0)
#define C8_OUT(tt, buf) do { const int kt_ = (tt) % nkt, nt_ = (tt) / nkt; unsigned char* d_ = dst + (size_t)nt_ * 128 * K + kt_ * 128; \
        _Pragma("unroll") for (int r = 0; r < 2; ++r) { const int c_ = r * 512 + tid, n_ = c_ >> 3, ch_ = c_ & 7; \
            __builtin_nontemporal_store(*(const u32x4*)(lds + (buf) * 16384 + n_ * 128 + ((ch_ ^ ((n_ >> 2) & 7)) << 4)), (u32x4*)(d_ + (size_t)n_ * K + ch_ * 16)); } } while (0)
    C8_LOAD(v0, t); if (t + nvb < t_end) C8_LOAD(v1, t + nvb);
    if (t + 2 * nvb < t_end) C8_LOAD(n0, t + 2 * nvb);
    if (t + 3 * nvb < t_end) C8_LOAD(n1, t + 3 * nvb);
    for (; t < t_end; t += 2 * nvb) {
        const bool two = t + nvb < t_end;
        if (t + 4 * nvb < t_end) C8_LOAD(m0, t + 4 * nvb);
        if (t + 5 * nvb < t_end) C8_LOAD(m1, t + 5 * nvb);
        __syncthreads();
        C8_PUT(v0, 0); if (two) C8_PUT(v1, 1);
        __syncthreads();
        C8_OUT(t, 0); if (two) C8_OUT(t + nvb, 1);
#pragma unroll
        for (int i = 0; i < 8; ++i) { v0[i] = n0[i]; v1[i] = n1[i]; n0[i] = m0[i]; n1[i] = m1[i]; }
    }
#undef C8_LOAD
#undef C8_PUT
#undef C8_OUT
    __syncthreads();
}

namespace g8 {
constexpr int BK = 64, HALF = 128, HTB = HALF * BK * 2;
__device__ __forceinline__ int lds_byte8(int r, int c) { const int st = (r >> 4) * 2 + (c >> 5), rr = r & 15, cc = c & 31, ob = rr * 64 + cc * 2; return st * 1024 + (ob ^ (((ob >> 9) & 1) << 5)); }
__device__ __forceinline__ void stage_rc(int b, int& R, int& C) { const int st = b / 1024, sb = b % 1024, swz = sb ^ (((sb >> 9) & 1) << 5); R = (st >> 1) * 16 + swz / 64; C = (st & 1) * 32 + (swz % 64) / 2; }
__device__ __forceinline__ int perm32(int rho) { const int n = rho >> 4, i = rho & 15; return 8 * (i >> 2) + 4 * n + (i & 3); }
struct Unit { const char* A; const char* B; int row0, nv, pm, pn, e; };
__device__ __forceinline__ int xcd_remap(int L, int nwg) { const int q = nwg / 8, r = nwg % 8, xcd = L % 8, off = L / 8; return (xcd < r ? xcd * (q + 1) : r * (q + 1) + (xcd - r) * q) + off; }

template <bool GATHER, bool F8  , class Epi, class Sched>
__device__ __forceinline__ void gemm_phase8(char* lds_g, const int K, const int* __restrict__ rowmap, const Sched& S, const Epi& E) {
    LAS unsigned char* lds = (LAS unsigned char*)lds_g;
    const int tid = tid_opaque(), wid = __builtin_amdgcn_readfirstlane(tid >> 6), lane = tid & 63, wr = wid >> 2, wc = wid & 3, fr = lane & 15, fq = lane >> 4;
    constexpr int ESZ = F8 ? 1 : 2;
    const int nt = K * ESZ / 128;
    unsigned voffB[2], vaC[2][2], vaN[2][2];
#pragma unroll
    for (int i = 0; i < 2; ++i) { int sR_, sC_; stage_rc(tid * 16 + i * 8192, sR_, sC_); const int Rb = (sR_ & ~31) + perm32(sR_ & 31); voffB[i] = (unsigned)(Rb * K * ESZ + sC_ * 2); }
    const size_t kstep = (size_t)(BK * 2), hstep = (size_t)HALF * K * ESZ;
    const unsigned ldsw = (unsigned)wid * 1024u;
    const int aoff = lds_byte8(wr * 64 + fr, fq * 8), boff = lds_byte8(wc * 32 + fr, fq * 8);
#define G8_SA(b, h) (((b) * 2 + (h)) * HTB)
#define G8_SB(b, h) ((4 + (b) * 2 + (h)) * HTB)
#define G8_GLDS(bufoff, gptr, v0, v1) do { __builtin_amdgcn_global_load_lds((const unsigned*)((gptr) + (v0)), (LAS unsigned*)(lds + (bufoff) + ldsw), 16, 0, 0); \
        __builtin_amdgcn_global_load_lds((const unsigned*)((gptr) + (v1)), (LAS unsigned*)(lds + (bufoff) + ldsw + 8192), 16, 0, 0); } while (0)
#define G8_STB(bufoff, gptr) G8_GLDS(bufoff, gptr, voffB[0], voffB[1])
#define G8_STA(bufoff, gptr, va, h) G8_GLDS(bufoff, gptr, va[h][0], va[h][1])
#define G8_STA2(bufoff, gptr, h) G8_GLDS(bufoff, gptr, ((GATHER && last) ? vaN[h][0] : vaC[h][0]), ((GATHER && last) ? vaN[h][1] : vaC[h][1]))
#define G8_VA(va, u) do { int tv_ = tid; asm volatile("" : "+v"(tv_)); _Pragma("unroll") for (int i_ = 0; i_ < 2; ++i_) { int sR_, sC_; stage_rc(tv_ * 16 + i_ * 8192, sR_, sC_); _Pragma("unroll") for (int h_ = 0; h_ < 2; ++h_) { \
        if (GATHER) { int r_ = h_ * HALF + sR_; r_ = r_ < (u).nv ? r_ : (u).nv - 1; va[h_][i_] = (unsigned)rowmap[(u).row0 + r_] * (unsigned)(K * ESZ) + (unsigned)sC_ * 2u; } \
        else va[h_][i_] = (unsigned)((h_ * HALF + sR_) * K * ESZ + sC_ * 2); } } } while (0)
#define G8_LD8(dst, addr) do { const i32x4 lo_ = *(const LAS i32x4*)(lds + (addr)), hi_ = *(const LAS i32x4*)(lds + (addr) + 1024); dst = __builtin_shufflevector(lo_, hi_, 0, 1, 2, 3, 4, 5, 6, 7); } while (0)
#define G8_LDA(dst, b, h) do { if (F8) { _Pragma("unroll") for (int m = 0; m < 4; ++m) G8_LD8(dst##8[m], G8_SA(b, h) + aoff + m * 2048); } \
        else { _Pragma("unroll") for (int m = 0; m < 4; ++m) _Pragma("unroll") for (int k = 0; k < 2; ++k) dst[m][k] = *(const LAS bf16x8*)(lds + G8_SA(b, h) + aoff + m * 2048 + k * 1024); } } while (0)
#define G8_LDB(dst, b, h) do { if (F8) { _Pragma("unroll") for (int n = 0; n < 2; ++n) G8_LD8(dst##8[n], G8_SB(b, h) + boff + n * 2048); } \
        else { _Pragma("unroll") for (int n = 0; n < 2; ++n) _Pragma("unroll") for (int k = 0; k < 2; ++k) dst[n][k] = *(const LAS bf16x8*)(lds + G8_SB(b, h) + boff + n * 2048 + k * 1024); } } while (0)
#define G8_MMA(ai, bj, At, Bt) do { __builtin_amdgcn_s_setprio(1); _Pragma("unroll") for (int m = 0; m < 4; ++m) _Pragma("unroll") for (int n = 0; n < 2; ++n) { \
        if (F8) asm volatile("v_mfma_scale_f32_16x16x128_f8f6f4 %0, %1, %2, %0, %3, %4 op_sel_hi:[0,0,0]" : "+v"(acc[ai][bj][m][n]) : "v"(Bt##8[n]), "v"(At##8[m]), "v"(f8_sw), "v"(f8_sa)); \
        else { _Pragma("unroll") for (int k = 0; k < 2; ++k) acc[ai][bj][m][n] = __builtin_amdgcn_mfma_f32_16x16x32_bf16(Bt[n][k], At[m][k], acc[ai][bj][m][n], 0, 0, 0); } } \
        __builtin_amdgcn_s_setprio(0); } while (0)
#define G8_WAIT_V(n) asm volatile("s_waitcnt vmcnt(" #n ")" ::: "memory")
#define G8_WAIT_L(n) asm volatile("s_waitcnt lgkmcnt(" #n ")" ::: "memory")
#define G8_BAR __builtin_amdgcn_s_barrier()
#define G8_SCHED __builtin_amdgcn_sched_barrier(0)
    Unit cur, nxt; int ui = 0;
    if (!S.next(0, cur)) return;
    f32x4 acc[2][2][4][2];
#pragma unroll
    for (int a = 0; a < 2; ++a)
#pragma unroll
        for (int b = 0; b < 2; ++b)
#pragma unroll
            for (int m = 0; m < 4; ++m)
#pragma unroll
                for (int n = 0; n < 2; ++n) acc[a][b][m][n] = (f32x4){0.f, 0.f, 0.f, 0.f};
    bf16x8 At[4][2], B0[2][2], B1[2][2];
    const int f8_sw = 0x79797979, f8_sa = 0x7f7f7f7f;
    i32x8 At8[4], B08[2], B18[2];
    const char* cA = cur.A; const char* cB = cur.B;
    G8_VA(vaC, cur);
#pragma unroll
    for (int h = 0; h < 2; ++h) { vaN[h][0] = vaC[h][0]; vaN[h][1] = vaC[h][1]; }
    G8_STB(G8_SB(0, 0), cB); G8_STA(G8_SA(0, 0), cA, vaC, 0); G8_STB(G8_SB(0, 1), cB + hstep); G8_STA(G8_SA(0, 1), cA, vaC, 1);
    if (wr == 1) G8_BAR;
    G8_WAIT_V(4); G8_BAR;
    G8_STB(G8_SB(1, 0), cB + kstep); G8_STA(G8_SA(1, 0), cA + kstep, vaC, 0); G8_STB(G8_SB(1, 1), cB + hstep + kstep);
    G8_WAIT_V(6); G8_BAR;
    for (;;) {
        const bool has_next = S.next(ui + 1, nxt);
        const char* nA = has_next ? nxt.A : cA; const char* nB = has_next ? nxt.B : cB;
        if (GATHER && has_next) G8_VA(vaN, nxt);
        for (int t = 0; t < nt; t += 2) {
            const bool last = (t == nt - 2);
            const char* a1 = cA + (size_t)(t + 1) * kstep;
            const char* a2 = last ? nA : cA + (size_t)(t + 2) * kstep; const char* b2 = last ? nB : cB + (size_t)(t + 2) * kstep;
            const char* a3 = a2 + kstep; const char* b3 = b2 + kstep;
            G8_LDB(B0, 0, 0); G8_SCHED; G8_LDA(At, 0, 0); G8_STA(G8_SA(1, 1), a1, vaC, 1);
            G8_WAIT_L(8); G8_BAR; G8_WAIT_L(0); G8_MMA(0, 0, At, B0); G8_BAR; G8_SCHED;
            G8_LDB(B1, 0, 1); G8_STB(G8_SB(0, 0), b2);
            G8_BAR; G8_WAIT_L(0); G8_MMA(0, 1, At, B1); G8_BAR; if (F8) G8_SCHED;
            G8_LDA(At, 0, 1); G8_STA2(G8_SA(0, 0), a2, 0);
            G8_BAR; G8_WAIT_L(0); G8_MMA(1, 0, At, B0); G8_BAR; G8_SCHED;
            G8_STB(G8_SB(0, 1), b2 + hstep);
            G8_WAIT_V(6); G8_BAR; G8_MMA(1, 1, At, B1); G8_BAR; if (F8) G8_SCHED;
            G8_LDB(B0, 1, 0); G8_SCHED; G8_LDA(At, 1, 0); G8_STA2(G8_SA(0, 1), a2, 1);
            G8_WAIT_L(8); G8_BAR; G8_WAIT_L(0); G8_MMA(0, 0, At, B0); G8_BAR; G8_SCHED;
            G8_LDB(B1, 1, 1); G8_STB(G8_SB(1, 0), b3);
            G8_BAR; G8_WAIT_L(0); G8_MMA(0, 1, At, B1); G8_BAR; if (F8) G8_SCHED;
            G8_LDA(At, 1, 1); G8_STA2(G8_SA(1, 0), a3, 0);
            G8_BAR; G8_WAIT_L(0); G8_MMA(1, 0, At, B0); G8_BAR; G8_SCHED;
            G8_STB(G8_SB(1, 1), b3 + hstep);
            G8_WAIT_V(6); G8_BAR; G8_MMA(1, 1, At, B1); G8_BAR; if (F8) G8_SCHED;
        }
        bool keep_acc; { int te_ = tid; asm volatile("" : "+v"(te_)); const int le_ = te_ & 63; keep_acc = E(acc, cur, wr, wc, le_ & 15, le_ >> 4); }
        if (!has_next) break;
        if (!keep_acc) {
#pragma unroll
        for (int a = 0; a < 2; ++a)
#pragma unroll
            for (int b = 0; b < 2; ++b)
#pragma unroll
                for (int m = 0; m < 4; ++m)
#pragma unroll
                    for (int n = 0; n < 2; ++n) acc[a][b][m][n] = (f32x4){0.f, 0.f, 0.f, 0.f};
        }
        cur = nxt; cA = nA; cB = nB; ++ui;
        if (GATHER) {
#pragma unroll
            for (int h = 0; h < 2; ++h) { vaC[h][0] = vaN[h][0]; vaC[h][1] = vaN[h][1]; }
        }
    }
    G8_WAIT_V(0);
    if (wr == 0) G8_BAR;
    G8_BAR;
#undef G8_SA
#undef G8_SB
#undef G8_GLDS
#undef G8_STB
#undef G8_STA
#undef G8_STA2
#undef G8_VA
#undef G8_LDA
#undef G8_LDB
#undef G8_MMA
#undef G8_WAIT_V
#undef G8_WAIT_L
#undef G8_BAR
#undef G8_SCHED
}
__device__ __forceinline__ f32x2 gelu_pk(f32x2 v) {
    const f32x2 av = __builtin_elementwise_abs(v), d = av * 0.2316418882f + 1.0f;
    f32x2 t; t.x = __builtin_amdgcn_rcpf(d.x); t.y = __builtin_amdgcn_rcpf(d.y);
    f32x2 q = t * 0.5307027145f + (-0.7265760135f); q = q * t + 0.7107068705f; q = q * t + (-0.142248368f); q = q * t + 0.127414796f; q = q * t;
    const f32x2 s = (v * v) * (-0.72134752044f);
    f32x2 e; e.x = __builtin_amdgcn_exp2f(s.x); e.y = __builtin_amdgcn_exp2f(s.y);
    const f32x2 m = v * (q * e), r = v - m;
    f32x2 o; o.x = v.x < 0.f ? m.x : r.x; o.y = v.y < 0.f ? m.y : r.y; return o;
}
struct DenseOrder {
    const char* A; const char* B; int K, nM, nN, G, c, esz, pn0;
    __device__ __forceinline__ bool next(int i, Unit& u) const {
        const int nwg = nM * nN; const long L = (long)i * G + c; if (L >= nwg) return false;
        const int wgid = xcd_remap((int)L, nwg);
        const int nig = 8 * nN, gid = wgid / nig, fm = gid * 8, gsz = (nM - fm) < 8 ? (nM - fm) : 8;
        u.pm = fm + ((wgid % nig) % gsz); const int pnl = (wgid % nig) / gsz; u.pn = pn0 + pnl; u.row0 = u.pm * 256; u.nv = 256; u.e = 0;
        u.A = A + (size_t)u.pm * 256 * K * esz; u.B = B + (size_t)pnl * 256 * K * esz; return true;
    }
};
}

__device__ __forceinline__ void phase_prologue(const Params& p, char* lds, int vb, int nvb) {
    for (int i = vb * NTHREADS + tid_opaque(); i < NE * D; i += nvb * NTHREADS) {
        const int e = i >> 11, d = i & (D - 1); const float w = p.w_router[(size_t)d * NE + e];
        const unsigned hi = cvt_pk_bf16(w, 0.f) & 0xffffu; const float rem = w - __uint_as_float(hi << 16);
        p.wr_hi[i] = (bf16_t)hi; p.wr_lo[i] = (bf16_t)(cvt_pk_bf16(rem, 0.f) & 0xffffu);
    }
    float* wf = (float*)lds;
    for (int i = tid_opaque(); i < D * 2; i += NTHREADS) { const int d = i >> 1, hf = i & 1; const f32x4 wv = *(const f32x4*)(p.w_in + (size_t)d * PW + 3072 + hf * 4);
#pragma unroll
        for (int j = 0; j < 4; ++j) wf[(hf * 4 + j) * D + d] = wv[j]; }
    __syncthreads();
    const int tid = tid_opaque(), wid = tid >> 6, lane = tid & 63;
    for (int tok = vb * 8 + wid; tok < T; tok += nvb * 8) {
        const float* xr = p.x + (size_t)tok * D;
        f32x4 xv[8]; float ss = 0.f;
#pragma unroll
        for (int i = 0; i < 8; ++i) { xv[i] = *(const f32x4*)(xr + i * 256 + lane * 4); ss += xv[i][0] * xv[i][0] + xv[i][1] * xv[i][1] + xv[i][2] * xv[i][2] + xv[i][3] * xv[i][3]; }
        ss = wave_sum(ss);
        const float rstd = rsqrtf(ss * (1.0f / D) + 1e-5f);
        float fa[8];
#pragma unroll
        for (int j = 0; j < 8; ++j) fa[j] = 0.f;
#pragma unroll
        for (int i = 0; i < 8; ++i) {
            const f32x4 g = *(const f32x4*)(p.g_mix + i * 256 + lane * 4);
            const f32x4 hv = xv[i] * rstd * g;
            u32x2 w; w.x = cvt_pk_bf16(hv[0], hv[1]); w.y = cvt_pk_bf16(hv[2], hv[3]);
            *(u32x2*)(p.h + (size_t)tok * D + i * 256 + lane * 4) = w;
            *(unsigned*)(p.h8 + (size_t)tok * D + i * 256 + lane * 4) = pack_fp8x4(hv[0], hv[1], hv[2], hv[3]);
#pragma unroll
            for (int hh = 0; hh < 8; ++hh) { const f32x4 w4 = *(const f32x4*)(wf + hh * D + i * 256 + lane * 4); fa[hh] += hv[0] * w4[0] + hv[1] * w4[1] + hv[2] * w4[2] + hv[3] * w4[3]; }
        }
        float mine = 0.f;
#pragma unroll
        for (int j = 0; j < 8; ++j) { const float s = wave_sum(fa[j]); if (lane == j) mine = s; }
        if (lane < 8) p.ls[(size_t)tok * 8 + lane] = log_sigmoid(mine + p.b_forget[lane]);
    }
    __syncthreads();
}

__device__ __forceinline__ void phase_convert_dense(const Params& p, char* lds, int vb, int nvb) {
    conv_tiles(lds, p.w_in, PW, p.wb_in, D, 32, 0, 32 * PN_SPLIT, true, vb, nvb);
    conv_tiles_f8(lds, p.w_in, PW, p.wb_in8, D, 16, 16 * 2 * PN_SPLIT, 16 * 72, vb, nvb, 1 << 30, 0, true);
}
constexpr int UPSPLIT = 14592;
__device__ __forceinline__ void phase_convert_moe(const Params& p, char* lds, int part, int vb, int nvb) {
    unsigned char* up8 = (unsigned char*)p.wb_up; unsigned char* dn8 = (unsigned char*)p.wb_down;
    if (part == 0) {
        conv_tiles_f8(lds, p.w_up, 2 * DFF, up8, D, 16, 0, UPSPLIT, vb, nvb, 32, (size_t)D * 2 * DFF);
        conv_tiles(lds, p.w_ba, D, p.wb_ba, AW, 16, 0, 16 * 8, false, vb, nvb);
        conv_tiles(lds, p.w_bg, D, p.wb_bg, GW, 16, 0, 16 * 8, false, vb, nvb);
    } else {
        conv_tiles(lds, p.w_out, D, p.wb_out, D, 32, 0, 32 * 8, false, vb, nvb);
        conv_tiles_f8(lds, p.w_up, 2 * DFF, up8, D, 16, UPSPLIT, 16 * 32 * NE, vb, nvb, 32, (size_t)D * 2 * DFF);
        conv_tiles_f8(lds, p.w_down, D, dn8, DFF, 16, 0, 16 * 16 * NE, vb, nvb, 16, (size_t)DFF * D);
    }
}

struct EpiInproj {
    bf16_t *q, *k, *v, *zg, *gates; float* lnpart;
    __device__ __forceinline__ bool operator()(f32x4 (&acc)[2][2][4][2], const g8::Unit& u, int wr, int wc, int fr, int fq) const {
        const int pn = u.pn;
        bf16_t* base; int ld, colt, act;
        if (pn < 4) { base = q; ld = AW; colt = pn * 256; act = 0; }
        else if (pn < 8) { base = k; ld = AW; colt = (pn - 4) * 256; act = 0; }
        else if (pn < 12) { base = v; ld = AW; colt = (pn - 8) * 256; act = 0; }
        else if (pn < 20) { base = zg; ld = 2048; colt = (pn - 12) * 256; act = 1; }
        else { base = gates; ld = 4096; colt = (pn - 20) * 256; act = 2; }
        const bool lnp = pn >= 16 && pn < 20;
#pragma unroll
        for (int ai = 0; ai < 2; ++ai)
#pragma unroll
            for (int m = 0; m < 4; ++m) {
                const size_t row = (size_t)u.pm * 256 + ai * 128 + wr * 64 + m * 16 + fr;
                bf16_t* rowp = base + row * ld + colt + wc * 32 + fq * 8;
                float ps = 0.f, pq = 0.f;
#pragma unroll
                for (int bj = 0; bj < 2; ++bj) {
                    f32x4 v0 = acc[ai][bj][m][0], v1 = acc[ai][bj][m][1];
                    if (act == 1) {
                        const f32x2 a = g8::gelu_pk((f32x2){v0[0], v0[1]}), b = g8::gelu_pk((f32x2){v0[2], v0[3]}), c = g8::gelu_pk((f32x2){v1[0], v1[1]}), d = g8::gelu_pk((f32x2){v1[2], v1[3]});
                        v0 = (f32x4){a.x, a.y, b.x, b.y}; v1 = (f32x4){c.x, c.y, d.x, d.y};
                    } else if (act == 2) {
#pragma unroll
                        for (int j = 0; j < 4; ++j) { v0[j] = sigmoidf_(v0[j]); v1[j] = sigmoidf_(v1[j]); }
                    }
                    if (lnp) { ps += (v0[0] + v0[1]) + (v0[2] + v0[3]) + (v1[0] + v1[1]) + (v1[2] + v1[3]); pq += (v0[0] * v0[0] + v0[1] * v0[1]) + (v0[2] * v0[2] + v0[3] * v0[3]) + (v1[0] * v1[0] + v1[1] * v1[1]) + (v1[2] * v1[2] + v1[3] * v1[3]); }
                    u32x4 w; w.x = cvt_pk_bf16(v0[0], v0[1]); w.y = cvt_pk_bf16(v0[2], v0[3]); w.z = cvt_pk_bf16(v1[0], v1[1]); w.w = cvt_pk_bf16(v1[2], v1[3]);
                    *(u32x4*)(rowp + bj * 128) = w;
                }
                if (lnp) {
                    ps += __shfl_xor(ps, 16); ps += __shfl_xor(ps, 32); pq += __shfl_xor(pq, 16); pq += __shfl_xor(pq, 32);
                    if (fq == 0) *(f32x2*)(lnpart + (row * 16 + (pn - 16) * 4 + wc) * 2) = (f32x2){ps, pq};
                }
            }
        return false;
    }
};
__device__ __forceinline__ void phase_inproj8(const Params& p, char* lds, int vb, int nvb) {
    EpiInproj E; E.q = p.q; E.k = p.k; E.v = p.v; E.zg = p.zg; E.gates = p.gates; E.lnpart = p.lnpart;
    {
        g8::DenseOrder S; S.A = (const char*)p.h; S.B = (const char*)p.wb_in; S.K = D; S.nM = 32; S.nN = PN_SPLIT; S.G = nvb; S.c = vb; S.esz = 2; S.pn0 = 0;
        g8::gemm_phase8<false, false>(lds, D, nullptr, S, E);
    }
    {
        g8::DenseOrder S; S.A = (const char*)p.h8; S.B = (const char*)(p.wb_in8 + (size_t)PN_SPLIT * 256 * D); S.K = D; S.nM = 32; S.nN = 36 - PN_SPLIT; S.G = nvb; S.c = vb; S.esz = 1; S.pn0 = PN_SPLIT;
        g8::gemm_phase8<false, true>(lds, D, nullptr, S, E);
    }
}
__device__ __forceinline__ void phase_inproj_conv(const Params& p, char* lds, int vb, int nvb) {
    const int half = nvb >> 1; const bool first = vb >= half;
    if (first) phase_convert_moe(p, lds, 0, vb - half, nvb - half);
    phase_inproj8(p, lds, vb, nvb);
    if (!first) phase_convert_moe(p, lds, 1, vb, half);
}

__device__ __forceinline__ void phase_inproj(const Params& p, char* lds, int vb, int nvb) {
    for (int u = vb; u < 32 * 36; u += nvb) {
        const int pm = u / 36, pn = u % 36;
        const int bcol = pn < 12 ? pn * 256 : pn * 256 + 8;
        gemm_tile<PW, false, false>(lds, p.h, D, nullptr, pm * 256, 256, p.w_in + bcol, D,
            [&](const f32x4 (&acc)[8][4], int wr, int wc, int fr, int fq) {
#pragma unroll
                for (int m = 0; m < 8; ++m) {
                    const size_t row = (size_t)pm * 256 + wr * 128 + m * 16 + fr;
#pragma unroll
                    for (int n = 0; n < 4; ++n) {
                        const int c = wc * 64 + n * 16 + fq * 4;
                        f32x4 v = acc[m][n];
                        bf16_t* dst;
                        if (pn < 4) dst = p.q + row * AW + pn * 256 + c;
                        else if (pn < 8) dst = p.k + row * AW + (pn - 4) * 256 + c;
                        else if (pn < 12) dst = p.v + row * AW + (pn - 8) * 256 + c;
                        else if (pn < 20) { dst = p.zg + row * 2048 + (pn - 12) * 256 + c;
#pragma unroll
                            for (int j = 0; j < 4; ++j) v[j] = gelu_erf(v[j]); }
                        else { dst = p.gates + row * 4096 + (pn - 20) * 256 + c;
#pragma unroll
                            for (int j = 0; j < 4; ++j) v[j] = sigmoidf_(v[j]); }
                        u32x2 w; w.x = cvt_pk_bf16(v[0], v[1]); w.y = cvt_pk_bf16(v[2], v[3]);
                        *(u32x2*)dst = w;
                    }
                }
            });
    }
}

struct BranchOrder {
    const char *A0, *A1, *B0, *B1; int G, c;
    __device__ __forceinline__ bool next(int i, g8::Unit& u) const {
        const int nwg = 32 * 8; const long L = (long)(i >> 1) * G + c; if (L >= nwg) return false;
        const int wgid = g8::xcd_remap((int)L, nwg);
        const int nig = 8 * 8, gid = wgid / nig, fm = gid * 8;
        u.pm = fm + ((wgid % nig) % 8); u.pn = (wgid % nig) / 8; u.row0 = u.pm * 256; u.nv = 256; u.e = i & 1;
        u.A = ((i & 1) ? A1 : A0) + (size_t)u.pm * 256 * AW * 2; u.B = ((i & 1) ? B1 : B0) + (size_t)u.pn * 256 * AW * 2; return true;
    }
};
struct EpiBranch {
    const bf16_t* gates; bf16_t* merged;
    __device__ __forceinline__ bool operator()(f32x4 (&acc)[2][2][4][2], const g8::Unit& u, int wr, int wc, int fr, int fq) const {
#pragma unroll
        for (int aim = 0; aim < 4; ++aim) {
            const int ai = aim >> 1, m0 = (aim & 1) * 2;
            u32x4 ga[4][2], gb[4][2];
#pragma unroll
            for (int m = m0; m < m0 + 2; ++m) {
                const size_t row = (size_t)u.pm * 256 + ai * 128 + wr * 64 + m * 16 + fr;
#pragma unroll
                for (int bj = 0; bj < 2; ++bj) {
                    const int c = u.pn * 256 + bj * 128 + wc * 32 + fq * 8;
                    ga[m][bj] = *(const u32x4*)(gates + row * 4096 + c);
                    if (u.e == 0) gb[m][bj] = *(const u32x4*)(gates + row * 4096 + 2048 + c);
                }
            }
#pragma unroll
            for (int m = m0; m < m0 + 2; ++m) {
                const size_t row = (size_t)u.pm * 256 + ai * 128 + wr * 64 + m * 16 + fr;
#pragma unroll
                for (int bj = 0; bj < 2; ++bj) {
                    const int c = u.pn * 256 + bj * 128 + wc * 32 + fq * 8;
                    const u32x4 a_ = ga[m][bj];
                    const float gav[8] = {fmaxf(bf_lo(a_.x), 1e-6f), fmaxf(bf_hi(a_.x), 1e-6f), fmaxf(bf_lo(a_.y), 1e-6f), fmaxf(bf_hi(a_.y), 1e-6f),
                                          fmaxf(bf_lo(a_.z), 1e-6f), fmaxf(bf_hi(a_.z), 1e-6f), fmaxf(bf_lo(a_.w), 1e-6f), fmaxf(bf_hi(a_.w), 1e-6f)};
                    if (u.e == 0) {
                        const u32x4 b_ = gb[m][bj];
                        const float gbv[8] = {bf_lo(b_.x), bf_hi(b_.x), bf_lo(b_.y), bf_hi(b_.y), bf_lo(b_.z), bf_hi(b_.z), bf_lo(b_.w), bf_hi(b_.w)};
#pragma unroll
                        for (int j = 0; j < 4; ++j) { acc[ai][bj][m][0][j] *= gbv[j] / gav[j]; acc[ai][bj][m][1][j] *= gbv[4 + j] / gav[4 + j]; }
                    } else {
                        f32x4 v0 = acc[ai][bj][m][0], v1 = acc[ai][bj][m][1];
#pragma unroll
                        for (int j = 0; j < 4; ++j) { v0[j] *= gav[j]; v1[j] *= gav[4 + j]; }
                        u32x4 w; w.x = cvt_pk_bf16(v0[0], v0[1]); w.y = cvt_pk_bf16(v0[2], v0[3]); w.z = cvt_pk_bf16(v1[0], v1[1]); w.w = cvt_pk_bf16(v1[2], v1[3]);
                        *(u32x4*)(merged + row * D + c) = w;
                    }
                }
            }
        }
        return u.e == 0;
    }
};
__device__ __forceinline__ void phase_branch8(const Params& p, char* lds, int vb, int nvb) {
    BranchOrder S; S.A0 = (const char*)p.sg; S.A1 = (const char*)p.attn; S.B0 = (const char*)p.wb_bg; S.B1 = (const char*)p.wb_ba; S.G = nvb; S.c = vb;
    EpiBranch E; E.gates = p.gates; E.merged = p.merged;
    g8::gemm_phase8<false, false>(lds, AW, nullptr, S, E);
}
struct EpiOut {
    const float* x; float* x1;
    __device__ __forceinline__ bool operator()(f32x4 (&acc)[2][2][4][2], const g8::Unit& u, int wr, int wc, int fr, int fq) const {
#pragma unroll
        for (int aim = 0; aim < 4; ++aim) {
            const int ai = aim >> 1, m0 = (aim & 1) * 2;
            f32x4 xv[4][2][2];
#pragma unroll
            for (int m = m0; m < m0 + 2; ++m)
#pragma unroll
                for (int bj = 0; bj < 2; ++bj) {
                    const size_t o = ((size_t)u.pm * 256 + ai * 128 + wr * 64 + m * 16 + fr) * D + u.pn * 256 + bj * 128 + wc * 32 + fq * 8;
                    xv[m][bj][0] = *(const f32x4*)(x + o); xv[m][bj][1] = *(const f32x4*)(x + o + 4);
                }
#pragma unroll
            for (int m = m0; m < m0 + 2; ++m)
#pragma unroll
                for (int bj = 0; bj < 2; ++bj) {
                    const size_t o = ((size_t)u.pm * 256 + ai * 128 + wr * 64 + m * 16 + fr) * D + u.pn * 256 + bj * 128 + wc * 32 + fq * 8;
                    *(f32x4*)(x1 + o) = xv[m][bj][0] + acc[ai][bj][m][0];
                    *(f32x4*)(x1 + o + 4) = xv[m][bj][1] + acc[ai][bj][m][1];
                }
        }
        return false;
    }
};
__device__ __forceinline__ void phase_outproj8(const Params& p, char* lds, int vb, int nvb) {
    g8::DenseOrder S; S.A = (const char*)p.merged; S.B = (const char*)p.wb_out; S.K = D; S.nM = 32; S.nN = 8; S.G = nvb; S.c = vb; S.esz = 2; S.pn0 = 0;
    EpiOut E; E.x = p.x; E.x1 = p.x1;
    g8::gemm_phase8<false, false>(lds, D, nullptr, S, E);
}
struct MoeOrder {
    const int *unit_tab, *tile_row0, *tile_nrows; const char *A, *B; int nunits, rows_per_e, gather, G, c;
    __device__ __forceinline__ bool next(int i, g8::Unit& u) const {
        const int L = i * G + c; if (L >= nunits) return false;
        const int w = g8::xcd_remap(L, nunits);
        const int2 dd = *(const int2*)(unit_tab + 2 * w); const int d = dd.x;
        u.e = (unsigned)d >> 24; u.pn = (d >> 16) & 0xff; u.pm = d & 0xffff; u.row0 = dd.y & 0xffff; u.nv = (unsigned)dd.y >> 16;
        u.A = gather ? A : A + (size_t)u.row0 * D;
        u.B = B + ((size_t)u.e * rows_per_e + (size_t)u.pn * 256) * D; return true;
    }
};
struct EpiUp {
    const float* b_up; bf16_t* act;
    __device__ __forceinline__ bool operator()(f32x4 (&acc)[2][2][4][2], const g8::Unit& u, int wr, int wc, int fr, int fq) const {
        f32x4 bb[2][2];
#pragma unroll
        for (int bj = 0; bj < 2; ++bj) { const float* bp = b_up + (size_t)u.e * (2 * DFF) + u.pn * 256 + bj * 128 + wc * 32 + fq * 8; bb[bj][0] = *(const f32x4*)bp; bb[bj][1] = *(const f32x4*)(bp + 4); }
#pragma unroll
        for (int ai = 0; ai < 2; ++ai)
#pragma unroll
            for (int m = 0; m < 4; ++m) {
                const int r = ai * 128 + wr * 64 + m * 16 + fr;
                if (r < u.nv) {
#pragma unroll
                    for (int bj = 0; bj < 2; ++bj) {
                        const int c = u.pn * 256 + bj * 128 + wc * 32 + fq * 8;
                        const f32x4 v0 = acc[ai][bj][m][0] + bb[bj][0], v1 = acc[ai][bj][m][1] + bb[bj][1];
                        float a[4];
#pragma unroll
                        for (int j = 0; j < 2; ++j) {
                            const float g0 = fminf(v0[2 * j], 7.f), l0 = fminf(fmaxf(v0[2 * j + 1], -7.f), 7.f);
                            const float g1 = fminf(v1[2 * j], 7.f), l1 = fminf(fmaxf(v1[2 * j + 1], -7.f), 7.f);
                            a[j] = g0 * sigmoidf_(1.702f * g0) * (l0 + 1.0f); a[2 + j] = g1 * sigmoidf_(1.702f * g1) * (l1 + 1.0f);
                        }
                        *(unsigned*)((unsigned char*)act + (size_t)(u.row0 + r) * DFF + (c >> 1)) = pack_fp8x4(a[0], a[1], a[2], a[3]);
                    }
                }
            }
        return false;
    }
};
__device__ __forceinline__ void phase_moe_up8(const Params& p, char* lds, int vb, int nvb) {
    MoeOrder S; S.unit_tab = p.unit_up; S.tile_row0 = p.tile_row0; S.tile_nrows = p.tile_nrows; S.A = (const char*)p.h2; S.B = (const char*)p.wb_up;
    S.nunits = __builtin_amdgcn_readfirstlane(p.ntiles[0]) * 16; S.rows_per_e = 2 * DFF; S.gather = 1; S.G = nvb; S.c = vb;
    EpiUp E; E.b_up = p.b_up; E.act = p.act;
    g8::gemm_phase8<true, true>(lds, D, p.row_tok, S, E);
}
struct EpiDown {
    const float *b_down, *row_gate; const int* row_dst; bf16_t* y;
    __device__ __forceinline__ bool operator()(f32x4 (&acc)[2][2][4][2], const g8::Unit& u, int wr, int wc, int fr, int fq) const {
        f32x4 bb[2][2]; float gt[2][4]; int ds[2][4];
#pragma unroll
        for (int bj = 0; bj < 2; ++bj) { const float* bp = b_down + (size_t)u.e * D + u.pn * 256 + bj * 128 + wc * 32 + fq * 8; bb[bj][0] = *(const f32x4*)bp; bb[bj][1] = *(const f32x4*)(bp + 4); }
#pragma unroll
        for (int ai = 0; ai < 2; ++ai)
#pragma unroll
            for (int m = 0; m < 4; ++m) { int r = ai * 128 + wr * 64 + m * 16 + fr; r = r < u.nv ? r : u.nv - 1; gt[ai][m] = row_gate[u.row0 + r]; ds[ai][m] = row_dst[u.row0 + r]; }
#pragma unroll
        for (int ai = 0; ai < 2; ++ai)
#pragma unroll
            for (int m = 0; m < 4; ++m) {
                const int r = ai * 128 + wr * 64 + m * 16 + fr;
                if (r < u.nv) {
                    const float gate = gt[ai][m];
                    bf16_t* yp = y + (size_t)ds[ai][m] * D;
#pragma unroll
                    for (int bj = 0; bj < 2; ++bj) {
                        const int c = u.pn * 256 + bj * 128 + wc * 32 + fq * 8;
                        const f32x4 v0 = (acc[ai][bj][m][0] + bb[bj][0]) * gate, v1 = (acc[ai][bj][m][1] + bb[bj][1]) * gate;
                        u32x4 w; w.x = cvt_pk_bf16(v0[0], v0[1]); w.y = cvt_pk_bf16(v0[2], v0[3]); w.z = cvt_pk_bf16(v1[0], v1[1]); w.w = cvt_pk_bf16(v1[2], v1[3]);
                        *(u32x4*)(yp + c) = w;
                    }
                }
            }
        return false;
    }
};
__device__ __forceinline__ void phase_moe_down8(const Params& p, char* lds, int vb, int nvb) {
    MoeOrder S; S.unit_tab = p.unit_down; S.tile_row0 = p.tile_row0; S.tile_nrows = p.tile_nrows; S.A = (const char*)p.act; S.B = (const char*)p.wb_down;
    S.nunits = __builtin_amdgcn_readfirstlane(p.ntiles[0]) * 8; S.rows_per_e = D; S.gather = 0; S.G = nvb; S.c = vb;
    EpiDown E; E.b_down = p.b_down; E.row_gate = p.row_gate; E.row_dst = p.row_dst; E.y = p.y;
    g8::gemm_phase8<false, true>(lds, DFF, nullptr, S, E);
}

__device__ __forceinline__ void phase_attn_naive(const Params& p, char* lds, int vb, int nvb) {
    float* cs = (float*)lds;
    float* wtot = cs + 2048;
    float* qs = wtot + 64;
    const int tid = tid_opaque(), wid = tid >> 6, lane = tid & 63;
    for (int u = vb; u < 512; u += nvb) {
        const int qb = 15 - (u >> 5), bh = u & 31, b = bh >> 3, hh = bh & 7;
        const int nkeys = (qb + 1) * 128;
        __syncthreads();
        {
            float v[4];
#pragma unroll
            for (int j = 0; j < 4; ++j) { const int s = tid * 4 + j; v[j] = s < nkeys ? p.ls[((size_t)b * S + s) * 8 + hh] : 0.f; }
            v[1] += v[0]; v[2] += v[1]; v[3] += v[2];
            float incl = v[3];
#pragma unroll
            for (int o = 1; o < 64; o <<= 1) { const float t = __shfl_up(incl, o); if (lane >= o) incl += t; }
            if (lane == 63) wtot[wid] = incl;
            __syncthreads();
            float base = incl - v[3];
            for (int w = 0; w < wid; ++w) base += wtot[w];
#pragma unroll
            for (int j = 0; j < 4; ++j) cs[tid * 4 + j] = base + v[j];
            __syncthreads();
        }
        float* myq = qs + wid * 128;
        for (int rr = 0; rr < 16; ++rr) {
            const int t = qb * 128 + wid * 16 + rr;
            const size_t qoff = ((size_t)b * S + t) * AW + hh * 128;
            { const unsigned qq = *(const unsigned*)(p.q + qoff + lane * 2); myq[lane * 2] = bf_lo(qq) * 0.08838834764831845f; myq[lane * 2 + 1] = bf_hi(qq) * 0.08838834764831845f; }
            __builtin_amdgcn_wave_barrier();
            const float ct = cs[t];
            float mrun = -INFINITY, lrun = 0.f, o0 = 0.f, o1 = 0.f;
            for (int s0 = 0; s0 <= t; s0 += 64) {
                const int s = s0 + lane; const bool valid = s <= t; const int sl = valid ? s : t;
                const bf16_t* kp = p.k + ((size_t)b * S + sl) * AW + hh * 128;
                float acc = 0.f;
#pragma unroll
                for (int c = 0; c < 16; ++c) {
                    const u32x4 kk = *(const u32x4*)(kp + c * 8);
                    const f32x4 qa = *(const f32x4*)(myq + c * 8), qb4 = *(const f32x4*)(myq + c * 8 + 4);
                    acc += bf_lo(kk.x) * qa[0] + bf_hi(kk.x) * qa[1] + bf_lo(kk.y) * qa[2] + bf_hi(kk.y) * qa[3]
                         + bf_lo(kk.z) * qb4[0] + bf_hi(kk.z) * qb4[1] + bf_lo(kk.w) * qb4[2] + bf_hi(kk.w) * qb4[3];
                }
                const float sc = valid ? acc + (ct - cs[sl]) : -INFINITY;
                const float mnew = fmaxf(mrun, wave_max(sc));
                const float alpha = __expf(mrun - mnew);
                const float pj = valid ? __expf(sc - mnew) : 0.f;
                lrun = lrun * alpha + wave_sum(pj);
                o0 *= alpha; o1 *= alpha;
                const int nj = min(64, t - s0 + 1);
                const bf16_t* vp = p.v + ((size_t)b * S + s0) * AW + hh * 128 + lane * 2;
                for (int j = 0; j < nj; ++j) {
                    const float pjj = __shfl(pj, j);
                    const unsigned vv = *(const unsigned*)(vp + (size_t)j * AW);
                    o0 += pjj * bf_lo(vv); o1 += pjj * bf_hi(vv);
                }
                mrun = mnew;
            }
            const float inv = 1.0f / lrun;
            *(unsigned*)(p.attn + qoff + lane * 2) = cvt_pk_bf16(o0 * inv, o1 * inv);
            __builtin_amdgcn_wave_barrier();
        }
    }
    __syncthreads();
}

template <int KS> __device__ __forceinline__ int lds_byte_t(int r, int c) { const int st = (r >> 4) * KS + (c >> 5), ob = (r & 15) * 64 + (c & 31) * 2; return st * 1024 + (ob ^ (((ob >> 9) & 1) << 5)); }

__device__ __forceinline__ void attn_block(const Params& p, char* stg, const float* cs, int b, int hh, int qb) {
    const int tid = tid_opaque(), wid = tid >> 6, lane = tid & 63, fr = lane & 15, fq = lane >> 4, w = wid & 3, kh = wid >> 2;
    const int q0 = qb * 128;
    const float sc2 = 0.08838834764831845f * 1.4426950408889634f;
    const size_t tokb = (size_t)b * S;
    bf16x8 Qf[2][4];
#pragma unroll
    for (int qg = 0; qg < 2; ++qg)
#pragma unroll
        for (int ks = 0; ks < 4; ++ks) Qf[qg][ks] = *(const bf16x8*)(p.q + (tokb + q0 + 32 * w + 16 * qg + fr) * AW + hh * 128 + ks * 32 + fq * 8);
    f32x4 O[2][8];
#pragma unroll
    for (int qg = 0; qg < 2; ++qg)
#pragma unroll
        for (int dt = 0; dt < 8; ++dt) O[qg][dt] = (f32x4){0.f, 0.f, 0.f, 0.f};
    float mrun[2] = {-1e30f, -1e30f}, lrun[2] = {0.f, 0.f};
    const int kR = (wid >> 2) * 16 + (lane >> 2), kC = (wid & 3) * 32 + (((lane & 3) ^ ((lane >> 5) << 1)) << 3);
    const bf16_t* kg = p.k + (tokb + kR) * AW + hh * 128 + kC;
    const int vq4 = (lane & 7) | ((wid >> 1) << 3), vd8 = ((lane >> 3) & 7) | ((wid & 1) << 3);
    const bf16_t* vg = p.v + (tokb + 4 * vq4) * AW + hh * 128 + vd8 * 8;
    const int vq4p = vq4 & 15, vq4pp = vq4p & 7;
    const int vcol = (vq4p >> 3) * 32 + 8 * (vq4pp & 3) + 4 * (vq4pp >> 2);
    const int vwoff = 32768 + (vq4 >> 4) * 16384 + ((vd8 >> 1) * 2 + (vcol >> 5)) * 1024 + ((((vd8 & 1) * 512) + (vcol & 31) * 2) ^ ((vd8 & 1) << 5));
    u32x4 kreg[4], vreg[4];
#define AT_ISSUE(j) do { _Pragma("unroll") for (int i = 0; i < 4; ++i) kreg[i] = *(const u32x4*)(kg + (size_t)((j) * 128 + 32 * i) * AW); \
        _Pragma("unroll") for (int r = 0; r < 4; ++r) vreg[r] = *(const u32x4*)(vg + (size_t)((j) * 128 + r) * AW); } while (0)
#define AT_WRITE(sidx) do { char* st_ = stg + (sidx) * 65536; \
        _Pragma("unroll") for (int i = 0; i < 4; ++i) *(u32x4*)(st_ + (i * 512 + tid) * 16) = kreg[i]; \
        _Pragma("unroll") for (int dd = 0; dd < 8; ++dd) { u32x2 w_; const unsigned sel_ = (dd & 1) ? 0x07060302u : 0x05040100u; \
            w_.x = __builtin_amdgcn_perm(vreg[1][dd >> 1], vreg[0][dd >> 1], sel_); w_.y = __builtin_amdgcn_perm(vreg[3][dd >> 1], vreg[2][dd >> 1], sel_); \
            *(u32x2*)(st_ + vwoff + dd * 64) = w_; } } while (0)
    AT_ISSUE(0); AT_WRITE(0);
#pragma unroll
    for (int qg = 0; qg < 2; ++qg)
#pragma unroll
        for (int ks = 0; ks < 4; ++ks) asm volatile("" :: "v"(Qf[qg][ks]));
    __syncthreads();
    for (int j = 0; j <= qb; ++j) {
        const int cur = j & 1;
        if (j < qb) AT_ISSUE(j + 1);
        const bool diag = (j == qb);
        const bool skip = diag && (kh * 64 > 32 * w + 31);
        if (!skip) {
            const char* st_ = stg + cur * 65536;
            f32x4 Sx[4][2];
#pragma unroll
            for (int kt = 0; kt < 4; ++kt) { Sx[kt][0] = (f32x4){0.f, 0.f, 0.f, 0.f}; Sx[kt][1] = (f32x4){0.f, 0.f, 0.f, 0.f}; }
#pragma unroll
            for (int ks = 0; ks < 4; ++ks)
#pragma unroll
                for (int kt = 0; kt < 4; ++kt) {
                    const bf16x8 Kf = *(const bf16x8*)(st_ + lds_byte_t<4>(kh * 64 + kt * 16 + fr, ks * 32 + fq * 8));
                    Sx[kt][0] = __builtin_amdgcn_mfma_f32_16x16x32_bf16(Kf, Qf[0][ks], Sx[kt][0], 0, 0, 0);
                    Sx[kt][1] = __builtin_amdgcn_mfma_f32_16x16x32_bf16(Kf, Qf[1][ks], Sx[kt][1], 0, 0, 0);
                }
            const int keyb = j * 128 + kh * 64 + 4 * fq;
            const bool mask = diag && (kh * 64 + 63 > 32 * w);
#pragma unroll
            for (int kt = 0; kt < 4; ++kt) {
                const f32x4 cb = *(const f32x4*)(cs + keyb + kt * 16);
#pragma unroll
                for (int qg = 0; qg < 2; ++qg) {
                    const int qi = q0 + 32 * w + 16 * qg + fr;
#pragma unroll
                    for (int r = 0; r < 4; ++r) {
                        float v = Sx[kt][qg][r] * sc2 - cb[r];
                        if (mask && (keyb + kt * 16 + r > qi)) v = -INFINITY;
                        Sx[kt][qg][r] = v;
                    }
                }
            }
#pragma unroll
            for (int qg = 0; qg < 2; ++qg) {
                float mx = -INFINITY;
#pragma unroll
                for (int kt = 0; kt < 4; ++kt) mx = fmaxf(mx, fmaxf(fmaxf(Sx[kt][qg][0], Sx[kt][qg][1]), fmaxf(Sx[kt][qg][2], Sx[kt][qg][3])));
                mx = fmaxf(mx, __shfl_xor(mx, 16)); mx = fmaxf(mx, __shfl_xor(mx, 32));
                const float mnew = fmaxf(mrun[qg], mx);
                const float alpha = __builtin_amdgcn_exp2f(mrun[qg] - mnew);
                mrun[qg] = mnew;
                float ls = 0.f;
#pragma unroll
                for (int kt = 0; kt < 4; ++kt)
#pragma unroll
                    for (int r = 0; r < 4; ++r) { const float pv = __builtin_amdgcn_exp2f(Sx[kt][qg][r] - mnew); ls += pv; Sx[kt][qg][r] = pv; }
                lrun[qg] = lrun[qg] * alpha + ls;
#pragma unroll
                for (int dt = 0; dt < 8; ++dt) O[qg][dt] *= alpha;
            }
#pragma unroll
            for (int ks2 = 0; ks2 < 2; ++ks2) {
                bf16x8 Pf[2];
#pragma unroll
                for (int qg = 0; qg < 2; ++qg) {
                    u32x4 pw; pw.x = cvt_pk_bf16_mfma(Sx[2 * ks2][qg][0], Sx[2 * ks2][qg][1]); pw.y = cvt_pk_bf16_mfma(Sx[2 * ks2][qg][2], Sx[2 * ks2][qg][3]);
                    pw.z = cvt_pk_bf16_mfma(Sx[2 * ks2 + 1][qg][0], Sx[2 * ks2 + 1][qg][1]); pw.w = cvt_pk_bf16_mfma(Sx[2 * ks2 + 1][qg][2], Sx[2 * ks2 + 1][qg][3]);
                    Pf[qg] = __builtin_bit_cast(bf16x8, pw);
                }
#pragma unroll
                for (int dt = 0; dt < 8; ++dt) {
                    const bf16x8 Vf = *(const bf16x8*)(st_ + 32768 + kh * 16384 + lds_byte_t<2>(dt * 16 + fr, ks2 * 32 + fq * 8));
                    O[0][dt] = __builtin_amdgcn_mfma_f32_16x16x32_bf16(Vf, Pf[0], O[0][dt], 0, 0, 0);
                    O[1][dt] = __builtin_amdgcn_mfma_f32_16x16x32_bf16(Vf, Pf[1], O[1][dt], 0, 0, 0);
                }
            }
        }
        if (j < qb) AT_WRITE(cur ^ 1);
        __syncthreads();
    }
#undef AT_ISSUE
#undef AT_WRITE
#pragma unroll
    for (int qg = 0; qg < 2; ++qg) { lrun[qg] += __shfl_xor(lrun[qg], 16); lrun[qg] += __shfl_xor(lrun[qg], 32); }
    f32x4* ob = (f32x4*)(stg + w * 16384);
    float* mlb = (float*)(stg + 65536 + w * 1024);
    if (kh == 1) {
#pragma unroll
        for (int qg = 0; qg < 2; ++qg) {
            mlb[(qg * 2 + 0) * 64 + lane] = mrun[qg]; mlb[(qg * 2 + 1) * 64 + lane] = lrun[qg];
#pragma unroll
            for (int dt = 0; dt < 8; ++dt) ob[(qg * 8 + dt) * 64 + lane] = O[qg][dt];
        }
    }
    __syncthreads();
    if (kh == 0) {
#pragma unroll
        for (int qg = 0; qg < 2; ++qg) {
            const float m2 = mlb[(qg * 2 + 0) * 64 + lane], l2 = mlb[(qg * 2 + 1) * 64 + lane];
            const float mt = fmaxf(mrun[qg], m2);
            const float e1 = __builtin_amdgcn_exp2f(mrun[qg] - mt), e2 = __builtin_amdgcn_exp2f(m2 - mt);
            const float inv = 1.0f / (lrun[qg] * e1 + l2 * e2);
            const float f1 = e1 * inv, f2 = e2 * inv;
            bf16_t* orow = p.attn + (tokb + q0 + 32 * w + 16 * qg + fr) * AW + hh * 128 + 4 * fq;
#pragma unroll
            for (int dt = 0; dt < 8; ++dt) {
                const f32x4 o2 = ob[(qg * 8 + dt) * 64 + lane];
                const f32x4 o = O[qg][dt] * f1 + o2 * f2;
                u32x2 ww; ww.x = cvt_pk_bf16(o[0], o[1]); ww.y = cvt_pk_bf16(o[2], o[3]);
                *(u32x2*)(orow + dt * 16) = ww;
            }
        }
    }
    __syncthreads();
}

__device__ __forceinline__ void phase_attn(const Params& p, char* lds, int vb, int nvb) {
    float* cs = (float*)lds;
    float* wtot = (float*)(lds + 8192);
    char* stg = lds + 8192 + 256;
    for (int u = vb; u < 256; u += nvb) {
        const int bh = u & 31, b = bh >> 3, hh = bh & 7, x = u >> 5;
        const int nkeys = (16 - x) * 128;
        {
            const int tid = tid_opaque(), wid = tid >> 6, lane = tid & 63;
            float v[4];
#pragma unroll
            for (int j = 0; j < 4; ++j) { const int s = tid * 4 + j; v[j] = s < nkeys ? p.ls[((size_t)b * S + s) * 8 + hh] : 0.f; }
            v[1] += v[0]; v[2] += v[1]; v[3] += v[2];
            float incl = v[3];
#pragma unroll
            for (int o = 1; o < 64; o <<= 1) { const float t = __shfl_up(incl, o); if (lane >= o) incl += t; }
            if (lane == 63) wtot[wid] = incl;
            __syncthreads();
            float base = incl - v[3];
            for (int ww = 0; ww < wid; ++ww) base += wtot[ww];
#pragma unroll
            for (int j = 0; j < 4; ++j) cs[tid * 4 + j] = (base + v[j]) * 1.4426950408889634f;
            __syncthreads();
        }
        attn_block(p, stg, cs, b, hh, 15 - x);
        attn_block(p, stg, cs, b, hh, x);
    }
}

__device__ __forceinline__ void phase_gmlp_naive(const Params& p, char* lds, int vb, int nvb) {
    float* vn = (float*)lds;
    float* st = vn + 128 * 128;
    const int tid = tid_opaque(), wid = tid >> 6, lane = tid & 63;
    for (int u = vb; u < 512; u += nvb) {
        const int g = u & 7, bc = u >> 3;
        const size_t tok0 = (size_t)bc * 128;
        __syncthreads();
        for (int rr = 0; rr < 16; ++rr) {
            const int s = wid * 16 + rr;
            const bf16_t* vp = p.zg + (tok0 + s) * 2048 + 1024 + lane * 16;
            const u32x4 a = *(const u32x4*)vp, b = *(const u32x4*)(vp + 8);
            float sum = 0.f, sq = 0.f;
            const unsigned ww[8] = {a.x, a.y, a.z, a.w, b.x, b.y, b.z, b.w};
#pragma unroll
            for (int j = 0; j < 8; ++j) { const float lo = bf_lo(ww[j]), hi = bf_hi(ww[j]); sum += lo + hi; sq += lo * lo + hi * hi; }
            sum = wave_sum(sum); sq = wave_sum(sq);
            const float mean = sum * (1.0f / 1024.f); const float var = fmaxf(sq * (1.0f / 1024.f) - mean * mean, 0.f);
            if (lane == 0) { st[s * 2] = mean; st[s * 2 + 1] = rsqrtf(var + 1e-5f); }
        }
        __syncthreads();
        for (int idx = tid; idx < 128 * 16; idx += NTHREADS) {
            const int s = idx >> 4, dc = idx & 15;
            const u32x4 a = *(const u32x4*)(p.zg + (tok0 + s) * 2048 + 1024 + g * 128 + dc * 8);
            const float mean = st[s * 2], rstd = st[s * 2 + 1];
            const unsigned ww[4] = {a.x, a.y, a.z, a.w};
#pragma unroll
            for (int j = 0; j < 4; ++j) {
                const int c = g * 128 + dc * 8 + j * 2;
                vn[s * 128 + dc * 8 + j * 2]     = (bf_lo(ww[j]) - mean) * rstd * p.g_v_ln[c]     + p.b_v_ln[c];
                vn[s * 128 + dc * 8 + j * 2 + 1] = (bf_hi(ww[j]) - mean) * rstd * p.g_v_ln[c + 1] + p.b_v_ln[c + 1];
            }
        }
        __syncthreads();
        for (int rr = 0; rr < 16; ++rr) {
            const int t = wid * 16 + rr;
            const float* wrow = p.w_spatial + ((size_t)g * 128 + t) * 128;
            float a0 = 0.f, a1 = 0.f;
            for (int s = 0; s <= t; ++s) { const float w = wrow[s]; a0 += w * vn[s * 128 + lane]; a1 += w * vn[s * 128 + lane + 64]; }
            const float bs = p.b_spatial[g * 128 + t];
            const bf16_t* up = p.zg + (tok0 + t) * 2048 + g * 128;
            const float u0 = __uint_as_float((unsigned)up[lane] << 16), u1 = __uint_as_float((unsigned)up[lane + 64] << 16);
            bf16_t* op = p.sg + (tok0 + t) * GW + g * 128;
            op[lane] = (bf16_t)(cvt_pk_bf16(u0 * (a0 + bs), 0.f) & 0xffffu);
            op[lane + 64] = (bf16_t)(cvt_pk_bf16(u1 * (a1 + bs), 0.f) & 0xffffu);
        }
    }
    __syncthreads();
}

__device__ __forceinline__ void phase_gmlp(const Params& p, char* lds, int vb, int nvb) {
    float* st = (float*)lds;
    char* wimg = lds + 1024;
    char* vimg = lds + 1024 + 32768;
    const int tid = tid_opaque(), wid = tid >> 6, lane = tid & 63, fr = lane & 15, fq = lane >> 4;
    for (int u = vb; u < 512; u += nvb) {
        const int g = u & 7, bc = u >> 3;
        const size_t tok0 = (size_t)bc * 128;
        __syncthreads();
        if (tid < 128) {
            const float* pp = p.lnpart + (tok0 + tid) * 32;
            float sum = 0.f, sq = 0.f;
#pragma unroll
            for (int k = 0; k < 8; ++k) { const f32x4 t4 = *(const f32x4*)(pp + k * 4); sum += t4[0] + t4[2]; sq += t4[1] + t4[3]; }
            const float mean = sum * (1.0f / 1024.f); const float var = fmaxf(sq * (1.0f / 1024.f) - mean * mean, 0.f);
            st[tid * 2] = mean; st[tid * 2 + 1] = rsqrtf(var + 1e-5f);
        }
#pragma unroll
        for (int i = 0; i < 4; ++i) {
            const int q = tid + 512 * i, t = q >> 4, sc = q & 15;
            const float* wp = p.w_spatial + ((size_t)g * 128 + t) * 128 + sc * 8;
            const f32x4 w0 = *(const f32x4*)wp, w1 = *(const f32x4*)(wp + 4);
            float wv[8] = {w0[0], w0[1], w0[2], w0[3], w1[0], w1[1], w1[2], w1[3]};
#pragma unroll
            for (int j = 0; j < 8; ++j) wv[j] = (sc * 8 + j <= t) ? wv[j] : 0.f;
            u32x4 pk; pk.x = cvt_pk_bf16(wv[0], wv[1]); pk.y = cvt_pk_bf16(wv[2], wv[3]); pk.z = cvt_pk_bf16(wv[4], wv[5]); pk.w = cvt_pk_bf16(wv[6], wv[7]);
            *(u32x4*)(wimg + lds_byte_t<4>(t, sc * 8)) = pk;
        }
        __syncthreads();
        {
            const int vq4 = tid >> 4, vd8 = tid & 15;
            float vals[4][8];
            const f32x4 lg0 = *(const f32x4*)(p.g_v_ln + g * 128 + vd8 * 8), lg1 = *(const f32x4*)(p.g_v_ln + g * 128 + vd8 * 8 + 4);
            const f32x4 lb0 = *(const f32x4*)(p.b_v_ln + g * 128 + vd8 * 8), lb1 = *(const f32x4*)(p.b_v_ln + g * 128 + vd8 * 8 + 4);
            const float lgv[8] = {lg0[0], lg0[1], lg0[2], lg0[3], lg1[0], lg1[1], lg1[2], lg1[3]}, lbv[8] = {lb0[0], lb0[1], lb0[2], lb0[3], lb1[0], lb1[1], lb1[2], lb1[3]};
#pragma unroll
            for (int r = 0; r < 4; ++r) {
                const int s = 4 * vq4 + r;
                const u32x4 a = *(const u32x4*)(p.zg + (tok0 + s) * 2048 + 1024 + g * 128 + vd8 * 8);
                const float mean = st[s * 2], rstd = st[s * 2 + 1];
                const unsigned ww[4] = {a.x, a.y, a.z, a.w};
#pragma unroll
                for (int j = 0; j < 4; ++j) {
                    vals[r][2 * j] = (bf_lo(ww[j]) - mean) * rstd * lgv[2 * j] + lbv[2 * j];
                    vals[r][2 * j + 1] = (bf_hi(ww[j]) - mean) * rstd * lgv[2 * j + 1] + lbv[2 * j + 1];
                }
            }
#pragma unroll
            for (int dd = 0; dd < 8; ++dd) {
                u32x2 w_; w_.x = cvt_pk_bf16(vals[0][dd], vals[1][dd]); w_.y = cvt_pk_bf16(vals[2][dd], vals[3][dd]);
                *(u32x2*)(vimg + lds_byte_t<4>(vd8 * 8 + dd, 4 * vq4)) = w_;
            }
        }
        __syncthreads();
        f32x4 acc[8];
#pragma unroll
        for (int tt = 0; tt < 8; ++tt) acc[tt] = (f32x4){0.f, 0.f, 0.f, 0.f};
#pragma unroll
        for (int ks = 0; ks < 4; ++ks) {
            const bf16x8 Af = *(const bf16x8*)(vimg + lds_byte_t<4>(wid * 16 + fr, ks * 32 + fq * 8));
#pragma unroll
            for (int tt = 0; tt < 8; ++tt) {
                if (2 * ks <= tt) {
                    const bf16x8 Bf = *(const bf16x8*)(wimg + lds_byte_t<4>(tt * 16 + fr, ks * 32 + fq * 8));
                    acc[tt] = __builtin_amdgcn_mfma_f32_16x16x32_bf16(Af, Bf, acc[tt], 0, 0, 0);
                }
            }
        }
        u32x2 uu[8]; float bsv[8];
#pragma unroll
        for (int tt = 0; tt < 8; ++tt) { const int t = tt * 16 + fr; bsv[tt] = p.b_spatial[g * 128 + t]; uu[tt] = *(const u32x2*)(p.zg + (tok0 + t) * 2048 + g * 128 + wid * 16 + fq * 4); }
#pragma unroll
        for (int tt = 0; tt < 8; ++tt) {
            const int t = tt * 16 + fr; const float bs = bsv[tt];
            u32x2 w_; w_.x = cvt_pk_bf16(bf_lo(uu[tt].x) * (acc[tt][0] + bs), bf_hi(uu[tt].x) * (acc[tt][1] + bs)); w_.y = cvt_pk_bf16(bf_lo(uu[tt].y) * (acc[tt][2] + bs), bf_hi(uu[tt].y) * (acc[tt][3] + bs));
            *(u32x2*)(p.sg + (tok0 + t) * GW + g * 128 + wid * 16 + fq * 4) = w_;
        }
    }
    __syncthreads();
}

__device__ __forceinline__ void phase_branch(const Params& p, char* lds, int vb, int nvb) {
    for (int u = vb; u < 32 * 8; u += nvb) {
        const int pm = u >> 3, pn = u & 7;
        gemm_tile<D, false, false>(lds, p.attn, AW, nullptr, pm * 256, 256, p.w_ba + pn * 256, AW,
            [&](const f32x4 (&acc)[8][4], int wr, int wc, int fr, int fq) {
#pragma unroll
                for (int m = 0; m < 8; ++m) {
                    const size_t row = (size_t)pm * 256 + wr * 128 + m * 16 + fr;
#pragma unroll
                    for (int n = 0; n < 4; ++n) {
                        const int c = pn * 256 + wc * 64 + n * 16 + fq * 4;
                        const u32x2 gg = *(const u32x2*)(p.gates + row * 4096 + c);
                        f32x4 v = acc[m][n];
                        v[0] *= bf_lo(gg.x); v[1] *= bf_hi(gg.x); v[2] *= bf_lo(gg.y); v[3] *= bf_hi(gg.y);
                        *(f32x4*)(p.x1 + row * D + c) = v;
                    }
                }
            });
        gemm_tile<D, false, false>(lds, p.sg, GW, nullptr, pm * 256, 256, p.w_bg + pn * 256, GW,
            [&](const f32x4 (&acc)[8][4], int wr, int wc, int fr, int fq) {
#pragma unroll
                for (int m = 0; m < 8; ++m) {
                    const size_t row = (size_t)pm * 256 + wr * 128 + m * 16 + fr;
#pragma unroll
                    for (int n = 0; n < 4; ++n) {
                        const int c = pn * 256 + wc * 64 + n * 16 + fq * 4;
                        const u32x2 gg = *(const u32x2*)(p.gates + row * 4096 + 2048 + c);
                        const f32x4 prev = *(const f32x4*)(p.x1 + row * D + c);
                        f32x4 v = acc[m][n];
                        v[0] = prev[0] + v[0] * bf_lo(gg.x); v[1] = prev[1] + v[1] * bf_hi(gg.x); v[2] = prev[2] + v[2] * bf_lo(gg.y); v[3] = prev[3] + v[3] * bf_hi(gg.y);
                        u32x2 w; w.x = cvt_pk_bf16(v[0], v[1]); w.y = cvt_pk_bf16(v[2], v[3]);
                        *(u32x2*)(p.merged + row * D + c) = w;
                    }
                }
            });
    }
}

__device__ __forceinline__ void phase_outproj(const Params& p, char* lds, int vb, int nvb) {
    for (int u = vb; u < 32 * 8; u += nvb) {
        const int pm = u >> 3, pn = u & 7;
        gemm_tile<D, false, false>(lds, p.merged, D, nullptr, pm * 256, 256, p.w_out + pn * 256, D,
            [&](const f32x4 (&acc)[8][4], int wr, int wc, int fr, int fq) {
#pragma unroll
                for (int m = 0; m < 8; ++m) {
                    const size_t row = (size_t)pm * 256 + wr * 128 + m * 16 + fr;
#pragma unroll
                    for (int n = 0; n < 4; ++n) {
                        const int c = pn * 256 + wc * 64 + n * 16 + fq * 4;
                        const f32x4 xr = *(const f32x4*)(p.x + row * D + c);
                        *(f32x4*)(p.x1 + row * D + c) = xr + acc[m][n];
                    }
                }
            });
    }
}

__device__ __forceinline__ void phase_router(const Params& p, char* lds, int vb, int nvb) {
    constexpr int RS = 4112;
    char* img_hi = lds;
    char* img_lo = lds + 16 * RS;
    float* part = (float*)lds;
    float* logit = (float*)(lds + 32 * RS);
    int* cnt = (int*)(lds + 32 * RS + 16 * 32 * 4);
    const int tid = tid_opaque(), wid = tid >> 6, lane = tid & 63, fr = lane & 15, fq = lane >> 4;
    bf16x8 bh0[8], bl0[8], bh1[8], bl1[8];
#pragma unroll
    for (int ks = 0; ks < 8; ++ks) {
        const int k0 = wid * 256 + ks * 32 + fq * 8;
        bh0[ks] = *(const bf16x8*)(p.wr_hi + (size_t)fr * D + k0); bl0[ks] = *(const bf16x8*)(p.wr_lo + (size_t)fr * D + k0);
        bh1[ks] = *(const bf16x8*)(p.wr_hi + (size_t)(16 + fr) * D + k0); bl1[ks] = *(const bf16x8*)(p.wr_lo + (size_t)(16 + fr) * D + k0);
    }
    for (int c = vb; c < NCHUNK; c += nvb) {
        for (int pass = 0; pass < 2; ++pass) {
            __syncthreads();
#pragma unroll
            for (int i2 = 0; i2 < 2; ++i2) {
                const int tl = 2 * wid + i2, tok = c * 32 + pass * 16 + tl;
                const float* xr = p.x1 + (size_t)tok * D;
                f32x4 xv[8]; float ss = 0.f;
#pragma unroll
                for (int i = 0; i < 8; ++i) { xv[i] = *(const f32x4*)(xr + i * 256 + lane * 4); ss += xv[i][0] * xv[i][0] + xv[i][1] * xv[i][1] + xv[i][2] * xv[i][2] + xv[i][3] * xv[i][3]; }
                ss = wave_sum(ss);
                const float rstd = rsqrtf(ss * (1.0f / D) + 1e-5f);
#pragma unroll
                for (int i = 0; i < 8; ++i) {
                    const f32x4 g = *(const f32x4*)(p.g_ffn + i * 256 + lane * 4);
                    const f32x4 hv = xv[i] * rstd * g;
                    u32x2 hi; hi.x = cvt_pk_bf16(hv[0], hv[1]); hi.y = cvt_pk_bf16(hv[2], hv[3]);
                    *(unsigned*)((unsigned char*)p.h2 + (size_t)tok * D + i * 256 + lane * 4) = pack_fp8x4(hv[0], hv[1], hv[2], hv[3]);
                    u32x2 lo; lo.x = cvt_pk_bf16(hv[0] - bf_lo(hi.x), hv[1] - bf_hi(hi.x)); lo.y = cvt_pk_bf16(hv[2] - bf_lo(hi.y), hv[3] - bf_hi(hi.y));
                    *(u32x2*)(img_hi + tl * RS + (i * 256 + lane * 4) * 2) = hi;
                    *(u32x2*)(img_lo + tl * RS + (i * 256 + lane * 4) * 2) = lo;
                }
            }
            __syncthreads();
            f32x4 acc0 = {0.f, 0.f, 0.f, 0.f}, acc1 = {0.f, 0.f, 0.f, 0.f};
#pragma unroll
            for (int ks = 0; ks < 8; ++ks) {
                const int k0 = wid * 256 + ks * 32 + fq * 8;
                const bf16x8 ah = *(const bf16x8*)(img_hi + fr * RS + k0 * 2), al = *(const bf16x8*)(img_lo + fr * RS + k0 * 2);
                acc0 = __builtin_amdgcn_mfma_f32_16x16x32_bf16(al, bh0[ks], acc0, 0, 0, 0); acc0 = __builtin_amdgcn_mfma_f32_16x16x32_bf16(ah, bl0[ks], acc0, 0, 0, 0); acc0 = __builtin_amdgcn_mfma_f32_16x16x32_bf16(ah, bh0[ks], acc0, 0, 0, 0);
                acc1 = __builtin_amdgcn_mfma_f32_16x16x32_bf16(al, bh1[ks], acc1, 0, 0, 0); acc1 = __builtin_amdgcn_mfma_f32_16x16x32_bf16(ah, bl1[ks], acc1, 0, 0, 0); acc1 = __builtin_amdgcn_mfma_f32_16x16x32_bf16(ah, bh1[ks], acc1, 0, 0, 0);
            }
            __syncthreads();
#pragma unroll
            for (int r = 0; r < 4; ++r) { part[(wid * 16 + 4 * fq + r) * 32 + fr] = acc0[r]; part[(wid * 16 + 4 * fq + r) * 32 + 16 + fr] = acc1[r]; }
            if (pass == 0 && tid < 32) cnt[tid] = 0;
            __syncthreads();
            { const int tk2 = tid >> 5, e = tid & 31; float sacc = p.b_router[e];
#pragma unroll
              for (int ww = 0; ww < 8; ++ww) sacc += part[(ww * 16 + tk2) * 32 + e];
              logit[tk2 * 32 + e] = sacc; }
            __syncthreads();
            {
                const int tl = 2 * wid + (lane >> 5), e = lane & 31, tok = c * 32 + pass * 16 + tl;
                float val = logit[tl * 32 + e];
                float sv[4]; int si[4];
#pragma unroll
                for (int r = 0; r < 4; ++r) {
                    float mx = val;
#pragma unroll
                    for (int o = 16; o; o >>= 1) mx = fmaxf(mx, __shfl_xor(mx, o));
                    const unsigned long long bal = __ballot(val == mx);
                    const unsigned half = (unsigned)(lane >> 5 ? (bal >> 32) : (bal & 0xffffffffull));
                    const int idx = __ffs((int)half) - 1;
                    sv[r] = mx; si[r] = idx;
                    if (e == idx) val = -INFINITY;
                }
                const float e1 = __expf(sv[1] - sv[0]), e2 = __expf(sv[2] - sv[0]), e3 = __expf(sv[3] - sv[0]);
                const float inv = 1.0f / (1.0f + e1 + e2 + e3);
                if (e < 4) {
                    const int myi = e == 0 ? si[0] : e == 1 ? si[1] : e == 2 ? si[2] : si[3];
                    const float myg = (e == 0 ? 1.0f : e == 1 ? e1 : e == 2 ? e2 : e3) * inv;
                    p.top_idx[tok * 4 + e] = myi; p.top_gate[tok * 4 + e] = myg;
                    atomicAdd(&cnt[myi], 1);
                }
            }
        }
        __syncthreads();
        if (tid < 32) p.blk_cnt[c * 32 + tid] = cnt[tid];
    }
    __syncthreads();
}

__device__ __forceinline__ void phase_dispatch(const Params& p, char* lds, int vb, int nvb) {
    int* base = (int*)lds;
    int* tot = base + 32;
    int* start = tot + 32;
    int* tb = start + 32;
    int* red = tb + 64;
    int* idx = red + 16 * 32 * 2;
    const int tid = tid_opaque();
    for (int c = vb; c < NCHUNK; c += nvb) {
        __syncthreads();
        {
            const int e = tid & 31, part = tid >> 5;
            int total = 0, before = 0;
#pragma unroll 4
            for (int k = 0; k < 16; ++k) { const int cc = part * 16 + k; const int v = p.blk_cnt[cc * 32 + e]; total += v; before += (cc < c) ? v : 0; }
            red[(part * 32 + e) * 2] = total; red[(part * 32 + e) * 2 + 1] = before;
        }
        if (tid < 128) idx[tid] = p.top_idx[c * 128 + tid];
        __syncthreads();
        if (tid < 32) {
            int total = 0, before = 0;
#pragma unroll
            for (int k = 0; k < 16; ++k) { total += red[(k * 32 + tid) * 2]; before += red[(k * 32 + tid) * 2 + 1]; }
            int incl = total;
#pragma unroll
            for (int o = 1; o < 32; o <<= 1) { const int t = __shfl_up(incl, o); if (tid >= o) incl += t; }
            const int st = incl - total;
            base[tid] = st + before; tot[tid] = total; start[tid] = st;
        }
        __syncthreads();
        if (c == vb) {
            if (tid == 0) {
                int n = 0;
                for (int e = 0; e < NE; ++e) { tb[e] = n; n += (tot[e] + 255) >> 8; }
                tb[NE] = n; if (vb == 0) p.ntiles[0] = n;
            }
            __syncthreads();
            const int ntl = tb[NE];
            for (int w = vb * NTHREADS + tid; w < ntl * 16; w += (nvb < NCHUNK ? nvb : NCHUNK) * NTHREADS) { int e = 0; while (16 * tb[e + 1] <= w) ++e; const int Te = tb[e + 1] - tb[e], r = w - 16 * tb[e]; const int mt = r % Te, cntv = tot[e]; p.unit_up[2 * w] = (e << 24) | ((r / Te) << 16) | (tb[e] + mt); p.unit_up[2 * w + 1] = (start[e] + mt * 256) | (min(256, cntv - mt * 256) << 16); }
            for (int w = vb * NTHREADS + tid; w < ntl * 8; w += (nvb < NCHUNK ? nvb : NCHUNK) * NTHREADS) { int e = 0; while (8 * tb[e + 1] <= w) ++e; const int Te = tb[e + 1] - tb[e], r = w - 8 * tb[e]; const int mt = r % Te, cntv = tot[e]; p.unit_down[2 * w] = (e << 24) | ((r / Te) << 16) | (tb[e] + mt); p.unit_down[2 * w + 1] = (start[e] + mt * 256) | (min(256, cntv - mt * 256) << 16); }
        }
        if (tid < 128) {
            const int e = idx[tid];
            int rank = 0;
            for (int j = 0; j < tid; ++j) rank += (idx[j] == e) ? 1 : 0;
            const int row = base[e] + rank, a = c * 128 + tid;
            p.row_tok[row] = a >> 2; p.row_dst[row] = a; p.row_gate[row] = p.top_gate[a];
        }
    }
    __syncthreads();
}

__device__ __forceinline__ void phase_moe_up(const Params& p, char* lds, int vb, int nvb) {
    const int nt = p.ntiles[0];
    for (int u = vb; u < nt * 16; u += nvb) {
        const int tile = u >> 4, pn = u & 15;
        const int e = p.tile_e[tile], row0 = p.tile_row0[tile], nv = p.tile_nrows[tile];
        gemm_tile<2 * DFF, true, true>(lds, p.h2, D, p.row_tok, row0, nv, p.w_up + (size_t)e * D * (2 * DFF) + pn * 256, D,
            [&](const f32x4 (&acc)[8][4], int wr, int wc, int fr, int fq) {
#pragma unroll
                for (int m = 0; m < 8; ++m) {
                    const int r = tile_row<true>(wr, m, fr);
                    if (r < nv) {
#pragma unroll
                        for (int n = 0; n < 4; ++n) {
                            const int c = pn * 256 + wc * 64 + n * 16 + fq * 4;
                            const f32x4 bb = *(const f32x4*)(p.b_up + (size_t)e * (2 * DFF) + c);
                            const f32x4 v = acc[m][n] + bb;
                            const float g0 = fminf(v[0], 7.f), l0 = fminf(fmaxf(v[1], -7.f), 7.f);
                            const float g1 = fminf(v[2], 7.f), l1 = fminf(fmaxf(v[3], -7.f), 7.f);
                            const float a0 = g0 * sigmoidf_(1.702f * g0) * (l0 + 1.0f), a1 = g1 * sigmoidf_(1.702f * g1) * (l1 + 1.0f);
                            *(unsigned*)(p.act + (size_t)(row0 + r) * DFF + (c >> 1)) = cvt_pk_bf16(a0, a1);
                        }
                    }
                }
            });
    }
}

__device__ __forceinline__ void phase_moe_down(const Params& p, char* lds, int vb, int nvb) {
    const int nt = p.ntiles[0];
    for (int u = vb; u < nt * 8; u += nvb) {
        const int tile = u >> 3, pn = u & 7;
        const int e = p.tile_e[tile], row0 = p.tile_row0[tile], nv = p.tile_nrows[tile];
        gemm_tile<D, false, true>(lds, p.act, DFF, nullptr, row0, nv, p.w_down + (size_t)e * DFF * D + pn * 256, DFF,
            [&](const f32x4 (&acc)[8][4], int wr, int wc, int fr, int fq) {
#pragma unroll
                for (int m = 0; m < 8; ++m) {
                    const int r = tile_row<true>(wr, m, fr);
                    if (r < nv) {
                        const float gate = p.row_gate[row0 + r];
                        const size_t dst = (size_t)p.row_dst[row0 + r] * D;
#pragma unroll
                        for (int n = 0; n < 4; ++n) {
                            const int c = pn * 256 + wc * 64 + n * 16 + fq * 4;
                            const f32x4 bb = *(const f32x4*)(p.b_down + (size_t)e * D + c);
                            const f32x4 v = (acc[m][n] + bb) * gate;
                            u32x2 w; w.x = cvt_pk_bf16(v[0], v[1]); w.y = cvt_pk_bf16(v[2], v[3]);
                            *(u32x2*)(p.y + dst + c) = w;
                        }
                    }
                }
            });
    }
}

__device__ __forceinline__ void phase_final(const Params& p, char* lds, int vb, int nvb) {
    const int tid = tid_opaque(), wid = tid >> 6, lane = tid & 63;
    for (int tok = vb * 8 + wid; tok < T; tok += nvb * 8) {
        f32x4 xv[8]; float ss = 0.f;
#pragma unroll
        for (int i = 0; i < 8; ++i) {
            f32x4 v = *(const f32x4*)(p.x1 + (size_t)tok * D + i * 256 + lane * 4);
#pragma unroll
            for (int j = 0; j < 4; ++j) {
                const u32x2 yy = *(const u32x2*)(p.y + ((size_t)tok * 4 + j) * D + i * 256 + lane * 4);
                v[0] += bf_lo(yy.x); v[1] += bf_hi(yy.x); v[2] += bf_lo(yy.y); v[3] += bf_hi(yy.y);
            }
            xv[i] = v; ss += v[0] * v[0] + v[1] * v[1] + v[2] * v[2] + v[3] * v[3];
        }
        ss = wave_sum(ss);
        const float rstd = rsqrtf(ss * (1.0f / D) + 1e-5f);
#pragma unroll
        for (int i = 0; i < 8; ++i) {
            const f32x4 g = *(const f32x4*)(p.g_final + i * 256 + lane * 4);
            *(f32x4*)(p.out + (size_t)tok * D + i * 256 + lane * 4) = xv[i] * rstd * g;
        }
    }
}

template <int MODE>
__global__ void __launch_bounds__(NTHREADS, 2) k_fwd(Params p_kernarg) {
    extern __shared__ __attribute__((aligned(1024))) char lds[];
    const Params& p = *(const Params*)__builtin_amdgcn_kernarg_segment_ptr();
    const int vb = blockIdx.x, nvb = gridDim.x;
    XcdBarrier bar;
    if (MODE < 0) {
        volatile LAS unsigned* st = (volatile LAS unsigned*)(lds + LDS_BYTES - 16);
        if (threadIdx.x == 0) { st[0] = 0u; st[1] = 0u; st[2] = 0u; st[3] = 0u; }
        __syncthreads();
        bar = xcd_barrier_post(p.bar, st);
    }
#ifndef PROBE_MASK
#define PROBE_MASK 0
#endif
#define PHASE(i, call) if (MODE < 0 || MODE == (i)) { call; } if (MODE < 0) xcd_barrier(bar); if (MODE < 0 && ((PROBE_MASK >> (i)) & 1)) { call; xcd_barrier(bar); }
    PHASE(0, (phase_prologue(p, lds, vb, nvb), phase_convert_dense(p, lds, vb, nvb)))
    PHASE(1, phase_inproj_conv(p, lds, vb, nvb))
    PHASE(2, (phase_attn(p, lds, vb, nvb), phase_gmlp(p, lds, vb, nvb)))
    PHASE(3, phase_branch8(p, lds, vb, nvb))
    PHASE(4, phase_outproj8(p, lds, vb, nvb))
    PHASE(5, phase_router(p, lds, vb, nvb))
    PHASE(6, phase_dispatch(p, lds, vb, nvb))
    PHASE(7, phase_moe_up8(p, lds, vb, nvb))
    PHASE(8, phase_moe_down8(p, lds, vb, nvb))
    if (MODE < 0 || MODE == 9) phase_final(p, lds, vb, nvb);
}

template <int MODE> static void launch_phase(const Params& p, int grid, hipStream_t stream) {
    static bool attr = false;
    if (!attr) { (void)hipFuncSetAttribute((const void*)k_fwd<MODE>, hipFuncAttributeMaxDynamicSharedMemorySize, LDS_BYTES); attr = true; }
    hipLaunchKernelGGL(k_fwd<MODE>, dim3(grid), dim3(NTHREADS), LDS_BYTES, stream, p);
}

extern "C" void kernel_launch(void* const* d_in, const int* in_sizes, int n_in, void* d_out, int out_size, void* d_ws, size_t ws_size, hipStream_t stream) {
    Params p; memset(&p, 0, sizeof(p));
    const float* const* in = (const float* const*)d_in;
    p.x = in[0]; p.g_mix = in[1]; p.w_in = in[2]; p.b_forget = in[3]; p.g_v_ln = in[4]; p.b_v_ln = in[5]; p.w_spatial = in[6]; p.b_spatial = in[7];
    p.w_ba = in[8]; p.w_bg = in[9]; p.w_out = in[10]; p.g_ffn = in[11]; p.w_router = in[12]; p.b_router = in[13];
    p.w_up = in[14]; p.b_up = in[15]; p.w_down = in[16]; p.b_down = in[17]; p.g_final = in[18];
    p.out = (float*)d_out;
    char* w = (char*)d_ws; size_t off = 0;
    auto take = [&](size_t bytes) { char* r = w + off; off += (bytes + 255) & ~(size_t)255; return r; };
    p.bar = (unsigned*)take(XCD_BAR_WORDS * 4);
    p.h = (bf16_t*)take((size_t)T * D * 2);
    p.q = (bf16_t*)take((size_t)T * AW * 2); p.k = (bf16_t*)take((size_t)T * AW * 2); p.v = (bf16_t*)take((size_t)T * AW * 2);
    p.zg = (bf16_t*)take((size_t)T * 2048 * 2); p.gates = (bf16_t*)take((size_t)T * 4096 * 2);
    p.attn = (bf16_t*)take((size_t)T * AW * 2); p.sg = (bf16_t*)take((size_t)T * GW * 2);
    p.merged = (bf16_t*)take((size_t)T * D * 2); p.h2 = (bf16_t*)take((size_t)T * D * 2);
    p.h8 = (unsigned char*)take((size_t)T * D); p.wb_in8 = (unsigned char*)take((size_t)9216 * D);
    p.wr_hi = (bf16_t*)take((size_t)NE * D * 2); p.wr_lo = (bf16_t*)take((size_t)NE * D * 2);
    p.act = (bf16_t*)take((size_t)T * 4 * DFF * 2); p.y = (bf16_t*)take((size_t)T * 4 * D * 2);
    p.wb_in = (bf16_t*)take((size_t)9216 * D * 2); p.wb_ba = (bf16_t*)take((size_t)D * AW * 2); p.wb_bg = (bf16_t*)take((size_t)D * GW * 2); p.wb_out = (bf16_t*)take((size_t)D * D * 2);
    p.wb_up = (bf16_t*)take((size_t)NE * 2 * DFF * D * 2); p.wb_down = (bf16_t*)take((size_t)NE * D * DFF * 2);
    p.ls = (float*)take((size_t)T * 8 * 4); p.lnpart = (float*)take((size_t)T * 16 * 2 * 4); p.x1 = (float*)take((size_t)T * D * 4);
    p.top_gate = (float*)take((size_t)T * 4 * 4); p.row_gate = (float*)take((size_t)T * 4 * 4);
    p.top_idx = (int*)take((size_t)T * 4 * 4); p.blk_cnt = (int*)take((size_t)NCHUNK * 32 * 4);
    p.row_tok = (int*)take((size_t)T * 4 * 4); p.row_dst = (int*)take((size_t)T * 4 * 4);
    p.tile_e = (int*)take(MAXTILES * 4); p.tile_row0 = (int*)take(MAXTILES * 4); p.tile_nrows = (int*)take(MAXTILES * 4); p.ntiles = (int*)take(256); p.unit_up = (int*)take(MAXTILES * 16 * 8); p.unit_down = (int*)take(MAXTILES * 8 * 8);
#if MK_SINGLE
    static int grid = 0;
    if (!grid) {
        int dev = 0, cus = 0, per_cu = 0;
        (void)hipGetDevice(&dev);
        (void)hipDeviceGetAttribute(&cus, hipDeviceAttributeMultiprocessorCount, dev);
        (void)hipFuncSetAttribute((const void*)k_fwd<-1>, hipFuncAttributeMaxDynamicSharedMemorySize, LDS_BYTES);
        (void)hipOccupancyMaxActiveBlocksPerMultiprocessor(&per_cu, k_fwd<-1>, NTHREADS, LDS_BYTES);
        if (cus <= 0) cus = 256;
        grid = cus * (per_cu < 1 ? 1 : 1);
    }
    (void)hipMemsetAsync(p.bar, 0, XCD_BAR_WORDS * 4, stream);
    launch_phase<-1>(p, grid, stream);
#else
    launch_phase<0>(p, 256, stream); launch_phase<1>(p, 256, stream); launch_phase<2>(p, 256, stream); launch_phase<3>(p, 256, stream);
    launch_phase<4>(p, 256, stream); launch_phase<5>(p, 256, stream); launch_phase<6>(p, 256, stream); launch_phase<7>(p, 256, stream);
    launch_phase<8>(p, 256, stream); launch_phase<9>(p, 256, stream);
#endif
}
```

```cpp
#include <hip/hip_runtime.h>
#include <stdint.h>
#include <string.h>
#include <stdio.h>

#ifndef MK_SINGLE
#define MK_SINGLE 1
#endif

typedef unsigned short bf16_t;
typedef short bf16x8 __attribute__((ext_vector_type(8)));
typedef float f32x4 __attribute__((ext_vector_type(4)));
typedef float f32x2 __attribute__((ext_vector_type(2)));
typedef unsigned u32x4 __attribute__((ext_vector_type(4)));
typedef unsigned u32x2 __attribute__((ext_vector_type(2)));
typedef int i32x4 __attribute__((ext_vector_type(4)));
typedef int i32x8 __attribute__((ext_vector_type(8)));

constexpr int D = 2048, NB = 4, S = 2048, T = NB * S, H = 8, DH = 128, AW = 1024, GW = 1024, PW = 9224, NE = 32, DFF = 2048;
constexpr int PN_SPLIT = 20;
constexpr int NCHUNK = 256;
constexpr int MAXTILES = 192;
constexpr int NTHREADS = 512;
constexpr int LDS_BYTES = 144 * 1024;

#define XB_TMO      128
#define XB_XCNT(j)  (256  + 64 * (j))
#define XB_XSUB(j)  (1280 + 64 * (j))
#define XB_XGEN(j)  (2304 + 64 * (j))
#define XB_TOP      3328
#define XB_TOPGEN   3392
#define XCD_BAR_WORDS 3456
#define XB_SPIN_CAP (1u << 22)
#define LAS __attribute__((address_space(3)))

__device__ __forceinline__ unsigned xb_ld(unsigned* p)              { return __hip_atomic_load(p, __ATOMIC_RELAXED, __HIP_MEMORY_SCOPE_AGENT); }
__device__ __forceinline__ unsigned xb_add(unsigned* p, unsigned v) { return __hip_atomic_fetch_add(p, v, __ATOMIC_RELAXED, __HIP_MEMORY_SCOPE_AGENT); }
__device__ __forceinline__ unsigned xb_xcc_id() { return (unsigned)__builtin_amdgcn_s_getreg((3 << 11) | 20) & 0xFu; }
#define XB_SPIN(cond, bar) do { unsigned _sp = 0; while (cond) { __builtin_amdgcn_s_sleep(1); \
    if ((++_sp & 255u) == 0u) { if (xb_ld(&(bar)[XB_TMO])) break; if (_sp > XB_SPIN_CAP) { atomicAdd(&(bar)[XB_TMO], 1u); break; } } } } while (0)

struct XcdBarrier { unsigned* bar; unsigned x; volatile LAS unsigned* st; };

__device__ __forceinline__ XcdBarrier xcd_barrier_post(unsigned* bar, volatile LAS unsigned* st) {
    XcdBarrier b; b.bar = bar; b.x = xb_xcc_id(); b.st = st;
    if (threadIdx.x == 0) (void)xb_add(&bar[XB_XCNT(b.x)], 1u);
    return b;
}
__device__ __forceinline__ void xcd_barrier_complete(unsigned* bar, unsigned x, unsigned& nloc, unsigned& nx) {
    const unsigned G = gridDim.x * gridDim.y * gridDim.z;
    unsigned sum, cnt, mine, sp = 0u;
    for (;;) {
        sum = 0u; cnt = 0u; mine = 0u;
#pragma unroll
        for (unsigned j = 0; j < 16; ++j) { const unsigned c = xb_ld(&bar[XB_XCNT(j)]); sum += c; cnt += (c > 0u) ? 1u : 0u; mine = (j == x) ? c : mine; }
        if (sum == G) break;
        __builtin_amdgcn_s_sleep(1);
        if ((++sp & 255u) == 0u) { if (xb_ld(&bar[XB_TMO])) break; if (sp > XB_SPIN_CAP) { atomicAdd(&bar[XB_TMO], 1u); break; } }
    }
    nloc = mine > 0u ? mine : 1u; nx = cnt > 0u ? cnt : 1u;
}
__device__ __forceinline__ void xcd_barrier(const XcdBarrier& b) {
    asm volatile("s_waitcnt vmcnt(0)" ::: "memory");
    __syncthreads();
    if (threadIdx.x == 0) {
        unsigned* bar = b.bar;
        __builtin_amdgcn_s_waitcnt(0);
        unsigned nloc = b.st[0], nx = b.st[1];
        if (nloc == 0u) { xcd_barrier_complete(bar, b.x, nloc, nx); b.st[0] = nloc; b.st[1] = nx; }
        const unsigned old = xb_add(&bar[XB_XSUB(b.x)], 1u);
        const unsigned gen = old / nloc;
        if (old + 1u == (gen + 1u) * nloc) {
            __builtin_amdgcn_fence(__ATOMIC_RELEASE, "agent");
            asm volatile("s_waitcnt vmcnt(0)" ::: "memory");
            const unsigned og = xb_add(&bar[XB_TOP], 1u);
            const unsigned tg = og / nx;
            if (og + 1u == (tg + 1u) * nx) xb_add(&bar[XB_TOPGEN], 1u);
            else XB_SPIN(xb_ld(&bar[XB_TOPGEN]) == tg, bar);
            __builtin_amdgcn_fence(__ATOMIC_ACQUIRE, "agent");
            xb_add(&bar[XB_XGEN(b.x)], 1u);
            asm volatile("s_waitcnt vmcnt(0)" ::: "memory");
        } else {
            XB_SPIN(xb_ld(&bar[XB_XGEN(b.x)]) == gen, bar);
            __builtin_amdgcn_fence(__ATOMIC_ACQUIRE, "agent");
            asm volatile("s_waitcnt vmcnt(0)" ::: "memory");
        }
    }
    __syncthreads();
}

struct Params {
    const float *x, *g_mix, *w_in, *b_forget, *g_v_ln, *b_v_ln, *w_spatial, *b_spatial, *w_ba, *w_bg, *w_out, *g_ffn, *w_router, *b_router,
                *w_up, *b_up, *w_down, *b_down, *g_final;
    float* out;
    bf16_t *h, *q, *k, *v, *zg, *gates, *attn, *sg, *merged, *h2, *act, *y;
    bf16_t *wb_in, *wb_ba, *wb_bg, *wb_out, *wb_up, *wb_down, *wr_hi, *wr_lo;
    unsigned char *h8, *wb_in8;
    float *ls, *x1, *top_gate, *row_gate, *lnpart;
    int *top_idx, *blk_cnt, *row_tok, *row_dst, *tile_e, *tile_row0, *tile_nrows, *ntiles, *unit_up, *unit_down;
    unsigned* bar;
};

typedef __bf16 bf16x2_t __attribute__((ext_vector_type(2)));
__device__ __forceinline__ unsigned cvt_pk_bf16_mfma(float lo, float hi) { const f32x2 v = {lo, hi}; return __builtin_bit_cast(unsigned, __builtin_convertvector(v, bf16x2_t)); }
__device__ __forceinline__ unsigned cvt_pk_bf16(float lo, float hi) { unsigned r; asm("v_cvt_pk_bf16_f32 %0, %1, %2" : "=v"(r) : "v"(lo), "v"(hi)); return r; }
__device__ __forceinline__ int tid_opaque() { int t = threadIdx.x; asm volatile("" : "+v"(t)); return t; }
__device__ __forceinline__ float bf_lo(unsigned u) { return __uint_as_float(u << 16); }
__device__ __forceinline__ float bf_hi(unsigned u) { return __uint_as_float(u & 0xffff0000u); }
__device__ __forceinline__ float wave_sum(float v) {
#pragma unroll
    for (int o = 32; o; o >>= 1) v += __shfl_xor(v, o);
    return v; }
__device__ __forceinline__ float wave_max(float v) {
#pragma unroll
    for (int o = 32; o; o >>= 1) v = fmaxf(v, __shfl_xor(v, o));
    return v; }
__device__ __forceinline__ float sigmoidf_(float x) { return __builtin_amdgcn_rcpf(1.0f + __builtin_amdgcn_exp2f(-1.44269504f * x)); }
__device__ __forceinline__ float log_sigmoid(float x) { return fminf(x, 0.f) - log1pf(__expf(-fabsf(x))); }
__device__ __forceinline__ float gelu_erf(float v) { return 0.5f * v * (1.0f + erff(v * 0.70710678118654752f)); }

template <class Epi>
__device__ __forceinline__ void gemm_tile_naive(const bf16_t* __restrict__ A, int lda, const int* __restrict__ rowmap, int row0, int nvalid,
                                                const float* __restrict__ Bm, int ldb, int K, Epi&& epi) {
    const int tid = tid_opaque(), wid = tid >> 6, lane = tid & 63, wr = wid >> 2, wc = wid & 3, fr = lane & 15, fq = lane >> 4;
    const bf16_t* arow[8];
#pragma unroll
    for (int m = 0; m < 8; ++m) {
        int r = wr * 128 + m * 16 + fr; if (r >= nvalid) r = 0;
        const int gr = rowmap ? rowmap[row0 + r] : row0 + r;
        arow[m] = A + (size_t)gr * lda + fq * 8;
    }
    f32x4 acc[8][4];
#pragma unroll
    for (int m = 0; m < 8; ++m)
#pragma unroll
        for (int n = 0; n < 4; ++n) acc[m][n] = (f32x4){0.f, 0.f, 0.f, 0.f};
    for (int k0 = 0; k0 < K; k0 += 32) {
        bf16x8 At[8], Bf[4];
#pragma unroll
        for (int m = 0; m < 8; ++m) At[m] = *(const bf16x8*)(arow[m] + k0);
#pragma unroll
        for (int n = 0; n < 4; ++n) {
            const float* bp = Bm + (size_t)(k0 + fq * 8) * ldb + wc * 64 + n * 16 + fr;
            float v[8];
#pragma unroll
            for (int i = 0; i < 8; ++i) v[i] = bp[(size_t)i * ldb];
            u32x4 w; w.x = cvt_pk_bf16_mfma(v[0], v[1]); w.y = cvt_pk_bf16_mfma(v[2], v[3]); w.z = cvt_pk_bf16_mfma(v[4], v[5]); w.w = cvt_pk_bf16_mfma(v[6], v[7]);
            Bf[n] = __builtin_bit_cast(bf16x8, w);
        }
#pragma unroll
        for (int m = 0; m < 8; ++m)
#pragma unroll
            for (int n = 0; n < 4; ++n) acc[m][n] = __builtin_amdgcn_mfma_f32_16x16x32_bf16(Bf[n], At[m], acc[m][n], 0, 0, 0);
    }
    epi(acc, wr, wc, fr, fq);
}

template <bool MASKM> __device__ __forceinline__ int tile_row(int wr, int m, int fr) { return MASKM ? m * 32 + wr * 16 + fr : wr * 128 + m * 16 + fr; }
__device__ __forceinline__ int lds_byte(int r, int c) { const int st = (r >> 4) * 2 + (c >> 5), ob = (r & 15) * 64 + (c & 31) * 2; return st * 1024 + (ob ^ (((ob >> 9) & 1) << 5)); }
#define SCHED() __builtin_amdgcn_sched_barrier(0)

template <int LDB, bool GATHER, bool MASKM, class Epi>
__device__ __forceinline__ void gemm_tile(char* lds, const bf16_t* __restrict__ A, int lda, const int* __restrict__ rowmap, int row0, int nvalid,
                                          const float* __restrict__ Bm, int K, Epi&& epi) {
    constexpr int TILE_B = 256 * 64 * 2, STAGE_B = 2 * TILE_B;
    const int tid = tid_opaque(), wid = tid >> 6, lane = tid & 63, wr = wid >> 2, wc = wid & 3, fr = lane & 15, fq = lane >> 4;
    const int a_col = (wid & 1) * 32 + (((lane & 3) ^ ((lane >> 5) << 1)) << 3);
    unsigned aoff[4];
#pragma unroll
    for (int i = 0; i < 4; ++i) {
        const int R = ((wid >> 1) + 4 * i) * 16 + (lane >> 2);
        int r = MASKM ? ((R >> 4) & 7) * 32 + (R >> 7) * 16 + (R & 15) : R;
        if (MASKM && r >= nvalid) r = 0;
        const int gr = GATHER ? rowmap[row0 + r] : row0 + r;
        aoff[i] = (unsigned)gr * (unsigned)lda + (unsigned)a_col;
    }
    const int kq = lane & 3, nl = lane >> 2, kh = wid & 1, ng = wid >> 1;
    const unsigned bofs = (unsigned)((kh * 32 + kq * 8) * LDB + ng * 64 + nl * 4);
    const int boff0 = ((4 * ng + (nl >> 2)) * 2 + kh) * 1024 + ((((nl & 3) * 4) * 64 + kq * 16) ^ (((nl & 3) >> 1) << 5));
    const int mvalid = MASKM ? max(0, min(8, (nvalid - wr * 16 + 31) >> 5)) : 8;
    f32x4 acc[8][4];
#pragma unroll
    for (int m = 0; m < 8; ++m)
#pragma unroll
        for (int n = 0; n < 4; ++n) acc[m][n] = (f32x4){0.f, 0.f, 0.f, 0.f};
    u32x4 sa[4]; f32x4 sb[8];
#define G_ISSUE(kt) do { const bf16_t* Ak_ = A + (kt) * 64; const float* Bk_ = Bm + (size_t)(kt) * 64 * LDB; unsigned bo_ = bofs; asm volatile("" : "+v"(bo_)); \
        _Pragma("unroll") for (int i = 0; i < 4; ++i) sa[i] = *(const u32x4*)(Ak_ + aoff[i]); \
        _Pragma("unroll") for (int i = 0; i < 8; ++i) sb[i] = *(const f32x4*)(Bk_ + (bo_ + (unsigned)(i * LDB))); SCHED(); } while (0)
#define G_WRITE(buf) do { char* sA_ = lds + (buf) * STAGE_B; char* sB_ = sA_ + TILE_B; \
        _Pragma("unroll") for (int i = 0; i < 4; ++i) *(u32x4*)(sA_ + wid * 1024 + i * 8192 + lane * 16) = sa[i]; \
        _Pragma("unroll") for (int j = 0; j < 4; ++j) { u32x4 w_; w_.x = cvt_pk_bf16(sb[0][j], sb[1][j]); w_.y = cvt_pk_bf16(sb[2][j], sb[3][j]); \
            w_.z = cvt_pk_bf16(sb[4][j], sb[5][j]); w_.w = cvt_pk_bf16(sb[6][j], sb[7][j]); *(u32x4*)(sB_ + boff0 + j * 64) = w_; } } while (0)
#define G_KSTEP(buf, ks) do { const char* sA_ = lds + (buf) * STAGE_B; const char* sB_ = sA_ + TILE_B; bf16x8 Bf[4]; \
        _Pragma("unroll") for (int n = 0; n < 4; ++n) Bf[n] = *(const bf16x8*)(sB_ + lds_byte(wc * 64 + n * 16 + fr, (ks) * 32 + fq * 8)); \
        _Pragma("unroll") for (int mh = 0; mh < 2; ++mh) { if (!MASKM || mh * 4 < mvalid) { bf16x8 At[4]; \
            _Pragma("unroll") for (int m = 0; m < 4; ++m) At[m] = *(const bf16x8*)(sA_ + lds_byte(wr * 128 + (mh * 4 + m) * 16 + fr, (ks) * 32 + fq * 8)); \
            _Pragma("unroll") for (int m = 0; m < 4; ++m) { \
                _Pragma("unroll") for (int n = 0; n < 4; ++n) acc[mh * 4 + m][n] = __builtin_amdgcn_mfma_f32_16x16x32_bf16(Bf[n], At[m], acc[mh * 4 + m][n], 0, 0, 0); } } \
            SCHED(); } } while (0)
    const int nt = K / 64;
    G_ISSUE(0); G_WRITE(0); G_ISSUE(1); __syncthreads();
    for (int t = 0; t < nt; ++t) {
        const int cur = t & 1;
        if (t + 1 < nt) G_WRITE(cur ^ 1);
        if (t + 2 < nt) G_ISSUE(t + 2);
        G_KSTEP(cur, 0); G_KSTEP(cur, 1);
        __syncthreads();
    }
#undef G_ISSUE
#undef G_WRITE
#undef G_KSTEP
    epi(acc, wr, wc, fr, fq);
}

__device__ __forceinline__ void conv_tiles(char* lds, const float* __restrict__ src, int ldsrc, bf16_t* __restrict__ dst, int K, int nkt, int t_begin, int t_end, bool shift8, int vb, int nvb, int nnt = 1 << 30, size_t mstride = 0) {
    const int tid = tid_opaque(), w = tid >> 6, lane = tid & 63;
    f32x4 v0[8], v1[8], n0[8], n1[8], m0[8], m1[8];
    int t = t_begin + vb;
    if (t >= t_end) return;
#define CV_LOAD(dstv, tt) do { const int kt_ = (tt) % nkt, nt_ = (tt) / nkt, e_ = nt_ / nnt, ntl_ = nt_ % nnt; \
        const float* s_ = src + (size_t)e_ * mstride + (size_t)(kt_ * 64 + w * 8) * ldsrc + ntl_ * 256 + ((shift8 && nt_ >= 12) ? 8 : 0) + lane * 4; \
        _Pragma("unroll") for (int i = 0; i < 8; ++i) dstv[i] = __builtin_nontemporal_load((const f32x4*)(s_ + (size_t)i * ldsrc)); } while (0)
#define CV_PUT(srcv, buf) do { _Pragma("unroll") for (int j = 0; j < 4; ++j) { u32x4 pk; pk.x = cvt_pk_bf16(srcv[0][j], srcv[1][j]); pk.y = cvt_pk_bf16(srcv[2][j], srcv[3][j]); \
        pk.z = cvt_pk_bf16(srcv[4][j], srcv[5][j]); pk.w = cvt_pk_bf16(srcv[6][j], srcv[7][j]); *(u32x4*)(lds + (buf) * 32768 + (lane * 4 + j) * 128 + ((w ^ (lane & 7)) << 4)) = pk; } } while (0)
#define CV_OUT(tt, buf) do { const int kt_ = (tt) % nkt, nt_ = (tt) / nkt; bf16_t* d_ = dst + (size_t)nt_ * 256 * K + kt_ * 64; \
        _Pragma("unroll") for (int r = 0; r < 4; ++r) { const int c_ = r * 512 + tid, n_ = c_ >> 3, kc_ = c_ & 7; \
            __builtin_nontemporal_store(*(const u32x4*)(lds + (buf) * 32768 + n_ * 128 + ((kc_ ^ ((n_ >> 2) & 7)) << 4)), (u32x4*)(d_ + (size_t)n_ * K + kc_ * 8)); } } while (0)
    CV_LOAD(v0, t); if (t + nvb < t_end) CV_LOAD(v1, t + nvb);
    if (t + 2 * nvb < t_end) CV_LOAD(n0, t + 2 * nvb);
    if (t + 3 * nvb < t_end) CV_LOAD(n1, t + 3 * nvb);
    for (; t < t_end; t += 2 * nvb) {
        const bool two = t + nvb < t_end;
        if (t + 4 * nvb < t_end) CV_LOAD(m0, t + 4 * nvb);
        if (t + 5 * nvb < t_end) CV_LOAD(m1, t + 5 * nvb);
        __syncthreads();
        CV_PUT(v0, 0); if (two) CV_PUT(v1, 1);
        __syncthreads();
        CV_OUT(t, 0); if (two) CV_OUT(t + nvb, 1);
#pragma unroll
        for (int i = 0; i < 8; ++i) { v0[i] = n0[i]; v1[i] = n1[i]; n0[i] = m0[i]; n1[i] = m1[i]; }
    }
#undef CV_LOAD
#undef CV_PUT
#undef CV_OUT
    __syncthreads();
}

__device__ __forceinline__ unsigned pack_fp8x4(float a, float b, float c, float d) {
    a = fminf(fmaxf(a, -448.f), 448.f); b = fminf(fmaxf(b, -448.f), 448.f); c = fminf(fmaxf(c, -448.f), 448.f); d = fminf(fmaxf(d, -448.f), 448.f);
    int r = 0; r = __builtin_amdgcn_cvt_pk_fp8_f32(a, b, r, false); r = __builtin_amdgcn_cvt_pk_fp8_f32(c, d, r, true); return (unsigned)r;
}
__device__ __forceinline__ void conv_tiles_f8(char* lds, const float* __restrict__ src, int ldsrc, unsigned char* __restrict__ dst, int K, int nkt, int t_begin, int t_end, int vb, int nvb, int nnt, size_t mstride, bool shift8 = false) {
    const int tid = tid_opaque(), w = tid >> 6, lane = tid & 63, n4 = lane & 31, kg = w * 2 + (lane >> 5);
    f32x4 v0[8], v1[8], n0[8], n1[8], m0[8], m1[8];
    int t = t_begin + vb;
    if (t >= t_end) return;
#define C8_LOAD(dstv, tt) do { const int kt_ = (tt) % nkt, nt_ = (tt) / nkt, e_ = nt_ / nnt, ntl_ = nt_ % nnt; \
        const float* s_ = src + (size_t)e_ * mstride + (size_t)(kt_ * 128 + kg * 8) * ldsrc + ntl_ * 128 + ((shift8 && nt_ >= 24) ? 8 : 0) + n4 * 4; \
        _Pragma("unroll") for (int i = 0; i < 8; ++i) dstv[i] = __builtin_nontemporal_load((const f32x4*)(s_ + (size_t)i * ldsrc)); } while (0)
#define C8_PUT(srcv, buf) do { _Pragma("unroll") for (int j = 0; j < 4; ++j) { u32x2 pk; pk.x = pack_fp8x4(srcv[0][j] * 64.f, srcv[1][j] * 64.f, srcv[2][j] * 64.f, srcv[3][j] * 64.f); \
        pk.y = pack_fp8x4(srcv[4][j] * 64.f, srcv[5][j] * 64.f, srcv[6][j] * 64.f, srcv[7][j] * 64.f); \
        *(u32x2*)(lds + (buf) * 16384 + (n4 * 4 + j) * 128 + ((((kg >> 1) ^ (n4 & 7))) << 4) + (kg & 1) * 8) = pk; } } while (0)
#define C8_OUT(tt, buf) do { const int kt_ = (tt) % nkt, nt_ = (tt) / nkt; unsigned char* d_ = dst + (size_t)nt_ * 128 * K + kt_ * 128; \
        _Pragma("unroll") for (int r = 0; r < 2; ++r) { const int c_ = r * 512 + tid, n_ = c_ >> 3, ch_ = c_ & 7; \
            __builtin_nontemporal_store(*(const u32x4*)(lds + (buf) * 16384 + n_ * 128 + ((ch_ ^ ((n_ >> 2) & 7)) << 4)), (u32x4*)(d_ + (size_t)n_ * K + ch_ * 16)); } } while (0)
    C8_LOAD(v0, t); if (t + nvb < t_end) C8_LOAD(v1, t + nvb);
    if (t + 2 * nvb < t_end) C8_LOAD(n0, t + 2 * nvb);
    if (t + 3 * nvb < t_end) C8_LOAD(n1, t + 3 * nvb);
    for (; t < t_end; t += 2 * nvb) {
        const bool two = t + nvb < t_end;
        if (t + 4 * nvb < t_end) C8_LOAD(m0, t + 4 * nvb);
        if (t + 5 * nvb < t_end) C8_LOAD(m1, t + 5 * nvb);
        __syncthreads();
        C8_PUT(v0, 0); if (two) C8_PUT(v1, 1);
        __syncthreads();
        C8_OUT(t, 0); if (two) C8_OUT(t + nvb, 1);
#pragma unroll
        for (int i = 0; i < 8; ++i) { v0[i] = n0[i]; v1[i] = n1[i]; n0[i] = m0[i]; n1[i] = m1[i]; }
    }
#undef C8_LOAD
#undef C8_PUT
#undef C8_OUT
    __syncthreads();
}

namespace g8 {
constexpr int BK = 64, HALF = 128, HTB = HALF * BK * 2;
__device__ __forceinline__ int lds_byte8(int r, int c) { const int st = (r >> 4) * 2 + (c >> 5), rr = r & 15, cc = c & 31, ob = rr * 64 + cc * 2; return st * 1024 + (ob ^ (((ob >> 9) & 1) << 5)); }
__device__ __forceinline__ void stage_rc(int b, int& R, int& C) { const int st = b / 1024, sb = b % 1024, swz = sb ^ (((sb >> 9) & 1) << 5); R = (st >> 1) * 16 + swz / 64; C = (st & 1) * 32 + (swz % 64) / 2; }
__device__ __forceinline__ int perm32(int rho) { const int n = rho >> 4, i = rho & 15; return 8 * (i >> 2) + 4 * n + (i & 3); }
struct Unit { const char* A; const char* B; int row0, nv, pm, pn, e; };
__device__ __forceinline__ int xcd_remap(int L, int nwg) { const int q = nwg / 8, r = nwg % 8, xcd = L % 8, off = L / 8; return (xcd < r ? xcd * (q + 1) : r * (q + 1) + (xcd - r) * q) + off; }

template <bool GATHER, bool F8  , class Epi, class Sched>
__device__ __forceinline__ void gemm_phase8(char* lds_g, const int K, const int* __restrict__ rowmap, const Sched& S, const Epi& E) {
    LAS unsigned char* lds = (LAS unsigned char*)lds_g;
    const int tid = tid_opaque(), wid = __builtin_amdgcn_readfirstlane(tid >> 6), lane = tid & 63, wr = wid >> 2, wc = wid & 3, fr = lane & 15, fq = lane >> 4;
    constexpr int ESZ = F8 ? 1 : 2;
    const int nt = K * ESZ / 128;
    unsigned voffB[2], vaC[2][2], vaN[2][2];
#pragma unroll
    for (int i = 0; i < 2; ++i) { int sR_, sC_; stage_rc(tid * 16 + i * 8192, sR_, sC_); const int Rb = (sR_ & ~31) + perm32(sR_ & 31); voffB[i] = (unsigned)(Rb * K * ESZ + sC_ * 2); }
    const size_t kstep = (size_t)(BK * 2), hstep = (size_t)HALF * K * ESZ;
    const unsigned ldsw = (unsigned)wid * 1024u;
    const int aoff = lds_byte8(wr * 64 + fr, fq * 8), boff = lds_byte8(wc * 32 + fr, fq * 8);
#define G8_SA(b, h) (((b) * 2 + (h)) * HTB)
#define G8_SB(b, h) ((4 + (b) * 2 + (h)) * HTB)
#define G8_GLDS(bufoff, gptr, v0, v1) do { __builtin_amdgcn_global_load_lds((const unsigned*)((gptr) + (v0)), (LAS unsigned*)(lds + (bufoff) + ldsw), 16, 0, 0); \
        __builtin_amdgcn_global_load_lds((const unsigned*)((gptr) + (v1)), (LAS unsigned*)(lds + (bufoff) + ldsw + 8192), 16, 0, 0); } while (0)
#define G8_STB(bufoff, gptr) G8_GLDS(bufoff, gptr, voffB[0], voffB[1])
#define G8_STA(bufoff, gptr, va, h) G8_GLDS(bufoff, gptr, va[h][0], va[h][1])
#define G8_STA2(bufoff, gptr, h) G8_GLDS(bufoff, gptr, ((GATHER && last) ? vaN[h][0] : vaC[h][0]), ((GATHER && last) ? vaN[h][1] : vaC[h][1]))
#define G8_VA(va, u) do { int tv_ = tid; asm volatile("" : "+v"(tv_)); _Pragma("unroll") for (int i_ = 0; i_ < 2; ++i_) { int sR_, sC_; stage_rc(tv_ * 16 + i_ * 8192, sR_, sC_); _Pragma("unroll") for (int h_ = 0; h_ < 2; ++h_) { \
        if (GATHER) { int r_ = h_ * HALF + sR_; r_ = r_ < (u).nv ? r_ : (u).nv - 1; va[h_][i_] = (unsigned)rowmap[(u).row0 + r_] * (unsigned)(K * ESZ) + (unsigned)sC_ * 2u; } \
        else va[h_][i_] = (unsigned)((h_ * HALF + sR_) * K * ESZ + sC_ * 2); } } } while (0)
#define G8_LD8(dst, addr) do { const i32x4 lo_ = *(const LAS i32x4*)(lds + (addr)), hi_ = *(const LAS i32x4*)(lds + (addr) + 1024); dst = __builtin_shufflevector(lo_, hi_, 0, 1, 2, 3, 4, 5, 6, 7); } while (0)
#define G8_LDA(dst, b, h) do { if (F8) { _Pragma("unroll") for (int m = 0; m < 4; ++m) G8_LD8(dst##8[m], G8_SA(b, h) + aoff + m * 2048); } \
        else { _Pragma("unroll") for (int m = 0; m < 4; ++m) _Pragma("unroll") for (int k = 0; k < 2; ++k) dst[m][k] = *(const LAS bf16x8*)(lds + G8_SA(b, h) + aoff + m * 2048 + k * 1024); } } while (0)
#define G8_LDB(dst, b, h) do { if (F8) { _Pragma("unroll") for (int n = 0; n < 2; ++n) G8_LD8(dst##8[n], G8_SB(b, h) + boff + n * 2048); } \
        else { _Pragma("unroll") for (int n = 0; n < 2; ++n) _Pragma("unroll") for (int k = 0; k < 2; ++k) dst[n][k] = *(const LAS bf16x8*)(lds + G8_SB(b, h) + boff + n * 2048 + k * 1024); } } while (0)
#define G8_MMA(ai, bj, At, Bt) do { __builtin_amdgcn_s_setprio(1); _Pragma("unroll") for (int m = 0; m < 4; ++m) _Pragma("unroll") for (int n = 0; n < 2; ++n) { \
        if (F8) asm volatile("v_mfma_scale_f32_16x16x128_f8f6f4 %0, %1, %2, %0, %3, %4 op_sel_hi:[0,0,0]" : "+v"(acc[ai][bj][m][n]) : "v"(Bt##8[n]), "v"(At##8[m]), "v"(f8_sw), "v"(f8_sa)); \
        else { _Pragma("unroll") for (int k = 0; k < 2; ++k) acc[ai][bj][m][n] = __builtin_amdgcn_mfma_f32_16x16x32_bf16(Bt[n][k], At[m][k], acc[ai][bj][m][n], 0, 0, 0); } } \
        __builtin_amdgcn_s_setprio(0); } while (0)
#define G8_WAIT_V(n) asm volatile("s_waitcnt vmcnt(" #n ")" ::: "memory")
#define G8_WAIT_L(n) asm volatile("s_waitcnt lgkmcnt(" #n ")" ::: "memory")
#define G8_BAR __builtin_amdgcn_s_barrier()
#define G8_SCHED __builtin_amdgcn_sched_barrier(0)
    Unit cur, nxt; int ui = 0;
    if (!S.next(0, cur)) return;
    f32x4 acc[2][2][4][2];
#pragma unroll
    for (int a = 0; a < 2; ++a)
#pragma unroll
        for (int b = 0; b < 2; ++b)
#pragma unroll
            for (int m = 0; m < 4; ++m)
#pragma unroll
                for (int n = 0; n < 2; ++n) acc[a][b][m][n] = (f32x4){0.f, 0.f, 0.f, 0.f};
    bf16x8 At[4][2], B0[2][2], B1[2][2];
    const int f8_sw = 0x79797979, f8_sa = 0x7f7f7f7f;
    i32x8 At8[4], B08[2], B18[2];
    const char* cA = cur.A; const char* cB = cur.B;
    G8_VA(vaC, cur);
#pragma unroll
    for (int h = 0; h < 2; ++h) { vaN[h][0] = vaC[h][0]; vaN[h][1] = vaC[h][1]; }
    G8_STB(G8_SB(0, 0), cB); G8_STA(G8_SA(0, 0), cA, vaC, 0); G8_STB(G8_SB(0, 1), cB + hstep); G8_STA(G8_SA(0, 1), cA, vaC, 1);
    if (wr == 1) G8_BAR;
    G8_WAIT_V(4); G8_BAR;
    G8_STB(G8_SB(1, 0), cB + kstep); G8_STA(G8_SA(1, 0), cA + kstep, vaC, 0); G8_STB(G8_SB(1, 1), cB + hstep + kstep);
    G8_WAIT_V(6); G8_BAR;
    for (;;) {
        const bool has_next = S.next(ui + 1, nxt);
        const char* nA = has_next ? nxt.A : cA; const char* nB = has_next ? nxt.B : cB;
        if (GATHER && has_next) G8_VA(vaN, nxt);
        for (int t = 0; t < nt; t += 2) {
            const bool last = (t == nt - 2);
            const char* a1 = cA + (size_t)(t + 1) * kstep;
            const char* a2 = last ? nA : cA + (size_t)(t + 2) * kstep; const char* b2 = last ? nB : cB + (size_t)(t + 2) * kstep;
            const char* a3 = a2 + kstep; const char* b3 = b2 + kstep;
            G8_LDB(B0, 0, 0); G8_SCHED; G8_LDA(At, 0, 0); G8_STA(G8_SA(1, 1), a1, vaC, 1);
            G8_WAIT_L(8); G8_BAR; G8_WAIT_L(0); G8_MMA(0, 0, At, B0); G8_BAR; G8_SCHED;
            G8_LDB(B1, 0, 1); G8_STB(G8_SB(0, 0), b2);
            G8_BAR; G8_WAIT_L(0); G8_MMA(0, 1, At, B1); G8_BAR; if (F8) G8_SCHED;
            G8_LDA(At, 0, 1); G8_STA2(G8_SA(0, 0), a2, 0);
            G8_BAR; G8_WAIT_L(0); G8_MMA(1, 0, At, B0); G8_BAR; G8_SCHED;
            G8_STB(G8_SB(0, 1), b2 + hstep);
            G8_WAIT_V(6); G8_BAR; G8_MMA(1, 1, At, B1); G8_BAR; if (F8) G8_SCHED;
            G8_LDB(B0, 1, 0); G8_SCHED; G8_LDA(At, 1, 0); G8_STA2(G8_SA(0, 1), a2, 1);
            G8_WAIT_L(8); G8_BAR; G8_WAIT_L(0); G8_MMA(0, 0, At, B0); G8_BAR; G8_SCHED;
            G8_LDB(B1, 1, 1); G8_STB(G8_SB(1, 0), b3);
            G8_BAR; G8_WAIT_L(0); G8_MMA(0, 1, At, B1); G8_BAR; if (F8) G8_SCHED;
            G8_LDA(At, 1, 1); G8_STA2(G8_SA(1, 0), a3, 0);
            G8_BAR; G8_WAIT_L(0); G8_MMA(1, 0, At, B0); G8_BAR; G8_SCHED;
            G8_STB(G8_SB(1, 1), b3 + hstep);
            G8_WAIT_V(6); G8_BAR; G8_MMA(1, 1, At, B1); G8_BAR; if (F8) G8_SCHED;
        }
        bool keep_acc; { int te_ = tid; asm volatile("" : "+v"(te_)); const int le_ = te_ & 63; keep_acc = E(acc, cur, wr, wc, le_ & 15, le_ >> 4); }
        if (!has_next) break;
        if (!keep_acc) {
#pragma unroll
        for (int a = 0; a < 2; ++a)
#pragma unroll
            for (int b = 0; b < 2; ++b)
#pragma unroll
                for (int m = 0; m < 4; ++m)
#pragma unroll
                    for (int n = 0; n < 2; ++n) acc[a][b][m][n] = (f32x4){0.f, 0.f, 0.f, 0.f};
        }
        cur = nxt; cA = nA; cB = nB; ++ui;
        if (GATHER) {
#pragma unroll
            for (int h = 0; h < 2; ++h) { vaC[h][0] = vaN[h][0]; vaC[h][1] = vaN[h][1]; }
        }
    }
    G8_WAIT_V(0);
    if (wr == 0) G8_BAR;
    G8_BAR;
#undef G8_SA
#undef G8_SB
#undef G8_GLDS
#undef G8_STB
#undef G8_STA
#undef G8_STA2
#undef G8_VA
#undef G8_LDA
#undef G8_LDB
#undef G8_MMA
#undef G8_WAIT_V
#undef G8_WAIT_L
#undef G8_BAR
#undef G8_SCHED
}
__device__ __forceinline__ f32x2 gelu_pk(f32x2 v) {
    const f32x2 av = __builtin_elementwise_abs(v), d = av * 0.2316418882f + 1.0f;
    f32x2 t; t.x = __builtin_amdgcn_rcpf(d.x); t.y = __builtin_amdgcn_rcpf(d.y);
    f32x2 q = t * 0.5307027145f + (-0.7265760135f); q = q * t + 0.7107068705f; q = q * t + (-0.142248368f); q = q * t + 0.127414796f; q = q * t;
    const f32x2 s = (v * v) * (-0.72134752044f);
    f32x2 e; e.x = __builtin_amdgcn_exp2f(s.x); e.y = __builtin_amdgcn_exp2f(s.y);
    const f32x2 m = v * (q * e), r = v - m;
    f32x2 o; o.x = v.x < 0.f ? m.x : r.x; o.y = v.y < 0.f ? m.y : r.y; return o;
}
struct DenseOrder {
    const char* A; const char* B; int K, nM, nN, G, c, esz, pn0;
    __device__ __forceinline__ bool next(int i, Unit& u) const {
        const int nwg = nM * nN; const long L = (long)i * G + c; if (L >= nwg) return false;
        const int wgid = xcd_remap((int)L, nwg);
        const int nig = 8 * nN, gid = wgid / nig, fm = gid * 8, gsz = (nM - fm) < 8 ? (nM - fm) : 8;
        u.pm = fm + ((wgid % nig) % gsz); const int pnl = (wgid % nig) / gsz; u.pn = pn0 + pnl; u.row0 = u.pm * 256; u.nv = 256; u.e = 0;
        u.A = A + (size_t)u.pm * 256 * K * esz; u.B = B + (size_t)pnl * 256 * K * esz; return true;
    }
};
}

__device__ __forceinline__ void phase_prologue(const Params& p, char* lds, int vb, int nvb) {
    for (int i = vb * NTHREADS + tid_opaque(); i < NE * D; i += nvb * NTHREADS) {
        const int e = i >> 11, d = i & (D - 1); const float w = p.w_router[(size_t)d * NE + e];
        const unsigned hi = cvt_pk_bf16(w, 0.f) & 0xffffu; const float rem = w - __uint_as_float(hi << 16);
        p.wr_hi[i] = (bf16_t)hi; p.wr_lo[i] = (bf16_t)(cvt_pk_bf16(rem, 0.f) & 0xffffu);
    }
    float* wf = (float*)lds;
    for (int i = tid_opaque(); i < D * 2; i += NTHREADS) { const int d = i >> 1, hf = i & 1; const f32x4 wv = *(const f32x4*)(p.w_in + (size_t)d * PW + 3072 + hf * 4);
#pragma unroll
        for (int j = 0; j < 4; ++j) wf[(hf * 4 + j) * D + d] = wv[j]; }
    __syncthreads();
    const int tid = tid_opaque(), wid = tid >> 6, lane = tid & 63;
    for (int tok = vb * 8 + wid; tok < T; tok += nvb * 8) {
        const float* xr = p.x + (size_t)tok * D;
        f32x4 xv[8]; float ss = 0.f;
#pragma unroll
        for (int i = 0; i < 8; ++i) { xv[i] = *(const f32x4*)(xr + i * 256 + lane * 4); ss += xv[i][0] * xv[i][0] + xv[i][1] * xv[i][1] + xv[i][2] * xv[i][2] + xv[i][3] * xv[i][3]; }
        ss = wave_sum(ss);
        const float rstd = rsqrtf(ss * (1.0f / D) + 1e-5f);
        float fa[8];
#pragma unroll
        for (int j = 0; j < 8; ++j) fa[j] = 0.f;
#pragma unroll
        for (int i = 0; i < 8; ++i) {
            const f32x4 g = *(const f32x4*)(p.g_mix + i * 256 + lane * 4);
            const f32x4 hv = xv[i] * rstd * g;
            u32x2 w; w.x = cvt_pk_bf16(hv[0], hv[1]); w.y = cvt_pk_bf16(hv[2], hv[3]);
            *(u32x2*)(p.h + (size_t)tok * D + i * 256 + lane * 4) = w;
            *(unsigned*)(p.h8 + (size_t)tok * D + i * 256 + lane * 4) = pack_fp8x4(hv[0], hv[1], hv[2], hv[3]);
#pragma unroll
            for (int hh = 0; hh < 8; ++hh) { const f32x4 w4 = *(const f32x4*)(wf + hh * D + i * 256 + lane * 4); fa[hh] += hv[0] * w4[0] + hv[1] * w4[1] + hv[2] * w4[2] + hv[3] * w4[3]; }
        }
        float mine = 0.f;
#pragma unroll
        for (int j = 0; j < 8; ++j) { const float s = wave_sum(fa[j]); if (lane == j) mine = s; }
        if (lane < 8) p.ls[(size_t)tok * 8 + lane] = log_sigmoid(mine + p.b_forget[lane]);
    }
    __syncthreads();
}

__device__ __forceinline__ void phase_convert_dense(const Params& p, char* lds, int vb, int nvb) {
    conv_tiles(lds, p.w_in, PW, p.wb_in, D, 32, 0, 32 * PN_SPLIT, true, vb, nvb);
    conv_tiles_f8(lds, p.w_in, PW, p.wb_in8, D, 16, 16 * 2 * PN_SPLIT, 16 * 72, vb, nvb, 1 << 30, 0, true);
}
constexpr int UPSPLIT = 14592;
__device__ __forceinline__ void phase_convert_moe(const Params& p, char* lds, int part, int vb, int nvb) {
    unsigned char* up8 = (unsigned char*)p.wb_up; unsigned char* dn8 = (unsigned char*)p.wb_down;
    if (part == 0) {
        conv_tiles_f8(lds, p.w_up, 2 * DFF, up8, D, 16, 0, UPSPLIT, vb, nvb, 32, (size_t)D * 2 * DFF);
        conv_tiles(lds, p.w_ba, D, p.wb_ba, AW, 16, 0, 16 * 8, false, vb, nvb);
        conv_tiles(lds, p.w_bg, D, p.wb_bg, GW, 16, 0, 16 * 8, false, vb, nvb);
    } else {
        conv_tiles(lds, p.w_out, D, p.wb_out, D, 32, 0, 32 * 8, false, vb, nvb);
        conv_tiles_f8(lds, p.w_up, 2 * DFF, up8, D, 16, UPSPLIT, 16 * 32 * NE, vb, nvb, 32, (size_t)D * 2 * DFF);
        conv_tiles_f8(lds, p.w_down, D, dn8, DFF, 16, 0, 16 * 16 * NE, vb, nvb, 16, (size_t)DFF * D);
    }
}

struct EpiInproj {
    bf16_t *q, *k, *v, *zg, *gates; float* lnpart;
    __device__ __forceinline__ bool operator()(f32x4 (&acc)[2][2][4][2], const g8::Unit& u, int wr, int wc, int fr, int fq) const {
        const int pn = u.pn;
        bf16_t* base; int ld, colt, act;
        if (pn < 4) { base = q; ld = AW; colt = pn * 256; act = 0; }
        else if (pn < 8) { base = k; ld = AW; colt = (pn - 4) * 256; act = 0; }
        else if (pn < 12) { base = v; ld = AW; colt = (pn - 8) * 256; act = 0; }
        else if (pn < 20) { base = zg; ld = 2048; colt = (pn - 12) * 256; act = 1; }
        else { base = gates; ld = 4096; colt = (pn - 20) * 256; act = 2; }
        const bool lnp = pn >= 16 && pn < 20;
#pragma unroll
        for (int ai = 0; ai < 2; ++ai)
#pragma unroll
            for (int m = 0; m < 4; ++m) {
                const size_t row = (size_t)u.pm * 256 + ai * 128 + wr * 64 + m * 16 + fr;
                bf16_t* rowp = base + row * ld + colt + wc * 32 + fq * 8;
                float ps = 0.f, pq = 0.f;
#pragma unroll
                for (int bj = 0; bj < 2; ++bj) {
                    f32x4 v0 = acc[ai][bj][m][0], v1 = acc[ai][bj][m][1];
                    if (act == 1) {
                        const f32x2 a = g8::gelu_pk((f32x2){v0[0], v0[1]}), b = g8::gelu_pk((f32x2){v0[2], v0[3]}), c = g8::gelu_pk((f32x2){v1[0], v1[1]}), d = g8::gelu_pk((f32x2){v1[2], v1[3]});
                        v0 = (f32x4){a.x, a.y, b.x, b.y}; v1 = (f32x4){c.x, c.y, d.x, d.y};
                    } else if (act == 2) {
#pragma unroll
                        for (int j = 0; j < 4; ++j) { v0[j] = sigmoidf_(v0[j]); v1[j] = sigmoidf_(v1[j]); }
                    }
                    if (lnp) { ps += (v0[0] + v0[1]) + (v0[2] + v0[3]) + (v1[0] + v1[1]) + (v1[2] + v1[3]); pq += (v0[0] * v0[0] + v0[1] * v0[1]) + (v0[2] * v0[2] + v0[3] * v0[3]) + (v1[0] * v1[0] + v1[1] * v1[1]) + (v1[2] * v1[2] + v1[3] * v1[3]); }
                    u32x4 w; w.x = cvt_pk_bf16(v0[0], v0[1]); w.y = cvt_pk_bf16(v0[2], v0[3]); w.z = cvt_pk_bf16(v1[0], v1[1]); w.w = cvt_pk_bf16(v1[2], v1[3]);
                    *(u32x4*)(rowp + bj * 128) = w;
                }
                if (lnp) {
                    ps += __shfl_xor(ps, 16); ps += __shfl_xor(ps, 32); pq += __shfl_xor(pq, 16); pq += __shfl_xor(pq, 32);
                    if (fq == 0) *(f32x2*)(lnpart + (row * 16 + (pn - 16) * 4 + wc) * 2) = (f32x2){ps, pq};
                }
            }
        return false;
    }
};
__device__ __forceinline__ void phase_inproj8(const Params& p, char* lds, int vb, int nvb) {
    EpiInproj E; E.q = p.q; E.k = p.k; E.v = p.v; E.zg = p.zg; E.gates = p.gates; E.lnpart = p.lnpart;
    {
        g8::DenseOrder S; S.A = (const char*)p.h; S.B = (const char*)p.wb_in; S.K = D; S.nM = 32; S.nN = PN_SPLIT; S.G = nvb; S.c = vb; S.esz = 2; S.pn0 = 0;
        g8::gemm_phase8<false, false>(lds, D, nullptr, S, E);
    }
    {
        g8::DenseOrder S; S.A = (const char*)p.h8; S.B = (const char*)(p.wb_in8 + (size_t)PN_SPLIT * 256 * D); S.K = D; S.nM = 32; S.nN = 36 - PN_SPLIT; S.G = nvb; S.c = vb; S.esz = 1; S.pn0 = PN_SPLIT;
        g8::gemm_phase8<false, true>(lds, D, nullptr, S, E);
    }
}
__device__ __forceinline__ void phase_inproj_conv(const Params& p, char* lds, int vb, int nvb) {
    const int half = nvb >> 1; const bool first = vb >= half;
    if (first) phase_convert_moe(p, lds, 0, vb - half, nvb - half);
    phase_inproj8(p, lds, vb, nvb);
    if (!first) phase_convert_moe(p, lds, 1, vb, half);
}

__device__ __forceinline__ void phase_inproj(const Params& p, char* lds, int vb, int nvb) {
    for (int u = vb; u < 32 * 36; u += nvb) {
        const int pm = u / 36, pn = u % 36;
        const int bcol = pn < 12 ? pn * 256 : pn * 256 + 8;
        gemm_tile<PW, false, false>(lds, p.h, D, nullptr, pm * 256, 256, p.w_in + bcol, D,
            [&](const f32x4 (&acc)[8][4], int wr, int wc, int fr, int fq) {
#pragma unroll
                for (int m = 0; m < 8; ++m) {
                    const size_t row = (size_t)pm * 256 + wr * 128 + m * 16 + fr;
#pragma unroll
                    for (int n = 0; n < 4; ++n) {
                        const int c = wc * 64 + n * 16 + fq * 4;
                        f32x4 v = acc[m][n];
                        bf16_t* dst;
                        if (pn < 4) dst = p.q + row * AW + pn * 256 + c;
                        else if (pn < 8) dst = p.k + row * AW + (pn - 4) * 256 + c;
                        else if (pn < 12) dst = p.v + row * AW + (pn - 8) * 256 + c;
                        else if (pn < 20) { dst = p.zg + row * 2048 + (pn - 12) * 256 + c;
#pragma unroll
                            for (int j = 0; j < 4; ++j) v[j] = gelu_erf(v[j]); }
                        else { dst = p.gates + row * 4096 + (pn - 20) * 256 + c;
#pragma unroll
                            for (int j = 0; j < 4; ++j) v[j] = sigmoidf_(v[j]); }
                        u32x2 w; w.x = cvt_pk_bf16(v[0], v[1]); w.y = cvt_pk_bf16(v[2], v[3]);
                        *(u32x2*)dst = w;
                    }
                }
            });
    }
}

struct BranchOrder {
    const char *A0, *A1, *B0, *B1; int G, c;
    __device__ __forceinline__ bool next(int i, g8::Unit& u) const {
        const int nwg = 32 * 8; const long L = (long)(i >> 1) * G + c; if (L >= nwg) return false;
        const int wgid = g8::xcd_remap((int)L, nwg);
        const int nig = 8 * 8, gid = wgid / nig, fm = gid * 8;
        u.pm = fm + ((wgid % nig) % 8); u.pn = (wgid % nig) / 8; u.row0 = u.pm * 256; u.nv = 256; u.e = i & 1;
        u.A = ((i & 1) ? A1 : A0) + (size_t)u.pm * 256 * AW * 2; u.B = ((i & 1) ? B1 : B0) + (size_t)u.pn * 256 * AW * 2; return true;
    }
};
struct EpiBranch {
    const bf16_t* gates; bf16_t* merged;
    __device__ __forceinline__ bool operator()(f32x4 (&acc)[2][2][4][2], const g8::Unit& u, int wr, int wc, int fr, int fq) const {
#pragma unroll
        for (int aim = 0; aim < 4; ++aim) {
            const int ai = aim >> 1, m0 = (aim & 1) * 2;
            u32x4 ga[4][2], gb[4][2];
#pragma unroll
            for (int m = m0; m < m0 + 2; ++m) {
                const size_t row = (size_t)u.pm * 256 + ai * 128 + wr * 64 + m * 16 + fr;
#pragma unroll
                for (int bj = 0; bj < 2; ++bj) {
                    const int c = u.pn * 256 + bj * 128 + wc * 32 + fq * 8;
                    ga[m][bj] = *(const u32x4*)(gates + row * 4096 + c);
                    if (u.e == 0) gb[m][bj] = *(const u32x4*)(gates + row * 4096 + 2048 + c);
                }
            }
#pragma unroll
            for (int m = m0; m < m0 + 2; ++m) {
                const size_t row = (size_t)u.pm * 256 + ai * 128 + wr * 64 + m * 16 + fr;
#pragma unroll
                for (int bj = 0; bj < 2; ++bj) {
                    const int c = u.pn * 256 + bj * 128 + wc * 32 + fq * 8;
                    const u32x4 a_ = ga[m][bj];
                    const float gav[8] = {fmaxf(bf_lo(a_.x), 1e-6f), fmaxf(bf_hi(a_.x), 1e-6f), fmaxf(bf_lo(a_.y), 1e-6f), fmaxf(bf_hi(a_.y), 1e-6f),
                                          fmaxf(bf_lo(a_.z), 1e-6f), fmaxf(bf_hi(a_.z), 1e-6f), fmaxf(bf_lo(a_.w), 1e-6f), fmaxf(bf_hi(a_.w), 1e-6f)};
                    if (u.e == 0) {
                        const u32x4 b_ = gb[m][bj];
                        const float gbv[8] = {bf_lo(b_.x), bf_hi(b_.x), bf_lo(b_.y), bf_hi(b_.y), bf_lo(b_.z), bf_hi(b_.z), bf_lo(b_.w), bf_hi(b_.w)};
#pragma unroll
                        for (int j = 0; j < 4; ++j) { acc[ai][bj][m][0][j] *= gbv[j] * __builtin_amdgcn_rcpf(gav[j]); acc[ai][bj][m][1][j] *= gbv[4 + j] * __builtin_amdgcn_rcpf(gav[4 + j]); }
                    } else {
                        f32x4 v0 = acc[ai][bj][m][0], v1 = acc[ai][bj][m][1];
#pragma unroll
                        for (int j = 0; j < 4; ++j) { v0[j] *= gav[j]; v1[j] *= gav[4 + j]; }
                        u32x4 w; w.x = cvt_pk_bf16(v0[0], v0[1]); w.y = cvt_pk_bf16(v0[2], v0[3]); w.z = cvt_pk_bf16(v1[0], v1[1]); w.w = cvt_pk_bf16(v1[2], v1[3]);
                        *(u32x4*)(merged + row * D + c) = w;
                    }
                }
            }
        }
        return u.e == 0;
    }
};
__device__ __forceinline__ void phase_branch8(const Params& p, char* lds, int vb, int nvb) {
    BranchOrder S; S.A0 = (const char*)p.sg; S.A1 = (const char*)p.attn; S.B0 = (const char*)p.wb_bg; S.B1 = (const char*)p.wb_ba; S.G = nvb; S.c = vb;
    EpiBranch E; E.gates = p.gates; E.merged = p.merged;
    g8::gemm_phase8<false, false>(lds, AW, nullptr, S, E);
}
struct EpiOut {
    const float* x; float* x1;
    __device__ __forceinline__ bool operator()(f32x4 (&acc)[2][2][4][2], const g8::Unit& u, int wr, int wc, int fr, int fq) const {
#pragma unroll
        for (int aim = 0; aim < 4; ++aim) {
            const int ai = aim >> 1, m0 = (aim & 1) * 2;
            f32x4 xv[4][2][2];
#pragma unroll
            for (int m = m0; m < m0 + 2; ++m)
#pragma unroll
                for (int bj = 0; bj < 2; ++bj) {
                    const size_t o = ((size_t)u.pm * 256 + ai * 128 + wr * 64 + m * 16 + fr) * D + u.pn * 256 + bj * 128 + wc * 32 + fq * 8;
                    xv[m][bj][0] = *(const f32x4*)(x + o); xv[m][bj][1] = *(const f32x4*)(x + o + 4);
                }
#pragma unroll
            for (int m = m0; m < m0 + 2; ++m)
#pragma unroll
                for (int bj = 0; bj < 2; ++bj) {
                    const size_t o = ((size_t)u.pm * 256 + ai * 128 + wr * 64 + m * 16 + fr) * D + u.pn * 256 + bj * 128 + wc * 32 + fq * 8;
                    *(f32x4*)(x1 + o) = xv[m][bj][0] + acc[ai][bj][m][0];
                    *(f32x4*)(x1 + o + 4) = xv[m][bj][1] + acc[ai][bj][m][1];
                }
        }
        return false;
    }
};
__device__ __forceinline__ void phase_outproj8(const Params& p, char* lds, int vb, int nvb) {
    g8::DenseOrder S; S.A = (const char*)p.merged; S.B = (const char*)p.wb_out; S.K = D; S.nM = 32; S.nN = 8; S.G = nvb; S.c = vb; S.esz = 2; S.pn0 = 0;
    EpiOut E; E.x = p.x; E.x1 = p.x1;
    g8::gemm_phase8<false, false>(lds, D, nullptr, S, E);
}
struct MoeOrder {
    const int *unit_tab, *tile_row0, *tile_nrows; const char *A, *B; int nunits, rows_per_e, gather, G, c;
    __device__ __forceinline__ bool next(int i, g8::Unit& u) const {
        const int L = i * G + c; if (L >= nunits) return false;
        const int w = g8::xcd_remap(L, nunits);
        const int2 dd = *(const int2*)(unit_tab + 2 * w); const int d = dd.x;
        u.e = (unsigned)d >> 24; u.pn = (d >> 16) & 0xff; u.pm = d & 0xffff; u.row0 = dd.y & 0xffff; u.nv = (unsigned)dd.y >> 16;
        u.A = gather ? A : A + (size_t)u.row0 * D;
        u.B = B + ((size_t)u.e * rows_per_e + (size_t)u.pn * 256) * D; return true;
    }
};
struct EpiUp {
    const float* b_up; bf16_t* act;
    __device__ __forceinline__ bool operator()(f32x4 (&acc)[2][2][4][2], const g8::Unit& u, int wr, int wc, int fr, int fq) const {
        f32x4 bb[2][2];
#pragma unroll
        for (int bj = 0; bj < 2; ++bj) { const float* bp = b_up + (size_t)u.e * (2 * DFF) + u.pn * 256 + bj * 128 + wc * 32 + fq * 8; bb[bj][0] = *(const f32x4*)bp; bb[bj][1] = *(const f32x4*)(bp + 4); }
#pragma unroll
        for (int ai = 0; ai < 2; ++ai)
#pragma unroll
            for (int m = 0; m < 4; ++m) {
                const int r = ai * 128 + wr * 64 + m * 16 + fr;
                if (r < u.nv) {
#pragma unroll
                    for (int bj = 0; bj < 2; ++bj) {
                        const int c = u.pn * 256 + bj * 128 + wc * 32 + fq * 8;
                        const f32x4 v0 = acc[ai][bj][m][0] + bb[bj][0], v1 = acc[ai][bj][m][1] + bb[bj][1];
                        float a[4];
#pragma unroll
                        for (int j = 0; j < 2; ++j) {
                            const float g0 = fminf(v0[2 * j], 7.f), l0 = fminf(fmaxf(v0[2 * j + 1], -7.f), 7.f);
                            const float g1 = fminf(v1[2 * j], 7.f), l1 = fminf(fmaxf(v1[2 * j + 1], -7.f), 7.f);
                            const float t0 = g0 * __builtin_amdgcn_rcpf(1.0f + __builtin_amdgcn_exp2f(-2.45546696f * g0)), t1 = g1 * __builtin_amdgcn_rcpf(1.0f + __builtin_amdgcn_exp2f(-2.45546696f * g1));
                            a[j] = fmaf(t0, l0, t0); a[2 + j] = fmaf(t1, l1, t1);
                        }
                        int pk = 0; pk = __builtin_amdgcn_cvt_pk_fp8_f32(a[0], a[1], pk, false); pk = __builtin_amdgcn_cvt_pk_fp8_f32(a[2], a[3], pk, true);
                        *(unsigned*)((unsigned char*)act + (size_t)(u.row0 + r) * DFF + (c >> 1)) = (unsigned)pk;
                    }
                }
            }
        return false;
    }
};
__device__ __forceinline__ void phase_moe_up8(const Params& p, char* lds, int vb, int nvb) {
    MoeOrder S; S.unit_tab = p.unit_up; S.tile_row0 = p.tile_row0; S.tile_nrows = p.tile_nrows; S.A = (const char*)p.h2; S.B = (const char*)p.wb_up;
    S.nunits = __builtin_amdgcn_readfirstlane(p.ntiles[0]) * 16; S.rows_per_e = 2 * DFF; S.gather = 1; S.G = nvb; S.c = vb;
    EpiUp E; E.b_up = p.b_up; E.act = p.act;
    g8::gemm_phase8<true, true>(lds, D, p.row_tok, S, E);
}
struct EpiDown {
    const float *b_down, *row_gate; const int* row_dst; bf16_t* y;
    __device__ __forceinline__ bool operator()(f32x4 (&acc)[2][2][4][2], const g8::Unit& u, int wr, int wc, int fr, int fq) const {
        f32x4 bb[2][2]; float gt[2][4]; int ds[2][4];
#pragma unroll
        for (int bj = 0; bj < 2; ++bj) { const float* bp = b_down + (size_t)u.e * D + u.pn * 256 + bj * 128 + wc * 32 + fq * 8; bb[bj][0] = *(const f32x4*)bp; bb[bj][1] = *(const f32x4*)(bp + 4); }
#pragma unroll
        for (int ai = 0; ai < 2; ++ai)
#pragma unroll
            for (int m = 0; m < 4; ++m) { int r = ai * 128 + wr * 64 + m * 16 + fr; r = r < u.nv ? r : u.nv - 1; gt[ai][m] = row_gate[u.row0 + r]; ds[ai][m] = row_dst[u.row0 + r]; }
#pragma unroll
        for (int ai = 0; ai < 2; ++ai)
#pragma unroll
            for (int m = 0; m < 4; ++m) {
                const int r = ai * 128 + wr * 64 + m * 16 + fr;
                if (r < u.nv) {
                    const float gate = gt[ai][m];
                    bf16_t* yp = y + (size_t)ds[ai][m] * D;
#pragma unroll
                    for (int bj = 0; bj < 2; ++bj) {
                        const int c = u.pn * 256 + bj * 128 + wc * 32 + fq * 8;
                        const f32x4 v0 = (acc[ai][bj][m][0] + bb[bj][0]) * gate, v1 = (acc[ai][bj][m][1] + bb[bj][1]) * gate;
                        u32x4 w; w.x = cvt_pk_bf16(v0[0], v0[1]); w.y = cvt_pk_bf16(v0[2], v0[3]); w.z = cvt_pk_bf16(v1[0], v1[1]); w.w = cvt_pk_bf16(v1[2], v1[3]);
                        *(u32x4*)(yp + c) = w;
                    }
                }
            }
        return false;
    }
};
__device__ __forceinline__ void phase_moe_down8(const Params& p, char* lds, int vb, int nvb) {
    MoeOrder S; S.unit_tab = p.unit_down; S.tile_row0 = p.tile_row0; S.tile_nrows = p.tile_nrows; S.A = (const char*)p.act; S.B = (const char*)p.wb_down;
    S.nunits = __builtin_amdgcn_readfirstlane(p.ntiles[0]) * 8; S.rows_per_e = D; S.gather = 0; S.G = nvb; S.c = vb;
    EpiDown E; E.b_down = p.b_down; E.row_gate = p.row_gate; E.row_dst = p.row_dst; E.y = p.y;
    g8::gemm_phase8<false, true>(lds, DFF, nullptr, S, E);
}

__device__ __forceinline__ void phase_attn_naive(const Params& p, char* lds, int vb, int nvb) {
    float* cs = (float*)lds;
    float* wtot = cs + 2048;
    float* qs = wtot + 64;
    const int tid = tid_opaque(), wid = tid >> 6, lane = tid & 63;
    for (int u = vb; u < 512; u += nvb) {
        const int qb = 15 - (u >> 5), bh = u & 31, b = bh >> 3, hh = bh & 7;
        const int nkeys = (qb + 1) * 128;
        __syncthreads();
        {
            float v[4];
#pragma unroll
            for (int j = 0; j < 4; ++j) { const int s = tid * 4 + j; v[j] = s < nkeys ? p.ls[((size_t)b * S + s) * 8 + hh] : 0.f; }
            v[1] += v[0]; v[2] += v[1]; v[3] += v[2];
            float incl = v[3];
#pragma unroll
            for (int o = 1; o < 64; o <<= 1) { const float t = __shfl_up(incl, o); if (lane >= o) incl += t; }
            if (lane == 63) wtot[wid] = incl;
            __syncthreads();
            float base = incl - v[3];
            for (int w = 0; w < wid; ++w) base += wtot[w];
#pragma unroll
            for (int j = 0; j < 4; ++j) cs[tid * 4 + j] = base + v[j];
            __syncthreads();
        }
        float* myq = qs + wid * 128;
        for (int rr = 0; rr < 16; ++rr) {
            const int t = qb * 128 + wid * 16 + rr;
            const size_t qoff = ((size_t)b * S + t) * AW + hh * 128;
            { const unsigned qq = *(const unsigned*)(p.q + qoff + lane * 2); myq[lane * 2] = bf_lo(qq) * 0.08838834764831845f; myq[lane * 2 + 1] = bf_hi(qq) * 0.08838834764831845f; }
            __builtin_amdgcn_wave_barrier();
            const float ct = cs[t];
            float mrun = -INFINITY, lrun = 0.f, o0 = 0.f, o1 = 0.f;
            for (int s0 = 0; s0 <= t; s0 += 64) {
                const int s = s0 + lane; const bool valid = s <= t; const int sl = valid ? s : t;
                const bf16_t* kp = p.k + ((size_t)b * S + sl) * AW + hh * 128;
                float acc = 0.f;
#pragma unroll
                for (int c = 0; c < 16; ++c) {
                    const u32x4 kk = *(const u32x4*)(kp + c * 8);
                    const f32x4 qa = *(const f32x4*)(myq + c * 8), qb4 = *(const f32x4*)(myq + c * 8 + 4);
                    acc += bf_lo(kk.x) * qa[0] + bf_hi(kk.x) * qa[1] + bf_lo(kk.y) * qa[2] + bf_hi(kk.y) * qa[3]
                         + bf_lo(kk.z) * qb4[0] + bf_hi(kk.z) * qb4[1] + bf_lo(kk.w) * qb4[2] + bf_hi(kk.w) * qb4[3];
                }
                const float sc = valid ? acc + (ct - cs[sl]) : -INFINITY;
                const float mnew = fmaxf(mrun, wave_max(sc));
                const float alpha = __expf(mrun - mnew);
                const float pj = valid ? __expf(sc - mnew) : 0.f;
                lrun = lrun * alpha + wave_sum(pj);
                o0 *= alpha; o1 *= alpha;
                const int nj = min(64, t - s0 + 1);
                const bf16_t* vp = p.v + ((size_t)b * S + s0) * AW + hh * 128 + lane * 2;
                for (int j = 0; j < nj; ++j) {
                    const float pjj = __shfl(pj, j);
                    const unsigned vv = *(const unsigned*)(vp + (size_t)j * AW);
                    o0 += pjj * bf_lo(vv); o1 += pjj * bf_hi(vv);
                }
                mrun = mnew;
            }
            const float inv = 1.0f / lrun;
            *(unsigned*)(p.attn + qoff + lane * 2) = cvt_pk_bf16(o0 * inv, o1 * inv);
            __builtin_amdgcn_wave_barrier();
        }
    }
    __syncthreads();
}

template <int KS> __device__ __forceinline__ int lds_byte_t(int r, int c) { const int st = (r >> 4) * KS + (c >> 5), ob = (r & 15) * 64 + (c & 31) * 2; return st * 1024 + (ob ^ (((ob >> 9) & 1) << 5)); }

__device__ __forceinline__ void attn_block(const Params& p, char* stg, const float* cs, int b, int hh, int qb) {
    const int tid = tid_opaque(), wid = tid >> 6, lane = tid & 63, fr = lane & 15, fq = lane >> 4, w = wid & 3, kh = wid >> 2;
    const int q0 = qb * 128;
    const float sc2 = 0.08838834764831845f * 1.4426950408889634f;
    const size_t tokb = (size_t)b * S;
    bf16x8 Qf[2][4];
#pragma unroll
    for (int qg = 0; qg < 2; ++qg)
#pragma unroll
        for (int ks = 0; ks < 4; ++ks) Qf[qg][ks] = *(const bf16x8*)(p.q + (tokb + q0 + 32 * w + 16 * qg + fr) * AW + hh * 128 + ks * 32 + fq * 8);
    f32x4 O[2][8];
#pragma unroll
    for (int qg = 0; qg < 2; ++qg)
#pragma unroll
        for (int dt = 0; dt < 8; ++dt) O[qg][dt] = (f32x4){0.f, 0.f, 0.f, 0.f};
    float mrun[2] = {-1e30f, -1e30f}, lrun[2] = {0.f, 0.f};
    const int kR = (wid >> 2) * 16 + (lane >> 2), kC = (wid & 3) * 32 + (((lane & 3) ^ ((lane >> 5) << 1)) << 3);
    const bf16_t* kg = p.k + (tokb + kR) * AW + hh * 128 + kC;
    const int vq4 = (lane & 7) | ((wid >> 1) << 3), vd8 = ((lane >> 3) & 7) | ((wid & 1) << 3);
    const bf16_t* vg = p.v + (tokb + 4 * vq4) * AW + hh * 128 + vd8 * 8;
    const int vq4p = vq4 & 15, vq4pp = vq4p & 7;
    const int vcol = (vq4p >> 3) * 32 + 8 * (vq4pp & 3) + 4 * (vq4pp >> 2);
    const int vwoff = 32768 + (vq4 >> 4) * 16384 + ((vd8 >> 1) * 2 + (vcol >> 5)) * 1024 + ((((vd8 & 1) * 512) + (vcol & 31) * 2) ^ ((vd8 & 1) << 5));
    u32x4 kreg[4], vreg[4];
#define AT_ISSUE(j) do { _Pragma("unroll") for (int i = 0; i < 4; ++i) kreg[i] = *(const u32x4*)(kg + (size_t)((j) * 128 + 32 * i) * AW); \
        _Pragma("unroll") for (int r = 0; r < 4; ++r) vreg[r] = *(const u32x4*)(vg + (size_t)((j) * 128 + r) * AW); } while (0)
#define AT_WRITE(sidx) do { char* st_ = stg + (sidx) * 65536; \
        _Pragma("unroll") for (int i = 0; i < 4; ++i) *(u32x4*)(st_ + (i * 512 + tid) * 16) = kreg[i]; \
        _Pragma("unroll") for (int dd = 0; dd < 8; ++dd) { u32x2 w_; const unsigned sel_ = (dd & 1) ? 0x07060302u : 0x05040100u; \
            w_.x = __builtin_amdgcn_perm(vreg[1][dd >> 1], vreg[0][dd >> 1], sel_); w_.y = __builtin_amdgcn_perm(vreg[3][dd >> 1], vreg[2][dd >> 1], sel_); \
            *(u32x2*)(st_ + vwoff + dd * 64) = w_; } } while (0)
    AT_ISSUE(0); AT_WRITE(0);
#pragma unroll
    for (int qg = 0; qg < 2; ++qg)
#pragma unroll
        for (int ks = 0; ks < 4; ++ks) asm volatile("" :: "v"(Qf[qg][ks]));
    __syncthreads();
    for (int j = 0; j <= qb; ++j) {
        const int cur = j & 1;
        if (j < qb) AT_ISSUE(j + 1);
        const bool diag = (j == qb);
        const bool skip = diag && (kh * 64 > 32 * w + 31);
        if (!skip) {
            const char* st_ = stg + cur * 65536;
            f32x4 Sx[4][2];
#pragma unroll
            for (int kt = 0; kt < 4; ++kt) { Sx[kt][0] = (f32x4){0.f, 0.f, 0.f, 0.f}; Sx[kt][1] = (f32x4){0.f, 0.f, 0.f, 0.f}; }
#pragma unroll
            for (int ks = 0; ks < 4; ++ks)
#pragma unroll
                for (int kt = 0; kt < 4; ++kt) {
                    const bf16x8 Kf = *(const bf16x8*)(st_ + lds_byte_t<4>(kh * 64 + kt * 16 + fr, ks * 32 + fq * 8));
                    Sx[kt][0] = __builtin_amdgcn_mfma_f32_16x16x32_bf16(Kf, Qf[0][ks], Sx[kt][0], 0, 0, 0);
                    Sx[kt][1] = __builtin_amdgcn_mfma_f32_16x16x32_bf16(Kf, Qf[1][ks], Sx[kt][1], 0, 0, 0);
                }
            const int keyb = j * 128 + kh * 64 + 4 * fq;
            const bool mask = diag && (kh * 64 + 63 > 32 * w);
#pragma unroll
            for (int kt = 0; kt < 4; ++kt) {
                const f32x4 cb = *(const f32x4*)(cs + keyb + kt * 16);
#pragma unroll
                for (int qg = 0; qg < 2; ++qg) {
                    const int qi = q0 + 32 * w + 16 * qg + fr;
#pragma unroll
                    for (int r = 0; r < 4; ++r) {
                        float v = Sx[kt][qg][r] * sc2 - cb[r];
                        if (mask && (keyb + kt * 16 + r > qi)) v = -INFINITY;
                        Sx[kt][qg][r] = v;
                    }
                }
            }
#pragma unroll
            for (int qg = 0; qg < 2; ++qg) {
                float mx = -INFINITY;
#pragma unroll
                for (int kt = 0; kt < 4; ++kt) mx = fmaxf(mx, fmaxf(fmaxf(Sx[kt][qg][0], Sx[kt][qg][1]), fmaxf(Sx[kt][qg][2], Sx[kt][qg][3])));
                mx = fmaxf(mx, __shfl_xor(mx, 16)); mx = fmaxf(mx, __shfl_xor(mx, 32));
                const float mnew = fmaxf(mrun[qg], mx);
                const float alpha = __builtin_amdgcn_exp2f(mrun[qg] - mnew);
                mrun[qg] = mnew;
                float ls = 0.f;
#pragma unroll
                for (int kt = 0; kt < 4; ++kt)
#pragma unroll
                    for (int r = 0; r < 4; ++r) { const float pv = __builtin_amdgcn_exp2f(Sx[kt][qg][r] - mnew); ls += pv; Sx[kt][qg][r] = pv; }
                lrun[qg] = lrun[qg] * alpha + ls;
#pragma unroll
                for (int dt = 0; dt < 8; ++dt) O[qg][dt] *= alpha;
            }
#pragma unroll
            for (int ks2 = 0; ks2 < 2; ++ks2) {
                bf16x8 Pf[2];
#pragma unroll
                for (int qg = 0; qg < 2; ++qg) {
                    u32x4 pw; pw.x = cvt_pk_bf16_mfma(Sx[2 * ks2][qg][0], Sx[2 * ks2][qg][1]); pw.y = cvt_pk_bf16_mfma(Sx[2 * ks2][qg][2], Sx[2 * ks2][qg][3]);
                    pw.z = cvt_pk_bf16_mfma(Sx[2 * ks2 + 1][qg][0], Sx[2 * ks2 + 1][qg][1]); pw.w = cvt_pk_bf16_mfma(Sx[2 * ks2 + 1][qg][2], Sx[2 * ks2 + 1][qg][3]);
                    Pf[qg] = __builtin_bit_cast(bf16x8, pw);
                }
#pragma unroll
                for (int dt = 0; dt < 8; ++dt) {
                    const bf16x8 Vf = *(const bf16x8*)(st_ + 32768 + kh * 16384 + lds_byte_t<2>(dt * 16 + fr, ks2 * 32 + fq * 8));
                    O[0][dt] = __builtin_amdgcn_mfma_f32_16x16x32_bf16(Vf, Pf[0], O[0][dt], 0, 0, 0);
                    O[1][dt] = __builtin_amdgcn_mfma_f32_16x16x32_bf16(Vf, Pf[1], O[1][dt], 0, 0, 0);
                }
            }
        }
        if (j < qb) AT_WRITE(cur ^ 1);
        __syncthreads();
    }
#undef AT_ISSUE
#undef AT_WRITE
#pragma unroll
    for (int qg = 0; qg < 2; ++qg) { lrun[qg] += __shfl_xor(lrun[qg], 16); lrun[qg] += __shfl_xor(lrun[qg], 32); }
    f32x4* ob = (f32x4*)(stg + w * 16384);
    float* mlb = (float*)(stg + 65536 + w * 1024);
    if (kh == 1) {
#pragma unroll
        for (int qg = 0; qg < 2; ++qg) {
            mlb[(qg * 2 + 0) * 64 + lane] = mrun[qg]; mlb[(qg * 2 + 1) * 64 + lane] = lrun[qg];
#pragma unroll
            for (int dt = 0; dt < 8; ++dt) ob[(qg * 8 + dt) * 64 + lane] = O[qg][dt];
        }
    }
    __syncthreads();
    if (kh == 0) {
#pragma unroll
        for (int qg = 0; qg < 2; ++qg) {
            const float m2 = mlb[(qg * 2 + 0) * 64 + lane], l2 = mlb[(qg * 2 + 1) * 64 + lane];
            const float mt = fmaxf(mrun[qg], m2);
            const float e1 = __builtin_amdgcn_exp2f(mrun[qg] - mt), e2 = __builtin_amdgcn_exp2f(m2 - mt);
            const float inv = 1.0f / (lrun[qg] * e1 + l2 * e2);
            const float f1 = e1 * inv, f2 = e2 * inv;
            bf16_t* orow = p.attn + (tokb + q0 + 32 * w + 16 * qg + fr) * AW + hh * 128 + 4 * fq;
#pragma unroll
            for (int dt = 0; dt < 8; ++dt) {
                const f32x4 o2 = ob[(qg * 8 + dt) * 64 + lane];
                const f32x4 o = O[qg][dt] * f1 + o2 * f2;
                u32x2 ww; ww.x = cvt_pk_bf16(o[0], o[1]); ww.y = cvt_pk_bf16(o[2], o[3]);
                *(u32x2*)(orow + dt * 16) = ww;
            }
        }
    }
    __syncthreads();
}

__device__ __forceinline__ void phase_attn(const Params& p, char* lds, int vb, int nvb) {
    float* cs = (float*)lds;
    float* wtot = (float*)(lds + 8192);
    char* stg = lds + 8192 + 256;
    for (int u = vb; u < 256; u += nvb) {
        const int bh = u & 31, b = bh >> 3, hh = bh & 7, x = u >> 5;
        const int nkeys = (16 - x) * 128;
        {
            const int tid = tid_opaque(), wid = tid >> 6, lane = tid & 63;
            float v[4];
#pragma unroll
            for (int j = 0; j < 4; ++j) { const int s = tid * 4 + j; v[j] = s < nkeys ? p.ls[((size_t)b * S + s) * 8 + hh] : 0.f; }
            v[1] += v[0]; v[2] += v[1]; v[3] += v[2];
            float incl = v[3];
#pragma unroll
            for (int o = 1; o < 64; o <<= 1) { const float t = __shfl_up(incl, o); if (lane >= o) incl += t; }
            if (lane == 63) wtot[wid] = incl;
            __syncthreads();
            float base = incl - v[3];
            for (int ww = 0; ww < wid; ++ww) base += wtot[ww];
#pragma unroll
            for (int j = 0; j < 4; ++j) cs[tid * 4 + j] = (base + v[j]) * 1.4426950408889634f;
            __syncthreads();
        }
        attn_block(p, stg, cs, b, hh, 15 - x);
        attn_block(p, stg, cs, b, hh, x);
    }
}

__device__ __forceinline__ void phase_gmlp_naive(const Params& p, char* lds, int vb, int nvb) {
    float* vn = (float*)lds;
    float* st = vn + 128 * 128;
    const int tid = tid_opaque(), wid = tid >> 6, lane = tid & 63;
    for (int u = vb; u < 512; u += nvb) {
        const int g = u & 7, bc = u >> 3;
        const size_t tok0 = (size_t)bc * 128;
        __syncthreads();
        for (int rr = 0; rr < 16; ++rr) {
            const int s = wid * 16 + rr;
            const bf16_t* vp = p.zg + (tok0 + s) * 2048 + 1024 + lane * 16;
            const u32x4 a = *(const u32x4*)vp, b = *(const u32x4*)(vp + 8);
            float sum = 0.f, sq = 0.f;
            const unsigned ww[8] = {a.x, a.y, a.z, a.w, b.x, b.y, b.z, b.w};
#pragma unroll
            for (int j = 0; j < 8; ++j) { const float lo = bf_lo(ww[j]), hi = bf_hi(ww[j]); sum += lo + hi; sq += lo * lo + hi * hi; }
            sum = wave_sum(sum); sq = wave_sum(sq);
            const float mean = sum * (1.0f / 1024.f); const float var = fmaxf(sq * (1.0f / 1024.f) - mean * mean, 0.f);
            if (lane == 0) { st[s * 2] = mean; st[s * 2 + 1] = rsqrtf(var + 1e-5f); }
        }
        __syncthreads();
        for (int idx = tid; idx < 128 * 16; idx += NTHREADS) {
            const int s = idx >> 4, dc = idx & 15;
            const u32x4 a = *(const u32x4*)(p.zg + (tok0 + s) * 2048 + 1024 + g * 128 + dc * 8);
            const float mean = st[s * 2], rstd = st[s * 2 + 1];
            const unsigned ww[4] = {a.x, a.y, a.z, a.w};
#pragma unroll
            for (int j = 0; j < 4; ++j) {
                const int c = g * 128 + dc * 8 + j * 2;
                vn[s * 128 + dc * 8 + j * 2]     = (bf_lo(ww[j]) - mean) * rstd * p.g_v_ln[c]     + p.b_v_ln[c];
                vn[s * 128 + dc * 8 + j * 2 + 1] = (bf_hi(ww[j]) - mean) * rstd * p.g_v_ln[c + 1] + p.b_v_ln[c + 1];
            }
        }
        __syncthreads();
        for (int rr = 0; rr < 16; ++rr) {
            const int t = wid * 16 + rr;
            const float* wrow = p.w_spatial + ((size_t)g * 128 + t) * 128;
            float a0 = 0.f, a1 = 0.f;
            for (int s = 0; s <= t; ++s) { const float w = wrow[s]; a0 += w * vn[s * 128 + lane]; a1 += w * vn[s * 128 + lane + 64]; }
            const float bs = p.b_spatial[g * 128 + t];
            const bf16_t* up = p.zg + (tok0 + t) * 2048 + g * 128;
            const float u0 = __uint_as_float((unsigned)up[lane] << 16), u1 = __uint_as_float((unsigned)up[lane + 64] << 16);
            bf16_t* op = p.sg + (tok0 + t) * GW + g * 128;
            op[lane] = (bf16_t)(cvt_pk_bf16(u0 * (a0 + bs), 0.f) & 0xffffu);
            op[lane + 64] = (bf16_t)(cvt_pk_bf16(u1 * (a1 + bs), 0.f) & 0xffffu);
        }
    }
    __syncthreads();
}

__device__ __forceinline__ void phase_gmlp(const Params& p, char* lds, int vb, int nvb) {
    float* st = (float*)lds;
    char* wimg = lds + 1024;
    char* vimg = lds + 1024 + 32768;
    const int tid = tid_opaque(), wid = tid >> 6, lane = tid & 63, fr = lane & 15, fq = lane >> 4;
    for (int u = vb; u < 512; u += nvb) {
        const int g = u & 7, bc = u >> 3;
        const size_t tok0 = (size_t)bc * 128;
        __syncthreads();
        if (tid < 128) {
            const float* pp = p.lnpart + (tok0 + tid) * 32;
            float sum = 0.f, sq = 0.f;
#pragma unroll
            for (int k = 0; k < 8; ++k) { const f32x4 t4 = *(const f32x4*)(pp + k * 4); sum += t4[0] + t4[2]; sq += t4[1] + t4[3]; }
            const float mean = sum * (1.0f / 1024.f); const float var = fmaxf(sq * (1.0f / 1024.f) - mean * mean, 0.f);
            st[tid * 2] = mean; st[tid * 2 + 1] = rsqrtf(var + 1e-5f);
        }
#pragma unroll
        for (int i = 0; i < 4; ++i) {
            const int q = tid + 512 * i, t = q >> 4, sc = q & 15;
            const float* wp = p.w_spatial + ((size_t)g * 128 + t) * 128 + sc * 8;
            const f32x4 w0 = *(const f32x4*)wp, w1 = *(const f32x4*)(wp + 4);
            float wv[8] = {w0[0], w0[1], w0[2], w0[3], w1[0], w1[1], w1[2], w1[3]};
#pragma unroll
            for (int j = 0; j < 8; ++j) wv[j] = (sc * 8 + j <= t) ? wv[j] : 0.f;
            u32x4 pk; pk.x = cvt_pk_bf16(wv[0], wv[1]); pk.y = cvt_pk_bf16(wv[2], wv[3]); pk.z = cvt_pk_bf16(wv[4], wv[5]); pk.w = cvt_pk_bf16(wv[6], wv[7]);
            *(u32x4*)(wimg + lds_byte_t<4>(t, sc * 8)) = pk;
        }
        __syncthreads();
        {
            const int vq4 = tid >> 4, vd8 = tid & 15;
            float vals[4][8];
            const f32x4 lg0 = *(const f32x4*)(p.g_v_ln + g * 128 + vd8 * 8), lg1 = *(const f32x4*)(p.g_v_ln + g * 128 + vd8 * 8 + 4);
            const f32x4 lb0 = *(const f32x4*)(p.b_v_ln + g * 128 + vd8 * 8), lb1 = *(const f32x4*)(p.b_v_ln + g * 128 + vd8 * 8 + 4);
            const float lgv[8] = {lg0[0], lg0[1], lg0[2], lg0[3], lg1[0], lg1[1], lg1[2], lg1[3]}, lbv[8] = {lb0[0], lb0[1], lb0[2], lb0[3], lb1[0], lb1[1], lb1[2], lb1[3]};
#pragma unroll
            for (int r = 0; r < 4; ++r) {
                const int s = 4 * vq4 + r;
                const u32x4 a = *(const u32x4*)(p.zg + (tok0 + s) * 2048 + 1024 + g * 128 + vd8 * 8);
                const float mean = st[s * 2], rstd = st[s * 2 + 1];
                const unsigned ww[4] = {a.x, a.y, a.z, a.w};
#pragma unroll
                for (int j = 0; j < 4; ++j) {
                    vals[r][2 * j] = (bf_lo(ww[j]) - mean) * rstd * lgv[2 * j] + lbv[2 * j];
                    vals[r][2 * j + 1] = (bf_hi(ww[j]) - mean) * rstd * lgv[2 * j + 1] + lbv[2 * j + 1];
                }
            }
#pragma unroll
            for (int dd = 0; dd < 8; ++dd) {
                u32x2 w_; w_.x = cvt_pk_bf16(vals[0][dd], vals[1][dd]); w_.y = cvt_pk_bf16(vals[2][dd], vals[3][dd]);
                *(u32x2*)(vimg + lds_byte_t<4>(vd8 * 8 + dd, 4 * vq4)) = w_;
            }
        }
        __syncthreads();
        f32x4 acc[8];
#pragma unroll
        for (int tt = 0; tt < 8; ++tt) acc[tt] = (f32x4){0.f, 0.f, 0.f, 0.f};
#pragma unroll
        for (int ks = 0; ks < 4; ++ks) {
            const bf16x8 Af = *(const bf16x8*)(vimg + lds_byte_t<4>(wid * 16 + fr, ks * 32 + fq * 8));
#pragma unroll
            for (int tt = 0; tt < 8; ++tt) {
                if (2 * ks <= tt) {
                    const bf16x8 Bf = *(const bf16x8*)(wimg + lds_byte_t<4>(tt * 16 + fr, ks * 32 + fq * 8));
                    acc[tt] = __builtin_amdgcn_mfma_f32_16x16x32_bf16(Af, Bf, acc[tt], 0, 0, 0);
                }
            }
        }
        u32x2 uu[8]; float bsv[8];
#pragma unroll
        for (int tt = 0; tt < 8; ++tt) { const int t = tt * 16 + fr; bsv[tt] = p.b_spatial[g * 128 + t]; uu[tt] = *(const u32x2*)(p.zg + (tok0 + t) * 2048 + g * 128 + wid * 16 + fq * 4); }
#pragma unroll
        for (int tt = 0; tt < 8; ++tt) {
            const int t = tt * 16 + fr; const float bs = bsv[tt];
            u32x2 w_; w_.x = cvt_pk_bf16(bf_lo(uu[tt].x) * (acc[tt][0] + bs), bf_hi(uu[tt].x) * (acc[tt][1] + bs)); w_.y = cvt_pk_bf16(bf_lo(uu[tt].y) * (acc[tt][2] + bs), bf_hi(uu[tt].y) * (acc[tt][3] + bs));
            *(u32x2*)(p.sg + (tok0 + t) * GW + g * 128 + wid * 16 + fq * 4) = w_;
        }
    }
    __syncthreads();
}

__device__ __forceinline__ void phase_branch(const Params& p, char* lds, int vb, int nvb) {
    for (int u = vb; u < 32 * 8; u += nvb) {
        const int pm = u >> 3, pn = u & 7;
        gemm_tile<D, false, false>(lds, p.attn, AW, nullptr, pm * 256, 256, p.w_ba + pn * 256, AW,
            [&](const f32x4 (&acc)[8][4], int wr, int wc, int fr, int fq) {
#pragma unroll
                for (int m = 0; m < 8; ++m) {
                    const size_t row = (size_t)pm * 256 + wr * 128 + m * 16 + fr;
#pragma unroll
                    for (int n = 0; n < 4; ++n) {
                        const int c = pn * 256 + wc * 64 + n * 16 + fq * 4;
                        const u32x2 gg = *(const u32x2*)(p.gates + row * 4096 + c);
                        f32x4 v = acc[m][n];
                        v[0] *= bf_lo(gg.x); v[1] *= bf_hi(gg.x); v[2] *= bf_lo(gg.y); v[3] *= bf_hi(gg.y);
                        *(f32x4*)(p.x1 + row * D + c) = v;
                    }
                }
            });
        gemm_tile<D, false, false>(lds, p.sg, GW, nullptr, pm * 256, 256, p.w_bg + pn * 256, GW,
            [&](const f32x4 (&acc)[8][4], int wr, int wc, int fr, int fq) {
#pragma unroll
                for (int m = 0; m < 8; ++m) {
                    const size_t row = (size_t)pm * 256 + wr * 128 + m * 16 + fr;
#pragma unroll
                    for (int n = 0; n < 4; ++n) {
                        const int c = pn * 256 + wc * 64 + n * 16 + fq * 4;
                        const u32x2 gg = *(const u32x2*)(p.gates + row * 4096 + 2048 + c);
                        const f32x4 prev = *(const f32x4*)(p.x1 + row * D + c);
                        f32x4 v = acc[m][n];
                        v[0] = prev[0] + v[0] * bf_lo(gg.x); v[1] = prev[1] + v[1] * bf_hi(gg.x); v[2] = prev[2] + v[2] * bf_lo(gg.y); v[3] = prev[3] + v[3] * bf_hi(gg.y);
                        u32x2 w; w.x = cvt_pk_bf16(v[0], v[1]); w.y = cvt_pk_bf16(v[2], v[3]);
                        *(u32x2*)(p.merged + row * D + c) = w;
                    }
                }
            });
    }
}

__device__ __forceinline__ void phase_outproj(const Params& p, char* lds, int vb, int nvb) {
    for (int u = vb; u < 32 * 8; u += nvb) {
        const int pm = u >> 3, pn = u & 7;
        gemm_tile<D, false, false>(lds, p.merged, D, nullptr, pm * 256, 256, p.w_out + pn * 256, D,
            [&](const f32x4 (&acc)[8][4], int wr, int wc, int fr, int fq) {
#pragma unroll
                for (int m = 0; m < 8; ++m) {
                    const size_t row = (size_t)pm * 256 + wr * 128 + m * 16 + fr;
#pragma unroll
                    for (int n = 0; n < 4; ++n) {
                        const int c = pn * 256 + wc * 64 + n * 16 + fq * 4;
                        const f32x4 xr = *(const f32x4*)(p.x + row * D + c);
                        *(f32x4*)(p.x1 + row * D + c) = xr + acc[m][n];
                    }
                }
            });
    }
}

__device__ __forceinline__ void phase_router(const Params& p, char* lds, int vb, int nvb) {
    constexpr int RS = 4112;
    char* img_hi = lds;
    char* img_lo = lds + 16 * RS;
    float* part = (float*)lds;
    float* logit = (float*)(lds + 32 * RS);
    int* cnt = (int*)(lds + 32 * RS + 16 * 32 * 4);
    const int tid = tid_opaque(), wid = tid >> 6, lane = tid & 63, fr = lane & 15, fq = lane >> 4;
    bf16x8 bh0[8], bl0[8], bh1[8], bl1[8];
#pragma unroll
    for (int ks = 0; ks < 8; ++ks) {
        const int k0 = wid * 256 + ks * 32 + fq * 8;
        bh0[ks] = *(const bf16x8*)(p.wr_hi + (size_t)fr * D + k0); bl0[ks] = *(const bf16x8*)(p.wr_lo + (size_t)fr * D + k0);
        bh1[ks] = *(const bf16x8*)(p.wr_hi + (size_t)(16 + fr) * D + k0); bl1[ks] = *(const bf16x8*)(p.wr_lo + (size_t)(16 + fr) * D + k0);
    }
    for (int c = vb; c < NCHUNK; c += nvb) {
        for (int pass = 0; pass < 2; ++pass) {
            __syncthreads();
#pragma unroll
            for (int i2 = 0; i2 < 2; ++i2) {
                const int tl = 2 * wid + i2, tok = c * 32 + pass * 16 + tl;
                const float* xr = p.x1 + (size_t)tok * D;
                f32x4 xv[8]; float ss = 0.f;
#pragma unroll
                for (int i = 0; i < 8; ++i) { xv[i] = *(const f32x4*)(xr + i * 256 + lane * 4); ss += xv[i][0] * xv[i][0] + xv[i][1] * xv[i][1] + xv[i][2] * xv[i][2] + xv[i][3] * xv[i][3]; }
                ss = wave_sum(ss);
                const float rstd = rsqrtf(ss * (1.0f / D) + 1e-5f);
#pragma unroll
                for (int i = 0; i < 8; ++i) {
                    const f32x4 g = *(const f32x4*)(p.g_ffn + i * 256 + lane * 4);
                    const f32x4 hv = xv[i] * rstd * g;
                    u32x2 hi; hi.x = cvt_pk_bf16(hv[0], hv[1]); hi.y = cvt_pk_bf16(hv[2], hv[3]);
                    *(unsigned*)((unsigned char*)p.h2 + (size_t)tok * D + i * 256 + lane * 4) = pack_fp8x4(hv[0], hv[1], hv[2], hv[3]);
                    u32x2 lo; lo.x = cvt_pk_bf16(hv[0] - bf_lo(hi.x), hv[1] - bf_hi(hi.x)); lo.y = cvt_pk_bf16(hv[2] - bf_lo(hi.y), hv[3] - bf_hi(hi.y));
                    *(u32x2*)(img_hi + tl * RS + (i * 256 + lane * 4) * 2) = hi;
                    *(u32x2*)(img_lo + tl * RS + (i * 256 + lane * 4) * 2) = lo;
                }
            }
            __syncthreads();
            f32x4 acc0 = {0.f, 0.f, 0.f, 0.f}, acc1 = {0.f, 0.f, 0.f, 0.f};
#pragma unroll
            for (int ks = 0; ks < 8; ++ks) {
                const int k0 = wid * 256 + ks * 32 + fq * 8;
                const bf16x8 ah = *(const bf16x8*)(img_hi + fr * RS + k0 * 2), al = *(const bf16x8*)(img_lo + fr * RS + k0 * 2);
                acc0 = __builtin_amdgcn_mfma_f32_16x16x32_bf16(al, bh0[ks], acc0, 0, 0, 0); acc0 = __builtin_amdgcn_mfma_f32_16x16x32_bf16(ah, bl0[ks], acc0, 0, 0, 0); acc0 = __builtin_amdgcn_mfma_f32_16x16x32_bf16(ah, bh0[ks], acc0, 0, 0, 0);
                acc1 = __builtin_amdgcn_mfma_f32_16x16x32_bf16(al, bh1[ks], acc1, 0, 0, 0); acc1 = __builtin_amdgcn_mfma_f32_16x16x32_bf16(ah, bl1[ks], acc1, 0, 0, 0); acc1 = __builtin_amdgcn_mfma_f32_16x16x32_bf16(ah, bh1[ks], acc1, 0, 0, 0);
            }
            __syncthreads();
#pragma unroll
            for (int r = 0; r < 4; ++r) { part[(wid * 16 + 4 * fq + r) * 32 + fr] = acc0[r]; part[(wid * 16 + 4 * fq + r) * 32 + 16 + fr] = acc1[r]; }
            if (pass == 0 && tid < 32) cnt[tid] = 0;
            __syncthreads();
            { const int tk2 = tid >> 5, e = tid & 31; float sacc = p.b_router[e];
#pragma unroll
              for (int ww = 0; ww < 8; ++ww) sacc += part[(ww * 16 + tk2) * 32 + e];
              logit[tk2 * 32 + e] = sacc; }
            __syncthreads();
            {
                const int tl = 2 * wid + (lane >> 5), e = lane & 31, tok = c * 32 + pass * 16 + tl;
                float val = logit[tl * 32 + e];
                float sv[4]; int si[4];
#pragma unroll
                for (int r = 0; r < 4; ++r) {
                    float mx = val;
#pragma unroll
                    for (int o = 16; o; o >>= 1) mx = fmaxf(mx, __shfl_xor(mx, o));
                    const unsigned long long bal = __ballot(val == mx);
                    const unsigned half = (unsigned)(lane >> 5 ? (bal >> 32) : (bal & 0xffffffffull));
                    const int idx = __ffs((int)half) - 1;
                    sv[r] = mx; si[r] = idx;
                    if (e == idx) val = -INFINITY;
                }
                const float e1 = __expf(sv[1] - sv[0]), e2 = __expf(sv[2] - sv[0]), e3 = __expf(sv[3] - sv[0]);
                const float inv = 1.0f / (1.0f + e1 + e2 + e3);
                if (e < 4) {
                    const int myi = e == 0 ? si[0] : e == 1 ? si[1] : e == 2 ? si[2] : si[3];
                    const float myg = (e == 0 ? 1.0f : e == 1 ? e1 : e == 2 ? e2 : e3) * inv;
                    p.top_idx[tok * 4 + e] = myi; p.top_gate[tok * 4 + e] = myg;
                    atomicAdd(&cnt[myi], 1);
                }
            }
        }
        __syncthreads();
        if (tid < 32) p.blk_cnt[c * 32 + tid] = cnt[tid];
    }
    __syncthreads();
}

__device__ __forceinline__ void phase_dispatch(const Params& p, char* lds, int vb, int nvb) {
    int* base = (int*)lds;
    int* tot = base + 32;
    int* start = tot + 32;
    int* tb = start + 32;
    int* red = tb + 64;
    int* idx = red + 16 * 32 * 2;
    const int tid = tid_opaque();
    for (int c = vb; c < NCHUNK; c += nvb) {
        __syncthreads();
        {
            const int e = tid & 31, part = tid >> 5;
            int total = 0, before = 0;
#pragma unroll 4
            for (int k = 0; k < 16; ++k) { const int cc = part * 16 + k; const int v = p.blk_cnt[cc * 32 + e]; total += v; before += (cc < c) ? v : 0; }
            red[(part * 32 + e) * 2] = total; red[(part * 32 + e) * 2 + 1] = before;
        }
        if (tid < 128) idx[tid] = p.top_idx[c * 128 + tid];
        __syncthreads();
        if (tid < 32) {
            int total = 0, before = 0;
#pragma unroll
            for (int k = 0; k < 16; ++k) { total += red[(k * 32 + tid) * 2]; before += red[(k * 32 + tid) * 2 + 1]; }
            int incl = total;
#pragma unroll
            for (int o = 1; o < 32; o <<= 1) { const int t = __shfl_up(incl, o); if (tid >= o) incl += t; }
            const int st = incl - total;
            base[tid] = st + before; tot[tid] = total; start[tid] = st;
        }
        __syncthreads();
        if (c == vb) {
            if (tid == 0) {
                int n = 0;
                for (int e = 0; e < NE; ++e) { tb[e] = n; n += (tot[e] + 255) >> 8; }
                tb[NE] = n; if (vb == 0) p.ntiles[0] = n;
            }
            __syncthreads();
            const int ntl = tb[NE];
            for (int w = vb * NTHREADS + tid; w < ntl * 16; w += (nvb < NCHUNK ? nvb : NCHUNK) * NTHREADS) { int e = 0; while (16 * tb[e + 1] <= w) ++e; const int Te = tb[e + 1] - tb[e], r = w - 16 * tb[e]; const int mt = r % Te, cntv = tot[e]; p.unit_up[2 * w] = (e << 24) | ((r / Te) << 16) | (tb[e] + mt); p.unit_up[2 * w + 1] = (start[e] + mt * 256) | (min(256, cntv - mt * 256) << 16); }
            for (int w = vb * NTHREADS + tid; w < ntl * 8; w += (nvb < NCHUNK ? nvb : NCHUNK) * NTHREADS) { int e = 0; while (8 * tb[e + 1] <= w) ++e; const int Te = tb[e + 1] - tb[e], r = w - 8 * tb[e]; const int mt = r % Te, cntv = tot[e]; p.unit_down[2 * w] = (e << 24) | ((r / Te) << 16) | (tb[e] + mt); p.unit_down[2 * w + 1] = (start[e] + mt * 256) | (min(256, cntv - mt * 256) << 16); }
        }
        if (tid < 128) {
            const int e = idx[tid];
            int rank = 0;
            for (int j = 0; j < tid; ++j) rank += (idx[j] == e) ? 1 : 0;
            const int row = base[e] + rank, a = c * 128 + tid;
            p.row_tok[row] = a >> 2; p.row_dst[row] = a; p.row_gate[row] = p.top_gate[a];
        }
    }
    __syncthreads();
}

__device__ __forceinline__ void phase_moe_up(const Params& p, char* lds, int vb, int nvb) {
    const int nt = p.ntiles[0];
    for (int u = vb; u < nt * 16; u += nvb) {
        const int tile = u >> 4, pn = u & 15;
        const int e = p.tile_e[tile], row0 = p.tile_row0[tile], nv = p.tile_nrows[tile];
        gemm_tile<2 * DFF, true, true>(lds, p.h2, D, p.row_tok, row0, nv, p.w_up + (size_t)e * D * (2 * DFF) + pn * 256, D,
            [&](const f32x4 (&acc)[8][4], int wr, int wc, int fr, int fq) {
#pragma unroll
                for (int m = 0; m < 8; ++m) {
                    const int r = tile_row<true>(wr, m, fr);
                    if (r < nv) {
#pragma unroll
                        for (int n = 0; n < 4; ++n) {
                            const int c = pn * 256 + wc * 64 + n * 16 + fq * 4;
                            const f32x4 bb = *(const f32x4*)(p.b_up + (size_t)e * (2 * DFF) + c);
                            const f32x4 v = acc[m][n] + bb;
                            const float g0 = fminf(v[0], 7.f), l0 = fminf(fmaxf(v[1], -7.f), 7.f);
                            const float g1 = fminf(v[2], 7.f), l1 = fminf(fmaxf(v[3], -7.f), 7.f);
                            const float a0 = g0 * sigmoidf_(1.702f * g0) * (l0 + 1.0f), a1 = g1 * sigmoidf_(1.702f * g1) * (l1 + 1.0f);
                            *(unsigned*)(p.act + (size_t)(row0 + r) * DFF + (c >> 1)) = cvt_pk_bf16(a0, a1);
                        }
                    }
                }
            });
    }
}

__device__ __forceinline__ void phase_moe_down(const Params& p, char* lds, int vb, int nvb) {
    const int nt = p.ntiles[0];
    for (int u = vb; u < nt * 8; u += nvb) {
        const int tile = u >> 3, pn = u & 7;
        const int e = p.tile_e[tile], row0 = p.tile_row0[tile], nv = p.tile_nrows[tile];
        gemm_tile<D, false, true>(lds, p.act, DFF, nullptr, row0, nv, p.w_down + (size_t)e * DFF * D + pn * 256, DFF,
            [&](const f32x4 (&acc)[8][4], int wr, int wc, int fr, int fq) {
#pragma unroll
                for (int m = 0; m < 8; ++m) {
                    const int r = tile_row<true>(wr, m, fr);
                    if (r < nv) {
                        const float gate = p.row_gate[row0 + r];
                        const size_t dst = (size_t)p.row_dst[row0 + r] * D;
#pragma unroll
                        for (int n = 0; n < 4; ++n) {
                            const int c = pn * 256 + wc * 64 + n * 16 + fq * 4;
                            const f32x4 bb = *(const f32x4*)(p.b_down + (size_t)e * D + c);
                            const f32x4 v = (acc[m][n] + bb) * gate;
                            u32x2 w; w.x = cvt_pk_bf16(v[0], v[1]); w.y = cvt_pk_bf16(v[2], v[3]);
                            *(u32x2*)(p.y + dst + c) = w;
                        }
                    }
                }
            });
    }
}

__device__ __forceinline__ void phase_final(const Params& p, char* lds, int vb, int nvb) {
    const int tid = tid_opaque(), wid = tid >> 6, lane = tid & 63;
    for (int tok = vb * 8 + wid; tok < T; tok += nvb * 8) {
        f32x4 xv[8]; float ss = 0.f;
#pragma unroll
        for (int i = 0; i < 8; ++i) {
            f32x4 v = *(const f32x4*)(p.x1 + (size_t)tok * D + i * 256 + lane * 4);
#pragma unroll
            for (int j = 0; j < 4; ++j) {
                const u32x2 yy = *(const u32x2*)(p.y + ((size_t)tok * 4 + j) * D + i * 256 + lane * 4);
                v[0] += bf_lo(yy.x); v[1] += bf_hi(yy.x); v[2] += bf_lo(yy.y); v[3] += bf_hi(yy.y);
            }
            xv[i] = v; ss += v[0] * v[0] + v[1] * v[1] + v[2] * v[2] + v[3] * v[3];
        }
        ss = wave_sum(ss);
        const float rstd = rsqrtf(ss * (1.0f / D) + 1e-5f);
#pragma unroll
        for (int i = 0; i < 8; ++i) {
            const f32x4 g = *(const f32x4*)(p.g_final + i * 256 + lane * 4);
            *(f32x4*)(p.out + (size_t)tok * D + i * 256 + lane * 4) = xv[i] * rstd * g;
        }
    }
}

template <int MODE>
__global__ void __launch_bounds__(NTHREADS, 2) k_fwd(Params p_kernarg) {
    extern __shared__ __attribute__((aligned(1024))) char lds[];
    const Params& p = *(const Params*)__builtin_amdgcn_kernarg_segment_ptr();
    const int vb = blockIdx.x, nvb = gridDim.x;
    XcdBarrier bar;
    if (MODE < 0) {
        volatile LAS unsigned* st = (volatile LAS unsigned*)(lds + LDS_BYTES - 16);
        if (threadIdx.x == 0) { st[0] = 0u; st[1] = 0u; st[2] = 0u; st[3] = 0u; }
        __syncthreads();
        bar = xcd_barrier_post(p.bar, st);
    }
#ifndef PROBE_MASK
#define PROBE_MASK 0
#endif
#define PHASE(i, call) if (MODE < 0 || MODE == (i)) { call; } if (MODE < 0) xcd_barrier(bar); if (MODE < 0 && ((PROBE_MASK >> (i)) & 1)) { call; xcd_barrier(bar); }
    PHASE(0, (phase_prologue(p, lds, vb, nvb), phase_convert_dense(p, lds, vb, nvb)))
    PHASE(1, phase_inproj_conv(p, lds, vb, nvb))
    PHASE(2, (phase_attn(p, lds, vb, nvb), phase_gmlp(p, lds, vb, nvb)))
    PHASE(3, phase_branch8(p, lds, vb, nvb))
    PHASE(4, phase_outproj8(p, lds, vb, nvb))
    PHASE(5, phase_router(p, lds, vb, nvb))
    PHASE(6, phase_dispatch(p, lds, vb, nvb))
    PHASE(7, phase_moe_up8(p, lds, vb, nvb))
    PHASE(8, phase_moe_down8(p, lds, vb, nvb))
    if (MODE < 0 || MODE == 9) phase_final(p, lds, vb, nvb);
}

template <int MODE> static void launch_phase(const Params& p, int grid, hipStream_t stream) {
    static bool attr = false;
    if (!attr) { (void)hipFuncSetAttribute((const void*)k_fwd<MODE>, hipFuncAttributeMaxDynamicSharedMemorySize, LDS_BYTES); attr = true; }
    hipLaunchKernelGGL(k_fwd<MODE>, dim3(grid), dim3(NTHREADS), LDS_BYTES, stream, p);
}

extern "C" void kernel_launch(void* const* d_in, const int* in_sizes, int n_in, void* d_out, int out_size, void* d_ws, size_t ws_size, hipStream_t stream) {
    Params p; memset(&p, 0, sizeof(p));
    const float* const* in = (const float* const*)d_in;
    p.x = in[0]; p.g_mix = in[1]; p.w_in = in[2]; p.b_forget = in[3]; p.g_v_ln = in[4]; p.b_v_ln = in[5]; p.w_spatial = in[6]; p.b_spatial = in[7];
    p.w_ba = in[8]; p.w_bg = in[9]; p.w_out = in[10]; p.g_ffn = in[11]; p.w_router = in[12]; p.b_router = in[13];
    p.w_up = in[14]; p.b_up = in[15]; p.w_down = in[16]; p.b_down = in[17]; p.g_final = in[18];
    p.out = (float*)d_out;
    char* w = (char*)d_ws; size_t off = 0;
    auto take = [&](size_t bytes) { char* r = w + off; off += (bytes + 255) & ~(size_t)255; return r; };
    p.bar = (unsigned*)take(XCD_BAR_WORDS * 4);
    p.h = (bf16_t*)take((size_t)T * D * 2);
    p.q = (bf16_t*)take((size_t)T * AW * 2); p.k = (bf16_t*)take((size_t)T * AW * 2); p.v = (bf16_t*)take((size_t)T * AW * 2);
    p.zg = (bf16_t*)take((size_t)T * 2048 * 2); p.gates = (bf16_t*)take((size_t)T * 4096 * 2);
    p.attn = (bf16_t*)take((size_t)T * AW * 2); p.sg = (bf16_t*)take((size_t)T * GW * 2);
    p.merged = (bf16_t*)take((size_t)T * D * 2); p.h2 = (bf16_t*)take((size_t)T * D * 2);
    p.h8 = (unsigned char*)take((size_t)T * D); p.wb_in8 = (unsigned char*)take((size_t)9216 * D);
    p.wr_hi = (bf16_t*)take((size_t)NE * D * 2); p.wr_lo = (bf16_t*)take((size_t)NE * D * 2);
    p.act = (bf16_t*)take((size_t)T * 4 * DFF * 2); p.y = (bf16_t*)take((size_t)T * 4 * D * 2);
    p.wb_in = (bf16_t*)take((size_t)9216 * D * 2); p.wb_ba = (bf16_t*)take((size_t)D * AW * 2); p.wb_bg = (bf16_t*)take((size_t)D * GW * 2); p.wb_out = (bf16_t*)take((size_t)D * D * 2);
    p.wb_up = (bf16_t*)take((size_t)NE * 2 * DFF * D * 2); p.wb_down = (bf16_t*)take((size_t)NE * D * DFF * 2);
    p.ls = (float*)take((size_t)T * 8 * 4); p.lnpart = (float*)take((size_t)T * 16 * 2 * 4); p.x1 = (float*)take((size_t)T * D * 4);
    p.top_gate = (float*)take((size_t)T * 4 * 4); p.row_gate = (float*)take((size_t)T * 4 * 4);
    p.top_idx = (int*)take((size_t)T * 4 * 4); p.blk_cnt = (int*)take((size_t)NCHUNK * 32 * 4);
    p.row_tok = (int*)take((size_t)T * 4 * 4); p.row_dst = (int*)take((size_t)T * 4 * 4);
    p.tile_e = (int*)take(MAXTILES * 4); p.tile_row0 = (int*)take(MAXTILES * 4); p.tile_nrows = (int*)take(MAXTILES * 4); p.ntiles = (int*)take(256); p.unit_up = (int*)take(MAXTILES * 16 * 8); p.unit_down = (int*)take(MAXTILES * 8 * 8);
#if MK_SINGLE
    static int grid = 0;
    if (!grid) {
        int dev = 0, cus = 0, per_cu = 0;
        (void)hipGetDevice(&dev);
        (void)hipDeviceGetAttribute(&cus, hipDeviceAttributeMultiprocessorCount, dev);
        (void)hipFuncSetAttribute((const void*)k_fwd<-1>, hipFuncAttributeMaxDynamicSharedMemorySize, LDS_BYTES);
        (void)hipOccupancyMaxActiveBlocksPerMultiprocessor(&per_cu, k_fwd<-1>, NTHREADS, LDS_BYTES);
        if (cus <= 0) cus = 256;
        grid = cus * (per_cu < 1 ? 1 : 1);
    }
    (void)hipMemsetAsync(p.bar, 0, XCD_BAR_WORDS * 4, stream);
    launch_phase<-1>(p, grid, stream);
#else
    launch_phase<0>(p, 256, stream); launch_phase<1>(p, 256, stream); launch_phase<2>(p, 256, stream); launch_phase<3>(p, 256, stream);
    launch_phase<4>(p, 256, stream); launch_phase<5>(p, 256, stream); launch_phase<6>(p, 256, stream); launch_phase<7>(p, 256, stream);
    launch_phase<8>(p, 256, stream); launch_phase<9>(p, 256, stream);
#endif
}
```

```cpp
#include <hip/hip_runtime.h>
#include <stdint.h>
#include <string.h>
#include <stdio.h>

#ifndef MK_SINGLE
#define MK_SINGLE 1
#endif

typedef unsigned short bf16_t;
typedef short bf16x8 __attribute__((ext_vector_type(8)));
typedef float f32x4 __attribute__((ext_vector_type(4)));
typedef float f32x2 __attribute__((ext_vector_type(2)));
typedef unsigned u32x4 __attribute__((ext_vector_type(4)));
typedef unsigned u32x2 __attribute__((ext_vector_type(2)));
typedef int i32x4 __attribute__((ext_vector_type(4)));
typedef int i32x8 __attribute__((ext_vector_type(8)));

constexpr int D = 2048, NB = 4, S = 2048, T = NB * S, H = 8, DH = 128, AW = 1024, GW = 1024, PW = 9224, NE = 32, DFF = 2048;
constexpr int PN_SPLIT = 20;
constexpr int NCHUNK = 256;
constexpr int MAXTILES = 192;
constexpr int NTHREADS = 512;
constexpr int LDS_BYTES = 144 * 1024;

#define XB_TMO      128
#define XB_XCNT(j)  (256  + 64 * (j))
#define XB_XSUB(j)  (1280 + 64 * (j))
#define XB_XGEN(j)  (2304 + 64 * (j))
#define XB_TOP      3328
#define XB_TOPGEN   3392
#define XCD_BAR_WORDS 3456
#define XB_SPIN_CAP (1u << 22)
#define LAS __attribute__((address_space(3)))

__device__ __forceinline__ unsigned xb_ld(unsigned* p)              { return __hip_atomic_load(p, __ATOMIC_RELAXED, __HIP_MEMORY_SCOPE_AGENT); }
__device__ __forceinline__ unsigned xb_add(unsigned* p, unsigned v) { return __hip_atomic_fetch_add(p, v, __ATOMIC_RELAXED, __HIP_MEMORY_SCOPE_AGENT); }
__device__ __forceinline__ unsigned xb_xcc_id() { return (unsigned)__builtin_amdgcn_s_getreg((3 << 11) | 20) & 0xFu; }
#define XB_SPIN(cond, bar) do { unsigned _sp = 0; while (cond) { __builtin_amdgcn_s_sleep(1); \
    if ((++_sp & 255u) == 0u) { if (xb_ld(&(bar)[XB_TMO])) break; if (_sp > XB_SPIN_CAP) { atomicAdd(&(bar)[XB_TMO], 1u); break; } } } } while (0)

struct XcdBarrier { unsigned* bar; unsigned x; volatile LAS unsigned* st; };

__device__ __forceinline__ XcdBarrier xcd_barrier_post(unsigned* bar, volatile LAS unsigned* st) {
    XcdBarrier b; b.bar = bar; b.x = xb_xcc_id(); b.st = st;
    if (threadIdx.x == 0) (void)xb_add(&bar[XB_XCNT(b.x)], 1u);
    return b;
}
__device__ __forceinline__ void xcd_barrier_complete(unsigned* bar, unsigned x, unsigned& nloc, unsigned& nx) {
    const unsigned G = gridDim.x * gridDim.y * gridDim.z;
    unsigned sum, cnt, mine, sp = 0u;
    for (;;) {
        sum = 0u; cnt = 0u; mine = 0u;
#pragma unroll
        for (unsigned j = 0; j < 16; ++j) { const unsigned c = xb_ld(&bar[XB_XCNT(j)]); sum += c; cnt += (c > 0u) ? 1u : 0u; mine = (j == x) ? c : mine; }
        if (sum == G) break;
        __builtin_amdgcn_s_sleep(1);
        if ((++sp & 255u) == 0u) { if (xb_ld(&bar[XB_TMO])) break; if (sp > XB_SPIN_CAP) { atomicAdd(&bar[XB_TMO], 1u); break; } }
    }
    nloc = mine > 0u ? mine : 1u; nx = cnt > 0u ? cnt : 1u;
}
__device__ __forceinline__ void xcd_barrier(const XcdBarrier& b) {
    asm volatile("s_waitcnt vmcnt(0)" ::: "memory");
    __syncthreads();
    if (threadIdx.x == 0) {
        unsigned* bar = b.bar;
        __builtin_amdgcn_s_waitcnt(0);
        unsigned nloc = b.st[0], nx = b.st[1];
        if (nloc == 0u) { xcd_barrier_complete(bar, b.x, nloc, nx); b.st[0] = nloc; b.st[1] = nx; }
        const unsigned old = xb_add(&bar[XB_XSUB(b.x)], 1u);
        const unsigned gen = old / nloc;
        if (old + 1u == (gen + 1u) * nloc) {
            __builtin_amdgcn_fence(__ATOMIC_RELEASE, "agent");
            asm volatile("s_waitcnt vmcnt(0)" ::: "memory");
            const unsigned og = xb_add(&bar[XB_TOP], 1u);
            const unsigned tg = og / nx;
            if (og + 1u == (tg + 1u) * nx) xb_add(&bar[XB_TOPGEN], 1u);
            else XB_SPIN(xb_ld(&bar[XB_TOPGEN]) == tg, bar);
            __builtin_amdgcn_fence(__ATOMIC_ACQUIRE, "agent");
            xb_add(&bar[XB_XGEN(b.x)], 1u);
            asm volatile("s_waitcnt vmcnt(0)" ::: "memory");
        } else {
            XB_SPIN(xb_ld(&bar[XB_XGEN(b.x)]) == gen, bar);
            __builtin_amdgcn_fence(__ATOMIC_ACQUIRE, "agent");
            asm volatile("s_waitcnt vmcnt(0)" ::: "memory");
        }
    }
    __syncthreads();
}

struct Params {
    const float *x, *g_mix, *w_in, *b_forget, *g_v_ln, *b_v_ln, *w_spatial, *b_spatial, *w_ba, *w_bg, *w_out, *g_ffn, *w_router, *b_router,
                *w_up, *b_up, *w_down, *b_down, *g_final;
    float* out;
    bf16_t *h, *q, *k, *v, *zg, *gates, *attn, *sg, *merged, *h2, *act, *y;
    bf16_t *wb_in, *wb_ba, *wb_bg, *wb_out, *wb_up, *wb_down, *wr_hi, *wr_lo;
    unsigned char *h8, *wb_in8;
    float *ls, *x1, *top_gate, *row_gate, *lnpart; bf16_t* x1b;
    int *top_idx, *blk_cnt, *row_tok, *row_dst, *tile_e, *tile_row0, *tile_nrows, *ntiles, *unit_up, *unit_down;
    unsigned* bar;
};

typedef __bf16 bf16x2_t __attribute__((ext_vector_type(2)));
__device__ __forceinline__ unsigned cvt_pk_bf16_mfma(float lo, float hi) { const f32x2 v = {lo, hi}; return __builtin_bit_cast(unsigned, __builtin_convertvector(v, bf16x2_t)); }
__device__ __forceinline__ unsigned cvt_pk_bf16(float lo, float hi) { unsigned r; asm("v_cvt_pk_bf16_f32 %0, %1, %2" : "=v"(r) : "v"(lo), "v"(hi)); return r; }
__device__ __forceinline__ int tid_opaque() { int t = threadIdx.x; asm volatile("" : "+v"(t)); return t; }
__device__ __forceinline__ float bf_lo(unsigned u) { return __uint_as_float(u << 16); }
__device__ __forceinline__ float bf_hi(unsigned u) { return __uint_as_float(u & 0xffff0000u); }
__device__ __forceinline__ float wave_sum(float v) {
#pragma unroll
    for (int o = 32; o; o >>= 1) v += __shfl_xor(v, o);
    return v; }
__device__ __forceinline__ float wave_max(float v) {
#pragma unroll
    for (int o = 32; o; o >>= 1) v = fmaxf(v, __shfl_xor(v, o));
    return v; }
__device__ __forceinline__ float sigmoidf_(float x) { return __builtin_amdgcn_rcpf(1.0f + __builtin_amdgcn_exp2f(-1.44269504f * x)); }
__device__ __forceinline__ float log_sigmoid(float x) { return fminf(x, 0.f) - log1pf(__expf(-fabsf(x))); }
__device__ __forceinline__ float gelu_erf(float v) { return 0.5f * v * (1.0f + erff(v * 0.70710678118654752f)); }

template <class Epi>
__device__ __forceinline__ void gemm_tile_naive(const bf16_t* __restrict__ A, int lda, const int* __restrict__ rowmap, int row0, int nvalid,
                                                const float* __restrict__ Bm, int ldb, int K, Epi&& epi) {
    const int tid = tid_opaque(), wid = tid >> 6, lane = tid & 63, wr = wid >> 2, wc = wid & 3, fr = lane & 15, fq = lane >> 4;
    const bf16_t* arow[8];
#pragma unroll
    for (int m = 0; m < 8; ++m) {
        int r = wr * 128 + m * 16 + fr; if (r >= nvalid) r = 0;
        const int gr = rowmap ? rowmap[row0 + r] : row0 + r;
        arow[m] = A + (size_t)gr * lda + fq * 8;
    }
    f32x4 acc[8][4];
#pragma unroll
    for (int m = 0; m < 8; ++m)
#pragma unroll
        for (int n = 0; n < 4; ++n) acc[m][n] = (f32x4){0.f, 0.f, 0.f, 0.f};
    for (int k0 = 0; k0 < K; k0 += 32) {
        bf16x8 At[8], Bf[4];
#pragma unroll
        for (int m = 0; m < 8; ++m) At[m] = *(const bf16x8*)(arow[m] + k0);
#pragma unroll
        for (int n = 0; n < 4; ++n) {
            const float* bp = Bm + (size_t)(k0 + fq * 8) * ldb + wc * 64 + n * 16 + fr;
            float v[8];
#pragma unroll
            for (int i = 0; i < 8; ++i) v[i] = bp[(size_t)i * ldb];
            u32x4 w; w.x = cvt_pk_bf16_mfma(v[0], v[1]); w.y = cvt_pk_bf16_mfma(v[2], v[3]); w.z = cvt_pk_bf16_mfma(v[4], v[5]); w.w = cvt_pk_bf16_mfma(v[6], v[7]);
            Bf[n] = __builtin_bit_cast(bf16x8, w);
        }
#pragma unroll
        for (int m = 0; m < 8; ++m)
#pragma unroll
            for (int n = 0; n < 4; ++n) acc[m][n] = __builtin_amdgcn_mfma_f32_16x16x32_bf16(Bf[n], At[m], acc[m][n], 0, 0, 0);
    }
    epi(acc, wr, wc, fr, fq);
}

template <bool MASKM> __device__ __forceinline__ int tile_row(int wr, int m, int fr) { return MASKM ? m * 32 + wr * 16 + fr : wr * 128 + m * 16 + fr; }
__device__ __forceinline__ int lds_byte(int r, int c) { const int st = (r >> 4) * 2 + (c >> 5), ob = (r & 15) * 64 + (c & 31) * 2; return st * 1024 + (ob ^ (((ob >> 9) & 1) << 5)); }
#define SCHED() __builtin_amdgcn_sched_barrier(0)

template <int LDB, bool GATHER, bool MASKM, class Epi>
__device__ __forceinline__ void gemm_tile(char* lds, const bf16_t* __restrict__ A, int lda, const int* __restrict__ rowmap, int row0, int nvalid,
                                          const float* __restrict__ Bm, int K, Epi&& epi) {
    constexpr int TILE_B = 256 * 64 * 2, STAGE_B = 2 * TILE_B;
    const int tid = tid_opaque(), wid = tid >> 6, lane = tid & 63, wr = wid >> 2, wc = wid & 3, fr = lane & 15, fq = lane >> 4;
    const int a_col = (wid & 1) * 32 + (((lane & 3) ^ ((lane >> 5) << 1)) << 3);
    unsigned aoff[4];
#pragma unroll
    for (int i = 0; i < 4; ++i) {
        const int R = ((wid >> 1) + 4 * i) * 16 + (lane >> 2);
        int r = MASKM ? ((R >> 4) & 7) * 32 + (R >> 7) * 16 + (R & 15) : R;
        if (MASKM && r >= nvalid) r = 0;
        const int gr = GATHER ? rowmap[row0 + r] : row0 + r;
        aoff[i] = (unsigned)gr * (unsigned)lda + (unsigned)a_col;
    }
    const int kq = lane & 3, nl = lane >> 2, kh = wid & 1, ng = wid >> 1;
    const unsigned bofs = (unsigned)((kh * 32 + kq * 8) * LDB + ng * 64 + nl * 4);
    const int boff0 = ((4 * ng + (nl >> 2)) * 2 + kh) * 1024 + ((((nl & 3) * 4) * 64 + kq * 16) ^ (((nl & 3) >> 1) << 5));
    const int mvalid = MASKM ? max(0, min(8, (nvalid - wr * 16 + 31) >> 5)) : 8;
    f32x4 acc[8][4];
#pragma unroll
    for (int m = 0; m < 8; ++m)
#pragma unroll
        for (int n = 0; n < 4; ++n) acc[m][n] = (f32x4){0.f, 0.f, 0.f, 0.f};
    u32x4 sa[4]; f32x4 sb[8];
#define G_ISSUE(kt) do { const bf16_t* Ak_ = A + (kt) * 64; const float* Bk_ = Bm + (size_t)(kt) * 64 * LDB; unsigned bo_ = bofs; asm volatile("" : "+v"(bo_)); \
        _Pragma("unroll") for (int i = 0; i < 4; ++i) sa[i] = *(const u32x4*)(Ak_ + aoff[i]); \
        _Pragma("unroll") for (int i = 0; i < 8; ++i) sb[i] = *(const f32x4*)(Bk_ + (bo_ + (unsigned)(i * LDB))); SCHED(); } while (0)
#define G_WRITE(buf) do { char* sA_ = lds + (buf) * STAGE_B; char* sB_ = sA_ + TILE_B; \
        _Pragma("unroll") for (int i = 0; i < 4; ++i) *(u32x4*)(sA_ + wid * 1024 + i * 8192 + lane * 16) = sa[i]; \
        _Pragma("unroll") for (int j = 0; j < 4; ++j) { u32x4 w_; w_.x = cvt_pk_bf16(sb[0][j], sb[1][j]); w_.y = cvt_pk_bf16(sb[2][j], sb[3][j]); \
            w_.z = cvt_pk_bf16(sb[4][j], sb[5][j]); w_.w = cvt_pk_bf16(sb[6][j], sb[7][j]); *(u32x4*)(sB_ + boff0 + j * 64) = w_; } } while (0)
#define G_KSTEP(buf, ks) do { const char* sA_ = lds + (buf) * STAGE_B; const char* sB_ = sA_ + TILE_B; bf16x8 Bf[4]; \
        _Pragma("unroll") for (int n = 0; n < 4; ++n) Bf[n] = *(const bf16x8*)(sB_ + lds_byte(wc * 64 + n * 16 + fr, (ks) * 32 + fq * 8)); \
        _Pragma("unroll") for (int mh = 0; mh < 2; ++mh) { if (!MASKM || mh * 4 < mvalid) { bf16x8 At[4]; \
            _Pragma("unroll") for (int m = 0; m < 4; ++m) At[m] = *(const bf16x8*)(sA_ + lds_byte(wr * 128 + (mh * 4 + m) * 16 + fr, (ks) * 32 + fq * 8)); \
            _Pragma("unroll") for (int m = 0; m < 4; ++m) { \
                _Pragma("unroll") for (int n = 0; n < 4; ++n) acc[mh * 4 + m][n] = __builtin_amdgcn_mfma_f32_16x16x32_bf16(Bf[n], At[m], acc[mh * 4 + m][n], 0, 0, 0); } } \
            SCHED(); } } while (0)
    const int nt = K / 64;
    G_ISSUE(0); G_WRITE(0); G_ISSUE(1); __syncthreads();
    for (int t = 0; t < nt; ++t) {
        const int cur = t & 1;
        if (t + 1 < nt) G_WRITE(cur ^ 1);
        if (t + 2 < nt) G_ISSUE(t + 2);
        G_KSTEP(cur, 0); G_KSTEP(cur, 1);
        __syncthreads();
    }
#undef G_ISSUE
#undef G_WRITE
#undef G_KSTEP
    epi(acc, wr, wc, fr, fq);
}

__device__ __forceinline__ void conv_tiles(char* lds, const float* __restrict__ src, int ldsrc, bf16_t* __restrict__ dst, int K, int nkt, int t_begin, int t_end, bool shift8, int vb, int nvb, int nnt = 1 << 30, size_t mstride = 0) {
    const int tid = tid_opaque(), w = tid >> 6, lane = tid & 63;
    f32x4 v0[8], v1[8], n0[8], n1[8], m0[8], m1[8];
    int t = t_begin + vb;
    if (t >= t_end) return;
#define CV_LOAD(dstv, tt) do { const int kt_ = (tt) % nkt, nt_ = (tt) / nkt, e_ = nt_ / nnt, ntl_ = nt_ % nnt; \
        const float* s_ = src + (size_t)e_ * mstride + (size_t)(kt_ * 64 + w * 8) * ldsrc + ntl_ * 256 + ((shift8 && nt_ >= 12) ? 8 : 0) + lane * 4; \
        _Pragma("unroll") for (int i = 0; i < 8; ++i) dstv[i] = __builtin_nontemporal_load((const f32x4*)(s_ + (size_t)i * ldsrc)); } while (0)
#define CV_PUT(srcv, buf) do { _Pragma("unroll") for (int j = 0; j < 4; ++j) { u32x4 pk; pk.x = cvt_pk_bf16(srcv[0][j], srcv[1][j]); pk.y = cvt_pk_bf16(srcv[2][j], srcv[3][j]); \
        pk.z = cvt_pk_bf16(srcv[4][j], srcv[5][j]); pk.w = cvt_pk_bf16(srcv[6][j], srcv[7][j]); *(u32x4*)(lds + (buf) * 32768 + (lane * 4 + j) * 128 + ((w ^ (lane & 7)) << 4)) = pk; } } while (0)
#define CV_OUT(tt, buf) do { const int kt_ = (tt) % nkt, nt_ = (tt) / nkt; bf16_t* d_ = dst + (size_t)nt_ * 256 * K + kt_ * 64; \
        _Pragma("unroll") for (int r = 0; r < 4; ++r) { const int c_ = r * 512 + tid, n_ = c_ >> 3, kc_ = c_ & 7; \
            __builtin_nontemporal_store(*(const u32x4*)(lds + (buf) * 32768 + n_ * 128 + ((kc_ ^ ((n_ >> 2) & 7)) << 4)), (u32x4*)(d_ + (size_t)n_ * K + kc_ * 8)); } } while (0)
    CV_LOAD(v0, t); if (t + nvb < t_end) CV_LOAD(v1, t + nvb);
    if (t + 2 * nvb < t_end) CV_LOAD(n0, t + 2 * nvb);
    if (t + 3 * nvb < t_end) CV_LOAD(n1, t + 3 * nvb);
    for (; t < t_end; t += 2 * nvb) {
        const bool two = t + nvb < t_end;
        if (t + 4 * nvb < t_end) CV_LOAD(m0, t + 4 * nvb);
        if (t + 5 * nvb < t_end) CV_LOAD(m1, t + 5 * nvb);
        __syncthreads();
        CV_PUT(v0, 0); if (two) CV_PUT(v1, 1);
        __syncthreads();
        CV_OUT(t, 0); if (two) CV_OUT(t + nvb, 1);
#pragma unroll
        for (int i = 0; i < 8; ++i) { v0[i] = n0[i]; v1[i] = n1[i]; n0[i] = m0[i]; n1[i] = m1[i]; }
    }
#undef CV_LOAD
#undef CV_PUT
#undef CV_OUT
    __syncthreads();
}

__device__ __forceinline__ unsigned pack_fp8x4(float a, float b, float c, float d) {
    a = fminf(fmaxf(a, -448.f), 448.f); b = fminf(fmaxf(b, -448.f), 448.f); c = fminf(fmaxf(c, -448.f), 448.f); d = fminf(fmaxf(d, -448.f), 448.f);
    int r = 0; r = __builtin_amdgcn_cvt_pk_fp8_f32(a, b, r, false); r = __builtin_amdgcn_cvt_pk_fp8_f32(c, d, r, true); return (unsigned)r;
}
__device__ __forceinline__ void conv_tiles_f8(char* lds, const float* __restrict__ src, int ldsrc, unsigned char* __restrict__ dst, int K, int nkt, int t_begin, int t_end, int vb, int nvb, int nnt, size_t mstride, bool shift8 = false) {
    const int tid = tid_opaque(), w = tid >> 6, lane = tid & 63, n4 = lane & 31, kg = w * 2 + (lane >> 5);
    f32x4 v0[8], v1[8], n0[8], n1[8], m0[8], m1[8];
    int t = t_begin + vb;
    if (t >= t_end) return;
#define C8_LOAD(dstv, tt) do { const int kt_ = (tt) % nkt, nt_ = (tt) / nkt, e_ = nt_ / nnt, ntl_ = nt_ % nnt; \
        const float* s_ = src + (size_t)e_ * mstride + (size_t)(kt_ * 128 + kg * 8) * ldsrc + ntl_ * 128 + ((shift8 && nt_ >= 24) ? 8 : 0) + n4 * 4; \
        _Pragma("unroll") for (int i = 0; i < 8; ++i) dstv[i] = __builtin_nontemporal_load((const f32x4*)(s_ + (size_t)i * ldsrc)); } while (0)
#define C8_PUT(srcv, buf) do { _Pragma("unroll") for (int j = 0; j < 4; ++j) { u32x2 pk; pk.x = pack_fp8x4(srcv[0][j] * 64.f, srcv[1][j] * 64.f, srcv[2][j] * 64.f, srcv[3][j] * 64.f); \
        pk.y = pack_fp8x4(srcv[4][j] * 64.f, srcv[5][j] * 64.f, srcv[6][j] * 64.f, srcv[7][j] * 64.f); \
        *(u32x2*)(lds + (buf) * 16384 + (n4 * 4 + j) * 128 + ((((kg >> 1) ^ (n4 & 7))) << 4) + (kg & 1) * 8) = pk; } } while (0)
#define C8_OUT(tt, buf) do { const int kt_ = (tt) % nkt, nt_ = (tt) / nkt; unsigned char* d_ = dst + (size_t)nt_ * 128 * K + kt_ * 128; \
        _Pragma("unroll") for (int r = 0; r < 2; ++r) { const int c_ = r * 512 + tid, n_ = c_ >> 3, ch_ = c_ & 7; \
            __builtin_nontemporal_store(*(const u32x4*)(lds + (buf) * 16384 + n_ * 128 + ((ch_ ^ ((n_ >> 2) & 7)) << 4)), (u32x4*)(d_ + (size_t)n_ * K + ch_ * 16)); } } while (0)
    C8_LOAD(v0, t); if (t + nvb < t_end) C8_LOAD(v1, t + nvb);
    if (t + 2 * nvb < t_end) C8_LOAD(n0, t + 2 * nvb);
    if (t + 3 * nvb < t_end) C8_LOAD(n1, t + 3 * nvb);
    for (; t < t_end; t += 2 * nvb) {
        const bool two = t + nvb < t_end;
        if (t + 4 * nvb < t_end) C8_LOAD(m0, t + 4 * nvb);
        if (t + 5 * nvb < t_end) C8_LOAD(m1, t + 5 * nvb);
        __syncthreads();
        C8_PUT(v0, 0); if (two) C8_PUT(v1, 1);
        __syncthreads();
        C8_OUT(t, 0); if (two) C8_OUT(t + nvb, 1);
#pragma unroll
        for (int i = 0; i < 8; ++i) { v0[i] = n0[i]; v1[i] = n1[i]; n0[i] = m0[i]; n1[i] = m1[i]; }
    }
#undef C8_LOAD
#undef C8_PUT
#undef C8_OUT
    __syncthreads();
}

namespace g8 {
constexpr int BK = 64, HALF = 128, HTB = HALF * BK * 2;
__device__ __forceinline__ int lds_byte8(int r, int c) { const int st = (r >> 4) * 2 + (c >> 5), rr = r & 15, cc = c & 31, ob = rr * 64 + cc * 2; return st * 1024 + (ob ^ (((ob >> 9) & 1) << 5)); }
__device__ __forceinline__ void stage_rc(int b, int& R, int& C) { const int st = b / 1024, sb = b % 1024, swz = sb ^ (((sb >> 9) & 1) << 5); R = (st >> 1) * 16 + swz / 64; C = (st & 1) * 32 + (swz % 64) / 2; }
__device__ __forceinline__ int perm32(int rho) { const int n = rho >> 4, i = rho & 15; return 8 * (i >> 2) + 4 * n + (i & 3); }
struct Unit { const char* A; const char* B; int row0, nv, pm, pn, e; };
__device__ __forceinline__ int xcd_remap(int L, int nwg) { const int q = nwg / 8, r = nwg % 8, xcd = L % 8, off = L / 8; return (xcd < r ? xcd * (q + 1) : r * (q + 1) + (xcd - r) * q) + off; }

template <bool GATHER, bool F8  , class Epi, class Sched>
__device__ __forceinline__ void gemm_phase8(char* lds_g, const int K, const int* __restrict__ rowmap, const Sched& S, const Epi& E) {
    LAS unsigned char* lds = (LAS unsigned char*)lds_g;
    const int tid = tid_opaque(), wid = __builtin_amdgcn_readfirstlane(tid >> 6), lane = tid & 63, wr = wid >> 2, wc = wid & 3, fr = lane & 15, fq = lane >> 4;
    constexpr int ESZ = F8 ? 1 : 2;
    const int nt = K * ESZ / 128;
    unsigned voffB[2], vaC[2][2], vaN[2][2];
#pragma unroll
    for (int i = 0; i < 2; ++i) { int sR_, sC_; stage_rc(tid * 16 + i * 8192, sR_, sC_); const int Rb = (sR_ & ~31) + perm32(sR_ & 31); voffB[i] = (unsigned)(Rb * K * ESZ + sC_ * 2); }
    const size_t kstep = (size_t)(BK * 2), hstep = (size_t)HALF * K * ESZ;
    const unsigned ldsw = (unsigned)wid * 1024u;
    const int aoff = lds_byte8(wr * 64 + fr, fq * 8), boff = lds_byte8(wc * 32 + fr, fq * 8);
#define G8_SA(b, h) (((b) * 2 + (h)) * HTB)
#define G8_SB(b, h) ((4 + (b) * 2 + (h)) * HTB)
#define G8_GLDS(bufoff, gptr, v0, v1) do { __builtin_amdgcn_global_load_lds((const unsigned*)((gptr) + (v0)), (LAS unsigned*)(lds + (bufoff) + ldsw), 16, 0, 0); \
        __builtin_amdgcn_global_load_lds((const unsigned*)((gptr) + (v1)), (LAS unsigned*)(lds + (bufoff) + ldsw + 8192), 16, 0, 0); } while (0)
#define G8_STB(bufoff, gptr) G8_GLDS(bufoff, gptr, voffB[0], voffB[1])
#define G8_STA(bufoff, gptr, va, h) G8_GLDS(bufoff, gptr, va[h][0], va[h][1])
#define G8_STA2(bufoff, gptr, h) G8_GLDS(bufoff, gptr, ((GATHER && last) ? vaN[h][0] : vaC[h][0]), ((GATHER && last) ? vaN[h][1] : vaC[h][1]))
#define G8_VA(va, u) do { int tv_ = tid; asm volatile("" : "+v"(tv_)); _Pragma("unroll") for (int i_ = 0; i_ < 2; ++i_) { int sR_, sC_; stage_rc(tv_ * 16 + i_ * 8192, sR_, sC_); _Pragma("unroll") for (int h_ = 0; h_ < 2; ++h_) { \
        if (GATHER) { int r_ = h_ * HALF + sR_; r_ = r_ < (u).nv ? r_ : (u).nv - 1; va[h_][i_] = (unsigned)rowmap[(u).row0 + r_] * (unsigned)(K * ESZ) + (unsigned)sC_ * 2u; } \
        else va[h_][i_] = (unsigned)((h_ * HALF + sR_) * K * ESZ + sC_ * 2); } } } while (0)
#define G8_LD8(dst, addr) do { const i32x4 lo_ = *(const LAS i32x4*)(lds + (addr)), hi_ = *(const LAS i32x4*)(lds + (addr) + 1024); dst = __builtin_shufflevector(lo_, hi_, 0, 1, 2, 3, 4, 5, 6, 7); } while (0)
#define G8_LDA(dst, b, h) do { if (F8) { _Pragma("unroll") for (int m = 0; m < 4; ++m) G8_LD8(dst##8[m], G8_SA(b, h) + aoff + m * 2048); } \
        else { _Pragma("unroll") for (int m = 0; m < 4; ++m) _Pragma("unroll") for (int k = 0; k < 2; ++k) dst[m][k] = *(const LAS bf16x8*)(lds + G8_SA(b, h) + aoff + m * 2048 + k * 1024); } } while (0)
#define G8_LDB(dst, b, h) do { if (F8) { _Pragma("unroll") for (int n = 0; n < 2; ++n) G8_LD8(dst##8[n], G8_SB(b, h) + boff + n * 2048); } \
        else { _Pragma("unroll") for (int n = 0; n < 2; ++n) _Pragma("unroll") for (int k = 0; k < 2; ++k) dst[n][k] = *(const LAS bf16x8*)(lds + G8_SB(b, h) + boff + n * 2048 + k * 1024); } } while (0)
#define G8_MMA(ai, bj, At, Bt) do { __builtin_amdgcn_s_setprio(1); _Pragma("unroll") for (int m = 0; m < 4; ++m) _Pragma("unroll") for (int n = 0; n < 2; ++n) { \
        if (F8) asm volatile("v_mfma_scale_f32_16x16x128_f8f6f4 %0, %1, %2, %0, %3, %4 op_sel_hi:[0,0,0]" : "+v"(acc[ai][bj][m][n]) : "v"(Bt##8[n]), "v"(At##8[m]), "v"(f8_sw), "v"(f8_sa)); \
        else { _Pragma("unroll") for (int k = 0; k < 2; ++k) acc[ai][bj][m][n] = __builtin_amdgcn_mfma_f32_16x16x32_bf16(Bt[n][k], At[m][k], acc[ai][bj][m][n], 0, 0, 0); } } \
        __builtin_amdgcn_s_setprio(0); } while (0)
#define G8_WAIT_V(n) asm volatile("s_waitcnt vmcnt(" #n ")" ::: "memory")
#define G8_WAIT_L(n) asm volatile("s_waitcnt lgkmcnt(" #n ")" ::: "memory")
#define G8_BAR __builtin_amdgcn_s_barrier()
#define G8_SCHED __builtin_amdgcn_sched_barrier(0)
    Unit cur, nxt; int ui = 0;
    if (!S.next(0, cur)) return;
    f32x4 acc[2][2][4][2];
#pragma unroll
    for (int a = 0; a < 2; ++a)
#pragma unroll
        for (int b = 0; b < 2; ++b)
#pragma unroll
            for (int m = 0; m < 4; ++m)
#pragma unroll
                for (int n = 0; n < 2; ++n) acc[a][b][m][n] = (f32x4){0.f, 0.f, 0.f, 0.f};
    bf16x8 At[4][2], B0[2][2], B1[2][2];
    const int f8_sw = 0x79797979, f8_sa = 0x7f7f7f7f;
    i32x8 At8[4], B08[2], B18[2];
    const char* cA = cur.A; const char* cB = cur.B;
    G8_VA(vaC, cur);
#pragma unroll
    for (int h = 0; h < 2; ++h) { vaN[h][0] = vaC[h][0]; vaN[h][1] = vaC[h][1]; }
    G8_STB(G8_SB(0, 0), cB); G8_STA(G8_SA(0, 0), cA, vaC, 0); G8_STB(G8_SB(0, 1), cB + hstep); G8_STA(G8_SA(0, 1), cA, vaC, 1);
    if (wr == 1) G8_BAR;
    G8_WAIT_V(4); G8_BAR;
    G8_STB(G8_SB(1, 0), cB + kstep); G8_STA(G8_SA(1, 0), cA + kstep, vaC, 0); G8_STB(G8_SB(1, 1), cB + hstep + kstep);
    G8_WAIT_V(6); G8_BAR;
    for (;;) {
        const bool has_next = S.next(ui + 1, nxt);
        const char* nA = has_next ? nxt.A : cA; const char* nB = has_next ? nxt.B : cB;
        if (GATHER && has_next) G8_VA(vaN, nxt);
        for (int t = 0; t < nt; t += 2) {
            const bool last = (t == nt - 2);
            const char* a1 = cA + (size_t)(t + 1) * kstep;
            const char* a2 = last ? nA : cA + (size_t)(t + 2) * kstep; const char* b2 = last ? nB : cB + (size_t)(t + 2) * kstep;
            const char* a3 = a2 + kstep; const char* b3 = b2 + kstep;
            G8_LDB(B0, 0, 0); G8_SCHED; G8_LDA(At, 0, 0); G8_STA(G8_SA(1, 1), a1, vaC, 1);
            G8_WAIT_L(8); G8_BAR; G8_WAIT_L(0); G8_MMA(0, 0, At, B0); G8_BAR; G8_SCHED;
            G8_LDB(B1, 0, 1); G8_STB(G8_SB(0, 0), b2);
            G8_BAR; G8_WAIT_L(0); G8_MMA(0, 1, At, B1); G8_BAR; if (F8) G8_SCHED;
            G8_LDA(At, 0, 1); G8_STA2(G8_SA(0, 0), a2, 0);
            G8_BAR; G8_WAIT_L(0); G8_MMA(1, 0, At, B0); G8_BAR; G8_SCHED;
            G8_STB(G8_SB(0, 1), b2 + hstep);
            G8_WAIT_V(6); G8_BAR; G8_MMA(1, 1, At, B1); G8_BAR; if (F8) G8_SCHED;
            G8_LDB(B0, 1, 0); G8_SCHED; G8_LDA(At, 1, 0); G8_STA2(G8_SA(0, 1), a2, 1);
            G8_WAIT_L(8); G8_BAR; G8_WAIT_L(0); G8_MMA(0, 0, At, B0); G8_BAR; G8_SCHED;
            G8_LDB(B1, 1, 1); G8_STB(G8_SB(1, 0), b3);
            G8_BAR; G8_WAIT_L(0); G8_MMA(0, 1, At, B1); G8_BAR; if (F8) G8_SCHED;
            G8_LDA(At, 1, 1); G8_STA2(G8_SA(1, 0), a3, 0);
            G8_BAR; G8_WAIT_L(0); G8_MMA(1, 0, At, B0); G8_BAR; G8_SCHED;
            G8_STB(G8_SB(1, 1), b3 + hstep);
            G8_WAIT_V(6); G8_BAR; G8_MMA(1, 1, At, B1); G8_BAR; if (F8) G8_SCHED;
        }
        bool keep_acc; { int te_ = tid; asm volatile("" : "+v"(te_)); const int le_ = te_ & 63; keep_acc = E(acc, cur, wr, wc, le_ & 15, le_ >> 4); }
        if (!has_next) break;
        if (!keep_acc) {
#pragma unroll
        for (int a = 0; a < 2; ++a)
#pragma unroll
            for (int b = 0; b < 2; ++b)
#pragma unroll
                for (int m = 0; m < 4; ++m)
#pragma unroll
                    for (int n = 0; n < 2; ++n) acc[a][b][m][n] = (f32x4){0.f, 0.f, 0.f, 0.f};
        }
        cur = nxt; cA = nA; cB = nB; ++ui;
        if (GATHER) {
#pragma unroll
            for (int h = 0; h < 2; ++h) { vaC[h][0] = vaN[h][0]; vaC[h][1] = vaN[h][1]; }
        }
    }
    G8_WAIT_V(0);
    if (wr == 0) G8_BAR;
    G8_BAR;
#undef G8_SA
#undef G8_SB
#undef G8_GLDS
#undef G8_STB
#undef G8_STA
#undef G8_STA2
#undef G8_VA
#undef G8_LDA
#undef G8_LDB
#undef G8_MMA
#undef G8_WAIT_V
#undef G8_WAIT_L
#undef G8_BAR
#undef G8_SCHED
}
__device__ __forceinline__ f32x2 gelu_pk(f32x2 v) {
    const f32x2 av = __builtin_elementwise_abs(v), d = av * 0.2316418882f + 1.0f;
    f32x2 t; t.x = __builtin_amdgcn_rcpf(d.x); t.y = __builtin_amdgcn_rcpf(d.y);
    f32x2 q = t * 0.5307027145f + (-0.7265760135f); q = q * t + 0.7107068705f; q = q * t + (-0.142248368f); q = q * t + 0.127414796f; q = q * t;
    const f32x2 s = (v * v) * (-0.72134752044f);
    f32x2 e; e.x = __builtin_amdgcn_exp2f(s.x); e.y = __builtin_amdgcn_exp2f(s.y);
    const f32x2 m = v * (q * e), r = v - m;
    f32x2 o; o.x = v.x < 0.f ? m.x : r.x; o.y = v.y < 0.f ? m.y : r.y; return o;
}
struct DenseOrder {
    const char* A; const char* B; int K, nM, nN, G, c, esz, pn0, gs = 8;
    __device__ __forceinline__ bool next(int i, Unit& u) const {
        const int nwg = nM * nN; const long L = (long)i * G + c; if (L >= nwg) return false;
        const int wgid = xcd_remap((int)L, nwg);
        const int nig = gs * nN, gid = wgid / nig, fm = gid * gs, gsz = (nM - fm) < gs ? (nM - fm) : gs;
        u.pm = fm + ((wgid % nig) % gsz); const int pnl = (wgid % nig) / gsz; u.pn = pn0 + pnl; u.row0 = u.pm * 256; u.nv = 256; u.e = 0;
        u.A = A + (size_t)u.pm * 256 * K * esz; u.B = B + (size_t)pnl * 256 * K * esz; return true;
    }
};
}

__device__ __forceinline__ void phase_prologue(const Params& p, char* lds, int vb, int nvb) {
    for (int i = vb * NTHREADS + tid_opaque(); i < NE * D; i += nvb * NTHREADS) {
        const int e = i >> 11, d = i & (D - 1); const float w = p.w_router[(size_t)d * NE + e];
        const unsigned hi = cvt_pk_bf16(w, 0.f) & 0xffffu; const float rem = w - __uint_as_float(hi << 16);
        p.wr_hi[i] = (bf16_t)hi; p.wr_lo[i] = (bf16_t)(cvt_pk_bf16(rem, 0.f) & 0xffffu);
    }
    float* wf = (float*)lds;
    for (int i = tid_opaque(); i < D * 2; i += NTHREADS) { const int d = i >> 1, hf = i & 1; const f32x4 wv = *(const f32x4*)(p.w_in + (size_t)d * PW + 3072 + hf * 4);
#pragma unroll
        for (int j = 0; j < 4; ++j) wf[(hf * 4 + j) * D + d] = wv[j]; }
    __syncthreads();
    const int tid = tid_opaque(), wid = tid >> 6, lane = tid & 63;
    for (int tok = vb * 8 + wid; tok < T; tok += nvb * 8) {
        const float* xr = p.x + (size_t)tok * D;
        f32x4 xv[8]; float ss = 0.f;
#pragma unroll
        for (int i = 0; i < 8; ++i) { xv[i] = *(const f32x4*)(xr + i * 256 + lane * 4); ss += xv[i][0] * xv[i][0] + xv[i][1] * xv[i][1] + xv[i][2] * xv[i][2] + xv[i][3] * xv[i][3]; }
        ss = wave_sum(ss);
        const float rstd = rsqrtf(ss * (1.0f / D) + 1e-5f);
        float fa[8];
#pragma unroll
        for (int j = 0; j < 8; ++j) fa[j] = 0.f;
#pragma unroll
        for (int i = 0; i < 8; ++i) {
            const f32x4 g = *(const f32x4*)(p.g_mix + i * 256 + lane * 4);
            const f32x4 hv = xv[i] * rstd * g;
            u32x2 w; w.x = cvt_pk_bf16(hv[0], hv[1]); w.y = cvt_pk_bf16(hv[2], hv[3]);
            *(u32x2*)(p.h + (size_t)tok * D + i * 256 + lane * 4) = w;
            *(unsigned*)(p.h8 + (size_t)tok * D + i * 256 + lane * 4) = pack_fp8x4(hv[0], hv[1], hv[2], hv[3]);
#pragma unroll
            for (int hh = 0; hh < 8; ++hh) { const f32x4 w4 = *(const f32x4*)(wf + hh * D + i * 256 + lane * 4); fa[hh] += hv[0] * w4[0] + hv[1] * w4[1] + hv[2] * w4[2] + hv[3] * w4[3]; }
        }
        float mine = 0.f;
#pragma unroll
        for (int j = 0; j < 8; ++j) { const float s = wave_sum(fa[j]); if (lane == j) mine = s; }
        if (lane < 8) p.ls[(size_t)tok * 8 + lane] = log_sigmoid(mine + p.b_forget[lane]);
    }
    __syncthreads();
}

__device__ __forceinline__ void phase_convert_dense(const Params& p, char* lds, int vb, int nvb) {
    conv_tiles(lds, p.w_in, PW, p.wb_in, D, 32, 0, 32 * PN_SPLIT, true, vb, nvb);
    conv_tiles_f8(lds, p.w_in, PW, p.wb_in8, D, 16, 16 * 2 * PN_SPLIT, 16 * 72, vb, nvb, 1 << 30, 0, true);
}
constexpr int UPSPLIT = 14592;
__device__ __forceinline__ void phase_convert_moe(const Params& p, char* lds, int part, int vb, int nvb) {
    unsigned char* up8 = (unsigned char*)p.wb_up; unsigned char* dn8 = (unsigned char*)p.wb_down;
    if (part == 0) {
        conv_tiles_f8(lds, p.w_up, 2 * DFF, up8, D, 16, 0, UPSPLIT, vb, nvb, 32, (size_t)D * 2 * DFF);
        conv_tiles(lds, p.w_ba, D, p.wb_ba, AW, 16, 0, 16 * 8, false, vb, nvb);
        conv_tiles(lds, p.w_bg, D, p.wb_bg, GW, 16, 0, 16 * 8, false, vb, nvb);
    } else {
        conv_tiles(lds, p.w_out, D, p.wb_out, D, 32, 0, 32 * 8, false, vb, nvb);
        conv_tiles_f8(lds, p.w_up, 2 * DFF, up8, D, 16, UPSPLIT, 16 * 32 * NE, vb, nvb, 32, (size_t)D * 2 * DFF);
        conv_tiles_f8(lds, p.w_down, D, dn8, DFF, 16, 0, 16 * 16 * NE, vb, nvb, 16, (size_t)DFF * D);
    }
}

struct EpiInproj {
    bf16_t *q, *k, *v, *zg, *gates; float* lnpart;
    __device__ __forceinline__ bool operator()(f32x4 (&acc)[2][2][4][2], const g8::Unit& u, int wr, int wc, int fr, int fq) const {
        const int pn = u.pn;
        bf16_t* base; int ld, colt, act;
        if (pn < 4) { base = q; ld = AW; colt = pn * 256; act = 0; }
        else if (pn < 8) { base = k; ld = AW; colt = (pn - 4) * 256; act = 0; }
        else if (pn < 12) { base = v; ld = AW; colt = (pn - 8) * 256; act = 0; }
        else if (pn < 20) { base = zg; ld = 2048; colt = (pn - 12) * 256; act = 1; }
        else { base = gates; ld = 4096; colt = (pn - 20) * 256; act = 2; }
        const bool lnp = pn >= 16 && pn < 20;
#pragma unroll
        for (int ai = 0; ai < 2; ++ai)
#pragma unroll
            for (int m = 0; m < 4; ++m) {
                const size_t row = (size_t)u.pm * 256 + ai * 128 + wr * 64 + m * 16 + fr;
                bf16_t* rowp = base + row * ld + colt + wc * 32 + fq * 8;
                float ps = 0.f, pq = 0.f;
#pragma unroll
                for (int bj = 0; bj < 2; ++bj) {
                    f32x4 v0 = acc[ai][bj][m][0], v1 = acc[ai][bj][m][1];
                    if (act == 1) {
                        const f32x2 a = g8::gelu_pk((f32x2){v0[0], v0[1]}), b = g8::gelu_pk((f32x2){v0[2], v0[3]}), c = g8::gelu_pk((f32x2){v1[0], v1[1]}), d = g8::gelu_pk((f32x2){v1[2], v1[3]});
                        v0 = (f32x4){a.x, a.y, b.x, b.y}; v1 = (f32x4){c.x, c.y, d.x, d.y};
                    } else if (act == 2) {
#pragma unroll
                        for (int j = 0; j < 4; ++j) { v0[j] = sigmoidf_(v0[j]); v1[j] = sigmoidf_(v1[j]); }
                    }
                    if (lnp) { ps += (v0[0] + v0[1]) + (v0[2] + v0[3]) + (v1[0] + v1[1]) + (v1[2] + v1[3]); pq += (v0[0] * v0[0] + v0[1] * v0[1]) + (v0[2] * v0[2] + v0[3] * v0[3]) + (v1[0] * v1[0] + v1[1] * v1[1]) + (v1[2] * v1[2] + v1[3] * v1[3]); }
                    u32x4 w; w.x = cvt_pk_bf16(v0[0], v0[1]); w.y = cvt_pk_bf16(v0[2], v0[3]); w.z = cvt_pk_bf16(v1[0], v1[1]); w.w = cvt_pk_bf16(v1[2], v1[3]);
                    *(u32x4*)(rowp + bj * 128) = w;
                }
                if (lnp) {
                    ps += __shfl_xor(ps, 16); ps += __shfl_xor(ps, 32); pq += __shfl_xor(pq, 16); pq += __shfl_xor(pq, 32);
                    if (fq == 0) *(f32x2*)(lnpart + (row * 16 + (pn - 16) * 4 + wc) * 2) = (f32x2){ps, pq};
                }
            }
        return false;
    }
};
__device__ __forceinline__ void phase_inproj8(const Params& p, char* lds, int vb, int nvb) {
    EpiInproj E; E.q = p.q; E.k = p.k; E.v = p.v; E.zg = p.zg; E.gates = p.gates; E.lnpart = p.lnpart;
    {
        g8::DenseOrder S; S.A = (const char*)p.h; S.B = (const char*)p.wb_in; S.K = D; S.nM = 32; S.nN = PN_SPLIT; S.G = nvb; S.c = vb; S.esz = 2; S.pn0 = 0; S.gs = 4;
        g8::gemm_phase8<false, false>(lds, D, nullptr, S, E);
    }
    {
        g8::DenseOrder S; S.A = (const char*)p.h8; S.B = (const char*)(p.wb_in8 + (size_t)PN_SPLIT * 256 * D); S.K = D; S.nM = 32; S.nN = 36 - PN_SPLIT; S.G = nvb; S.c = vb; S.esz = 1; S.pn0 = PN_SPLIT; S.gs = 4;
        g8::gemm_phase8<false, true>(lds, D, nullptr, S, E);
    }
}
__device__ __forceinline__ void phase_inproj_conv(const Params& p, char* lds, int vb, int nvb) {
    const int half = nvb >> 1; const bool first = vb >= half;
    if (first) phase_convert_moe(p, lds, 0, vb - half, nvb - half);
    phase_inproj8(p, lds, vb, nvb);
    if (!first) phase_convert_moe(p, lds, 1, vb, half);
}

__device__ __forceinline__ void phase_inproj(const Params& p, char* lds, int vb, int nvb) {
    for (int u = vb; u < 32 * 36; u += nvb) {
        const int pm = u / 36, pn = u % 36;
        const int bcol = pn < 12 ? pn * 256 : pn * 256 + 8;
        gemm_tile<PW, false, false>(lds, p.h, D, nullptr, pm * 256, 256, p.w_in + bcol, D,
            [&](const f32x4 (&acc)[8][4], int wr, int wc, int fr, int fq) {
#pragma unroll
                for (int m = 0; m < 8; ++m) {
                    const size_t row = (size_t)pm * 256 + wr * 128 + m * 16 + fr;
#pragma unroll
                    for (int n = 0; n < 4; ++n) {
                        const int c = wc * 64 + n * 16 + fq * 4;
                        f32x4 v = acc[m][n];
                        bf16_t* dst;
                        if (pn < 4) dst = p.q + row * AW + pn * 256 + c;
                        else if (pn < 8) dst = p.k + row * AW + (pn - 4) * 256 + c;
                        else if (pn < 12) dst = p.v + row * AW + (pn - 8) * 256 + c;
                        else if (pn < 20) { dst = p.zg + row * 2048 + (pn - 12) * 256 + c;
#pragma unroll
                            for (int j = 0; j < 4; ++j) v[j] = gelu_erf(v[j]); }
                        else { dst = p.gates + row * 4096 + (pn - 20) * 256 + c;
#pragma unroll
                            for (int j = 0; j < 4; ++j) v[j] = sigmoidf_(v[j]); }
                        u32x2 w; w.x = cvt_pk_bf16(v[0], v[1]); w.y = cvt_pk_bf16(v[2], v[3]);
                        *(u32x2*)dst = w;
                    }
                }
            });
    }
}

struct BranchOrder {
    const char *A0, *A1, *B0, *B1; int G, c;
    __device__ __forceinline__ bool next(int i, g8::Unit& u) const {
        const int nwg = 32 * 8; const long L = (long)(i >> 1) * G + c; if (L >= nwg) return false;
        const int wgid = g8::xcd_remap((int)L, nwg);
        const int nig = 8 * 8, gid = wgid / nig, fm = gid * 8;
        u.pm = fm + ((wgid % nig) % 8); u.pn = (wgid % nig) / 8; u.row0 = u.pm * 256; u.nv = 256; u.e = i & 1;
        u.A = ((i & 1) ? A1 : A0) + (size_t)u.pm * 256 * AW * 2; u.B = ((i & 1) ? B1 : B0) + (size_t)u.pn * 256 * AW * 2; return true;
    }
};
struct EpiBranch {
    const bf16_t* gates; bf16_t* merged;
    __device__ __forceinline__ bool operator()(f32x4 (&acc)[2][2][4][2], const g8::Unit& u, int wr, int wc, int fr, int fq) const {
#pragma unroll
        for (int aim = 0; aim < 4; ++aim) {
            const int ai = aim >> 1, m0 = (aim & 1) * 2;
            u32x4 ga[4][2], gb[4][2];
#pragma unroll
            for (int m = m0; m < m0 + 2; ++m) {
                const size_t row = (size_t)u.pm * 256 + ai * 128 + wr * 64 + m * 16 + fr;
#pragma unroll
                for (int bj = 0; bj < 2; ++bj) {
                    const int c = u.pn * 256 + bj * 128 + wc * 32 + fq * 8;
                    ga[m][bj] = *(const u32x4*)(gates + row * 4096 + c);
                    if (u.e == 0) gb[m][bj] = *(const u32x4*)(gates + row * 4096 + 2048 + c);
                }
            }
#pragma unroll
            for (int m = m0; m < m0 + 2; ++m) {
                const size_t row = (size_t)u.pm * 256 + ai * 128 + wr * 64 + m * 16 + fr;
#pragma unroll
                for (int bj = 0; bj < 2; ++bj) {
                    const int c = u.pn * 256 + bj * 128 + wc * 32 + fq * 8;
                    const u32x4 a_ = ga[m][bj];
                    const float gav[8] = {fmaxf(bf_lo(a_.x), 1e-6f), fmaxf(bf_hi(a_.x), 1e-6f), fmaxf(bf_lo(a_.y), 1e-6f), fmaxf(bf_hi(a_.y), 1e-6f),
                                          fmaxf(bf_lo(a_.z), 1e-6f), fmaxf(bf_hi(a_.z), 1e-6f), fmaxf(bf_lo(a_.w), 1e-6f), fmaxf(bf_hi(a_.w), 1e-6f)};
                    if (u.e == 0) {
                        const u32x4 b_ = gb[m][bj];
                        const float gbv[8] = {bf_lo(b_.x), bf_hi(b_.x), bf_lo(b_.y), bf_hi(b_.y), bf_lo(b_.z), bf_hi(b_.z), bf_lo(b_.w), bf_hi(b_.w)};
#pragma unroll
                        for (int j = 0; j < 4; ++j) { acc[ai][bj][m][0][j] *= gbv[j] * __builtin_amdgcn_rcpf(gav[j]); acc[ai][bj][m][1][j] *= gbv[4 + j] * __builtin_amdgcn_rcpf(gav[4 + j]); }
                    } else {
                        f32x4 v0 = acc[ai][bj][m][0], v1 = acc[ai][bj][m][1];
#pragma unroll
                        for (int j = 0; j < 4; ++j) { v0[j] *= gav[j]; v1[j] *= gav[4 + j]; }
                        u32x4 w; w.x = cvt_pk_bf16(v0[0], v0[1]); w.y = cvt_pk_bf16(v0[2], v0[3]); w.z = cvt_pk_bf16(v1[0], v1[1]); w.w = cvt_pk_bf16(v1[2], v1[3]);
                        *(u32x4*)(merged + row * D + c) = w;
                    }
                }
            }
        }
        return u.e == 0;
    }
};
__device__ __forceinline__ void phase_branch8(const Params& p, char* lds, int vb, int nvb) {
    BranchOrder S; S.A0 = (const char*)p.sg; S.A1 = (const char*)p.attn; S.B0 = (const char*)p.wb_bg; S.B1 = (const char*)p.wb_ba; S.G = nvb; S.c = vb;
    EpiBranch E; E.gates = p.gates; E.merged = p.merged;
    g8::gemm_phase8<false, false>(lds, AW, nullptr, S, E);
}
struct EpiOut {
    const float* x; bf16_t* x1;
    __device__ __forceinline__ bool operator()(f32x4 (&acc)[2][2][4][2], const g8::Unit& u, int wr, int wc, int fr, int fq) const {
#pragma unroll
        for (int aim = 0; aim < 4; ++aim) {
            const int ai = aim >> 1, m0 = (aim & 1) * 2;
            f32x4 xv[4][2][2];
#pragma unroll
            for (int m = m0; m < m0 + 2; ++m)
#pragma unroll
                for (int bj = 0; bj < 2; ++bj) {
                    const size_t o = ((size_t)u.pm * 256 + ai * 128 + wr * 64 + m * 16 + fr) * D + u.pn * 256 + bj * 128 + wc * 32 + fq * 8;
                    xv[m][bj][0] = *(const f32x4*)(x + o); xv[m][bj][1] = *(const f32x4*)(x + o + 4);
                }
#pragma unroll
            for (int m = m0; m < m0 + 2; ++m)
#pragma unroll
                for (int bj = 0; bj < 2; ++bj) {
                    const size_t o = ((size_t)u.pm * 256 + ai * 128 + wr * 64 + m * 16 + fr) * D + u.pn * 256 + bj * 128 + wc * 32 + fq * 8;
                    const f32x4 r0 = xv[m][bj][0] + acc[ai][bj][m][0], r1 = xv[m][bj][1] + acc[ai][bj][m][1];
                    u32x4 w; w.x = cvt_pk_bf16(r0[0], r0[1]); w.y = cvt_pk_bf16(r0[2], r0[3]); w.z = cvt_pk_bf16(r1[0], r1[1]); w.w = cvt_pk_bf16(r1[2], r1[3]);
                    *(u32x4*)(x1 + o) = w;
                }
        }
        return false;
    }
};
__device__ __forceinline__ void phase_outproj8(const Params& p, char* lds, int vb, int nvb) {
    g8::DenseOrder S; S.A = (const char*)p.merged; S.B = (const char*)p.wb_out; S.K = D; S.nM = 32; S.nN = 8; S.G = nvb; S.c = vb; S.esz = 2; S.pn0 = 0; S.gs = 4;
    EpiOut E; E.x = p.x; E.x1 = p.x1b;
    g8::gemm_phase8<false, false>(lds, D, nullptr, S, E);
}
struct MoeOrder {
    const int *unit_tab, *tile_row0, *tile_nrows; const char *A, *B; int nunits, rows_per_e, gather, G, c;
    __device__ __forceinline__ bool next(int i, g8::Unit& u) const {
        const int L = i * G + c; if (L >= nunits) return false;
        const int w = g8::xcd_remap(L, nunits);
        const int2 dd = *(const int2*)(unit_tab + 2 * w); const int d = dd.x;
        u.e = (unsigned)d >> 24; u.pn = (d >> 16) & 0xff; u.pm = d & 0xffff; u.row0 = dd.y & 0xffff; u.nv = (unsigned)dd.y >> 16;
        u.A = gather ? A : A + (size_t)u.row0 * D;
        u.B = B + ((size_t)u.e * rows_per_e + (size_t)u.pn * 256) * D; return true;
    }
};
struct EpiUp {
    const float* b_up; bf16_t* act;
    __device__ __forceinline__ bool operator()(f32x4 (&acc)[2][2][4][2], const g8::Unit& u, int wr, int wc, int fr, int fq) const {
        f32x4 bb[2][2];
#pragma unroll
        for (int bj = 0; bj < 2; ++bj) { const float* bp = b_up + (size_t)u.e * (2 * DFF) + u.pn * 256 + bj * 128 + wc * 32 + fq * 8; bb[bj][0] = *(const f32x4*)bp; bb[bj][1] = *(const f32x4*)(bp + 4); }
#pragma unroll
        for (int ai = 0; ai < 2; ++ai) {
            if (ai * 128 + wr * 64 < u.nv) {
#pragma unroll
                for (int bj = 0; bj < 2; ++bj) {
                    unsigned P[4];
#pragma unroll
                    for (int m = 0; m < 4; ++m) {
                        const f32x4 v0 = acc[ai][bj][m][0] + bb[bj][0], v1 = acc[ai][bj][m][1] + bb[bj][1];
                        float a[4];
#pragma unroll
                        for (int j = 0; j < 2; ++j) {
                            const float g0 = fminf(v0[2 * j], 7.f), l0 = fminf(fmaxf(v0[2 * j + 1], -7.f), 7.f);
                            const float g1 = fminf(v1[2 * j], 7.f), l1 = fminf(fmaxf(v1[2 * j + 1], -7.f), 7.f);
                            const float t0 = g0 * __builtin_amdgcn_rcpf(1.0f + __builtin_amdgcn_exp2f(-2.45546696f * g0)), t1 = g1 * __builtin_amdgcn_rcpf(1.0f + __builtin_amdgcn_exp2f(-2.45546696f * g1));
                            a[j] = fmaf(t0, l0, t0); a[2 + j] = fmaf(t1, l1, t1);
                        }
                        int pk = 0; pk = __builtin_amdgcn_cvt_pk_fp8_f32(a[0], a[1], pk, false); pk = __builtin_amdgcn_cvt_pk_fp8_f32(a[2], a[3], pk, true);
                        P[m] = (unsigned)pk;
                    }
                    const auto s0 = __builtin_amdgcn_permlane32_swap(P[0], P[2], false, false), s1 = __builtin_amdgcn_permlane32_swap(P[1], P[3], false, false);
                    const auto t0 = __builtin_amdgcn_permlane16_swap(s0[0], s1[0], false, false), t1 = __builtin_amdgcn_permlane16_swap(s0[1], s1[1], false, false);
                    const int r = ai * 128 + wr * 64 + fq * 16 + fr;
                    if (r < u.nv) { u32x4 w; w.x = t0[0]; w.y = t0[1]; w.z = t1[0]; w.w = t1[1];
                        *(u32x4*)((unsigned char*)act + (size_t)(u.row0 + r) * DFF + u.pn * 128 + bj * 64 + wc * 16) = w; }
                }
            }
        }
        return false;
    }
};
__device__ __forceinline__ void phase_moe_up8(const Params& p, char* lds, int vb, int nvb) {
    MoeOrder S; S.unit_tab = p.unit_up; S.tile_row0 = p.tile_row0; S.tile_nrows = p.tile_nrows; S.A = (const char*)p.h2; S.B = (const char*)p.wb_up;
    S.nunits = __builtin_amdgcn_readfirstlane(p.ntiles[0]) * 16; S.rows_per_e = 2 * DFF; S.gather = 1; S.G = nvb; S.c = vb;
    EpiUp E; E.b_up = p.b_up; E.act = p.act;
    g8::gemm_phase8<true, true>(lds, D, p.row_tok, S, E);
}
struct EpiDown {
    const float *b_down, *row_gate; const int* row_dst; bf16_t* y;
    __device__ __forceinline__ bool operator()(f32x4 (&acc)[2][2][4][2], const g8::Unit& u, int wr, int wc, int fr, int fq) const {
        f32x4 bb[2][2]; float gt[2][4]; int ds[2][4];
#pragma unroll
        for (int bj = 0; bj < 2; ++bj) { const float* bp = b_down + (size_t)u.e * D + u.pn * 256 + bj * 128 + wc * 32 + fq * 8; bb[bj][0] = *(const f32x4*)bp; bb[bj][1] = *(const f32x4*)(bp + 4); }
#pragma unroll
        for (int ai = 0; ai < 2; ++ai)
#pragma unroll
            for (int m = 0; m < 4; ++m) { int r = ai * 128 + wr * 64 + m * 16 + fr; r = r < u.nv ? r : u.nv - 1; gt[ai][m] = row_gate[u.row0 + r]; ds[ai][m] = row_dst[u.row0 + r]; }
#pragma unroll
        for (int ai = 0; ai < 2; ++ai)
#pragma unroll
            for (int m = 0; m < 4; ++m) {
                const int r = ai * 128 + wr * 64 + m * 16 + fr;
                if (r < u.nv) {
                    const float gate = gt[ai][m];
                    bf16_t* yp = y + (size_t)ds[ai][m] * D;
#pragma unroll
                    for (int bj = 0; bj < 2; ++bj) {
                        const int c = u.pn * 256 + bj * 128 + wc * 32 + fq * 8;
                        const f32x4 v0 = (acc[ai][bj][m][0] + bb[bj][0]) * gate, v1 = (acc[ai][bj][m][1] + bb[bj][1]) * gate;
                        u32x4 w; w.x = cvt_pk_bf16(v0[0], v0[1]); w.y = cvt_pk_bf16(v0[2], v0[3]); w.z = cvt_pk_bf16(v1[0], v1[1]); w.w = cvt_pk_bf16(v1[2], v1[3]);
                        *(u32x4*)(yp + c) = w;
                    }
                }
            }
        return false;
    }
};
__device__ __forceinline__ void phase_moe_down8(const Params& p, char* lds, int vb, int nvb) {
    MoeOrder S; S.unit_tab = p.unit_down; S.tile_row0 = p.tile_row0; S.tile_nrows = p.tile_nrows; S.A = (const char*)p.act; S.B = (const char*)p.wb_down;
    S.nunits = __builtin_amdgcn_readfirstlane(p.ntiles[0]) * 8; S.rows_per_e = D; S.gather = 0; S.G = nvb; S.c = vb;
    EpiDown E; E.b_down = p.b_down; E.row_gate = p.row_gate; E.row_dst = p.row_dst; E.y = p.y;
    g8::gemm_phase8<false, true>(lds, DFF, nullptr, S, E);
}

__device__ __forceinline__ void phase_attn_naive(const Params& p, char* lds, int vb, int nvb) {
    float* cs = (float*)lds;
    float* wtot = cs + 2048;
    float* qs = wtot + 64;
    const int tid = tid_opaque(), wid = tid >> 6, lane = tid & 63;
    for (int u = vb; u < 512; u += nvb) {
        const int qb = 15 - (u >> 5), bh = u & 31, b = bh >> 3, hh = bh & 7;
        const int nkeys = (qb + 1) * 128;
        __syncthreads();
        {
            float v[4];
#pragma unroll
            for (int j = 0; j < 4; ++j) { const int s = tid * 4 + j; v[j] = s < nkeys ? p.ls[((size_t)b * S + s) * 8 + hh] : 0.f; }
            v[1] += v[0]; v[2] += v[1]; v[3] += v[2];
            float incl = v[3];
#pragma unroll
            for (int o = 1; o < 64; o <<= 1) { const float t = __shfl_up(incl, o); if (lane >= o) incl += t; }
            if (lane == 63) wtot[wid] = incl;
            __syncthreads();
            float base = incl - v[3];
            for (int w = 0; w < wid; ++w) base += wtot[w];
#pragma unroll
            for (int j = 0; j < 4; ++j) cs[tid * 4 + j] = base + v[j];
            __syncthreads();
        }
        float* myq = qs + wid * 128;
        for (int rr = 0; rr < 16; ++rr) {
            const int t = qb * 128 + wid * 16 + rr;
            const size_t qoff = ((size_t)b * S + t) * AW + hh * 128;
            { const unsigned qq = *(const unsigned*)(p.q + qoff + lane * 2); myq[lane * 2] = bf_lo(qq) * 0.08838834764831845f; myq[lane * 2 + 1] = bf_hi(qq) * 0.08838834764831845f; }
            __builtin_amdgcn_wave_barrier();
            const float ct = cs[t];
            float mrun = -INFINITY, lrun = 0.f, o0 = 0.f, o1 = 0.f;
            for (int s0 = 0; s0 <= t; s0 += 64) {
                const int s = s0 + lane; const bool valid = s <= t; const int sl = valid ? s : t;
                const bf16_t* kp = p.k + ((size_t)b * S + sl) * AW + hh * 128;
                float acc = 0.f;
#pragma unroll
                for (int c = 0; c < 16; ++c) {
                    const u32x4 kk = *(const u32x4*)(kp + c * 8);
                    const f32x4 qa = *(const f32x4*)(myq + c * 8), qb4 = *(const f32x4*)(myq + c * 8 + 4);
                    acc += bf_lo(kk.x) * qa[0] + bf_hi(kk.x) * qa[1] + bf_lo(kk.y) * qa[2] + bf_hi(kk.y) * qa[3]
                         + bf_lo(kk.z) * qb4[0] + bf_hi(kk.z) * qb4[1] + bf_lo(kk.w) * qb4[2] + bf_hi(kk.w) * qb4[3];
                }
                const float sc = valid ? acc + (ct - cs[sl]) : -INFINITY;
                const float mnew = fmaxf(mrun, wave_max(sc));
                const float alpha = __expf(mrun - mnew);
                const float pj = valid ? __expf(sc - mnew) : 0.f;
                lrun = lrun * alpha + wave_sum(pj);
                o0 *= alpha; o1 *= alpha;
                const int nj = min(64, t - s0 + 1);
                const bf16_t* vp = p.v + ((size_t)b * S + s0) * AW + hh * 128 + lane * 2;
                for (int j = 0; j < nj; ++j) {
                    const float pjj = __shfl(pj, j);
                    const unsigned vv = *(const unsigned*)(vp + (size_t)j * AW);
                    o0 += pjj * bf_lo(vv); o1 += pjj * bf_hi(vv);
                }
                mrun = mnew;
            }
            const float inv = 1.0f / lrun;
            *(unsigned*)(p.attn + qoff + lane * 2) = cvt_pk_bf16(o0 * inv, o1 * inv);
            __builtin_amdgcn_wave_barrier();
        }
    }
    __syncthreads();
}

template <int KS> __device__ __forceinline__ int lds_byte_t(int r, int c) { const int st = (r >> 4) * KS + (c >> 5), ob = (r & 15) * 64 + (c & 31) * 2; return st * 1024 + (ob ^ (((ob >> 9) & 1) << 5)); }

__device__ __forceinline__ void attn_block(const Params& p, char* stg, const float* cs, int b, int hh, int qb) {
    const int tid = tid_opaque(), wid = tid >> 6, lane = tid & 63, fr = lane & 15, fq = lane >> 4, w = wid & 3, kh = wid >> 2;
    const int q0 = qb * 128;
    const float sc2 = 0.08838834764831845f * 1.4426950408889634f;
    const size_t tokb = (size_t)b * S;
    bf16x8 Qf[2][4];
#pragma unroll
    for (int qg = 0; qg < 2; ++qg)
#pragma unroll
        for (int ks = 0; ks < 4; ++ks) Qf[qg][ks] = *(const bf16x8*)(p.q + (tokb + q0 + 32 * w + 16 * qg + fr) * AW + hh * 128 + ks * 32 + fq * 8);
    f32x4 O[2][8];
#pragma unroll
    for (int qg = 0; qg < 2; ++qg)
#pragma unroll
        for (int dt = 0; dt < 8; ++dt) O[qg][dt] = (f32x4){0.f, 0.f, 0.f, 0.f};
    float mrun[2] = {-1e30f, -1e30f}, lrun[2] = {0.f, 0.f};
    const int kR = (wid >> 2) * 16 + (lane >> 2), kC = (wid & 3) * 32 + (((lane & 3) ^ ((lane >> 5) << 1)) << 3);
    const bf16_t* kg = p.k + (tokb + kR) * AW + hh * 128 + kC;
    const int vq4 = (lane & 7) | ((wid >> 1) << 3), vd8 = ((lane >> 3) & 7) | ((wid & 1) << 3);
    const bf16_t* vg = p.v + (tokb + 4 * vq4) * AW + hh * 128 + vd8 * 8;
    const int vq4p = vq4 & 15, vq4pp = vq4p & 7;
    const int vcol = (vq4p >> 3) * 32 + 8 * (vq4pp & 3) + 4 * (vq4pp >> 2);
    const int vwoff = 32768 + (vq4 >> 4) * 16384 + ((vd8 >> 1) * 2 + (vcol >> 5)) * 1024 + ((((vd8 & 1) * 512) + (vcol & 31) * 2) ^ ((vd8 & 1) << 5));
    u32x4 kreg[4], vreg[4];
#define AT_ISSUE(j) do { _Pragma("unroll") for (int i = 0; i < 4; ++i) kreg[i] = *(const u32x4*)(kg + (size_t)((j) * 128 + 32 * i) * AW); \
        _Pragma("unroll") for (int r = 0; r < 4; ++r) vreg[r] = *(const u32x4*)(vg + (size_t)((j) * 128 + r) * AW); } while (0)
#define AT_WRITE(sidx) do { char* st_ = stg + (sidx) * 65536; \
        _Pragma("unroll") for (int i = 0; i < 4; ++i) *(u32x4*)(st_ + (i * 512 + tid) * 16) = kreg[i]; \
        _Pragma("unroll") for (int dd = 0; dd < 8; ++dd) { u32x2 w_; const unsigned sel_ = (dd & 1) ? 0x07060302u : 0x05040100u; \
            w_.x = __builtin_amdgcn_perm(vreg[1][dd >> 1], vreg[0][dd >> 1], sel_); w_.y = __builtin_amdgcn_perm(vreg[3][dd >> 1], vreg[2][dd >> 1], sel_); \
            *(u32x2*)(st_ + vwoff + dd * 64) = w_; } } while (0)
    AT_ISSUE(0); AT_WRITE(0);
#pragma unroll
    for (int qg = 0; qg < 2; ++qg)
#pragma unroll
        for (int ks = 0; ks < 4; ++ks) asm volatile("" :: "v"(Qf[qg][ks]));
    __syncthreads();
    for (int j = 0; j <= qb; ++j) {
        const int cur = j & 1;
        if (j < qb) AT_ISSUE(j + 1);
        const bool diag = (j == qb);
        const bool skip = diag && (kh * 64 > 32 * w + 31);
        if (!skip) {
            const char* st_ = stg + cur * 65536;
            f32x4 Sx[4][2];
#pragma unroll
            for (int kt = 0; kt < 4; ++kt) { Sx[kt][0] = (f32x4){0.f, 0.f, 0.f, 0.f}; Sx[kt][1] = (f32x4){0.f, 0.f, 0.f, 0.f}; }
#pragma unroll
            for (int ks = 0; ks < 4; ++ks)
#pragma unroll
                for (int kt = 0; kt < 4; ++kt) {
                    const bf16x8 Kf = *(const bf16x8*)(st_ + lds_byte_t<4>(kh * 64 + kt * 16 + fr, ks * 32 + fq * 8));
                    Sx[kt][0] = __builtin_amdgcn_mfma_f32_16x16x32_bf16(Kf, Qf[0][ks], Sx[kt][0], 0, 0, 0);
                    Sx[kt][1] = __builtin_amdgcn_mfma_f32_16x16x32_bf16(Kf, Qf[1][ks], Sx[kt][1], 0, 0, 0);
                }
            const int keyb = j * 128 + kh * 64 + 4 * fq;
            const bool mask = diag && (kh * 64 + 63 > 32 * w);
#pragma unroll
            for (int kt = 0; kt < 4; ++kt) {
                const f32x4 cb = *(const f32x4*)(cs + keyb + kt * 16);
#pragma unroll
                for (int qg = 0; qg < 2; ++qg) {
                    const int qi = q0 + 32 * w + 16 * qg + fr;
#pragma unroll
                    for (int r = 0; r < 4; ++r) {
                        float v = Sx[kt][qg][r] * sc2 - cb[r];
                        if (mask && (keyb + kt * 16 + r > qi)) v = -INFINITY;
                        Sx[kt][qg][r] = v;
                    }
                }
            }
#pragma unroll
            for (int qg = 0; qg < 2; ++qg) {
                float mx = -INFINITY;
#pragma unroll
                for (int kt = 0; kt < 4; ++kt) mx = fmaxf(mx, fmaxf(fmaxf(Sx[kt][qg][0], Sx[kt][qg][1]), fmaxf(Sx[kt][qg][2], Sx[kt][qg][3])));
                mx = fmaxf(mx, __shfl_xor(mx, 16)); mx = fmaxf(mx, __shfl_xor(mx, 32));
                const float mnew = fmaxf(mrun[qg], mx);
                const float alpha = __builtin_amdgcn_exp2f(mrun[qg] - mnew);
                mrun[qg] = mnew;
                float ls = 0.f;
#pragma unroll
                for (int kt = 0; kt < 4; ++kt)
#pragma unroll
                    for (int r = 0; r < 4; ++r) { const float pv = __builtin_amdgcn_exp2f(Sx[kt][qg][r] - mnew); ls += pv; Sx[kt][qg][r] = pv; }
                lrun[qg] = lrun[qg] * alpha + ls;
#pragma unroll
                for (int dt = 0; dt < 8; ++dt) O[qg][dt] *= alpha;
            }
#pragma unroll
            for (int ks2 = 0; ks2 < 2; ++ks2) {
                bf16x8 Pf[2];
#pragma unroll
                for (int qg = 0; qg < 2; ++qg) {
                    u32x4 pw; pw.x = cvt_pk_bf16_mfma(Sx[2 * ks2][qg][0], Sx[2 * ks2][qg][1]); pw.y = cvt_pk_bf16_mfma(Sx[2 * ks2][qg][2], Sx[2 * ks2][qg][3]);
                    pw.z = cvt_pk_bf16_mfma(Sx[2 * ks2 + 1][qg][0], Sx[2 * ks2 + 1][qg][1]); pw.w = cvt_pk_bf16_mfma(Sx[2 * ks2 + 1][qg][2], Sx[2 * ks2 + 1][qg][3]);
                    Pf[qg] = __builtin_bit_cast(bf16x8, pw);
                }
#pragma unroll
                for (int dt = 0; dt < 8; ++dt) {
                    const bf16x8 Vf = *(const bf16x8*)(st_ + 32768 + kh * 16384 + lds_byte_t<2>(dt * 16 + fr, ks2 * 32 + fq * 8));
                    O[0][dt] = __builtin_amdgcn_mfma_f32_16x16x32_bf16(Vf, Pf[0], O[0][dt], 0, 0, 0);
                    O[1][dt] = __builtin_amdgcn_mfma_f32_16x16x32_bf16(Vf, Pf[1], O[1][dt], 0, 0, 0);
                }
            }
        }
        if (j < qb) AT_WRITE(cur ^ 1);
        __syncthreads();
    }
#undef AT_ISSUE
#undef AT_WRITE
#pragma unroll
    for (int qg = 0; qg < 2; ++qg) { lrun[qg] += __shfl_xor(lrun[qg], 16); lrun[qg] += __shfl_xor(lrun[qg], 32); }
    f32x4* ob = (f32x4*)(stg + w * 16384);
    float* mlb = (float*)(stg + 65536 + w * 1024);
    if (kh == 1) {
#pragma unroll
        for (int qg = 0; qg < 2; ++qg) {
            mlb[(qg * 2 + 0) * 64 + lane] = mrun[qg]; mlb[(qg * 2 + 1) * 64 + lane] = lrun[qg];
#pragma unroll
            for (int dt = 0; dt < 8; ++dt) ob[(qg * 8 + dt) * 64 + lane] = O[qg][dt];
        }
    }
    __syncthreads();
    if (kh == 0) {
#pragma unroll
        for (int qg = 0; qg < 2; ++qg) {
            const float m2 = mlb[(qg * 2 + 0) * 64 + lane], l2 = mlb[(qg * 2 + 1) * 64 + lane];
            const float mt = fmaxf(mrun[qg], m2);
            const float e1 = __builtin_amdgcn_exp2f(mrun[qg] - mt), e2 = __builtin_amdgcn_exp2f(m2 - mt);
            const float inv = 1.0f / (lrun[qg] * e1 + l2 * e2);
            const float f1 = e1 * inv, f2 = e2 * inv;
            bf16_t* orow = p.attn + (tokb + q0 + 32 * w + 16 * qg + fr) * AW + hh * 128 + 4 * fq;
#pragma unroll
            for (int dt = 0; dt < 8; ++dt) {
                const f32x4 o2 = ob[(qg * 8 + dt) * 64 + lane];
                const f32x4 o = O[qg][dt] * f1 + o2 * f2;
                u32x2 ww; ww.x = cvt_pk_bf16(o[0], o[1]); ww.y = cvt_pk_bf16(o[2], o[3]);
                *(u32x2*)(orow + dt * 16) = ww;
            }
        }
    }
    __syncthreads();
}

__device__ __forceinline__ void phase_attn(const Params& p, char* lds, int vb, int nvb) {
    float* cs = (float*)lds;
    float* wtot = (float*)(lds + 8192);
    char* stg = lds + 8192 + 256;
    for (int u = vb; u < 256; u += nvb) {
        const int bh = u & 31, b = bh >> 3, hh = bh & 7, x = u >> 5;
        const int nkeys = (16 - x) * 128;
        {
            const int tid = tid_opaque(), wid = tid >> 6, lane = tid & 63;
            float v[4];
#pragma unroll
            for (int j = 0; j < 4; ++j) { const int s = tid * 4 + j; v[j] = s < nkeys ? p.ls[((size_t)b * S + s) * 8 + hh] : 0.f; }
            v[1] += v[0]; v[2] += v[1]; v[3] += v[2];
            float incl = v[3];
#pragma unroll
            for (int o = 1; o < 64; o <<= 1) { const float t = __shfl_up(incl, o); if (lane >= o) incl += t; }
            if (lane == 63) wtot[wid] = incl;
            __syncthreads();
            float base = incl - v[3];
            for (int ww = 0; ww < wid; ++ww) base += wtot[ww];
#pragma unroll
            for (int j = 0; j < 4; ++j) cs[tid * 4 + j] = (base + v[j]) * 1.4426950408889634f;
            __syncthreads();
        }
        attn_block(p, stg, cs, b, hh, 15 - x);
        attn_block(p, stg, cs, b, hh, x);
    }
}

__device__ __forceinline__ void phase_gmlp_naive(const Params& p, char* lds, int vb, int nvb) {
    float* vn = (float*)lds;
    float* st = vn + 128 * 128;
    const int tid = tid_opaque(), wid = tid >> 6, lane = tid & 63;
    for (int u = vb; u < 512; u += nvb) {
        const int g = u & 7, bc = u >> 3;
        const size_t tok0 = (size_t)bc * 128;
        __syncthreads();
        for (int rr = 0; rr < 16; ++rr) {
            const int s = wid * 16 + rr;
            const bf16_t* vp = p.zg + (tok0 + s) * 2048 + 1024 + lane * 16;
            const u32x4 a = *(const u32x4*)vp, b = *(const u32x4*)(vp + 8);
            float sum = 0.f, sq = 0.f;
            const unsigned ww[8] = {a.x, a.y, a.z, a.w, b.x, b.y, b.z, b.w};
#pragma unroll
            for (int j = 0; j < 8; ++j) { const float lo = bf_lo(ww[j]), hi = bf_hi(ww[j]); sum += lo + hi; sq += lo * lo + hi * hi; }
            sum = wave_sum(sum); sq = wave_sum(sq);
            const float mean = sum * (1.0f / 1024.f); const float var = fmaxf(sq * (1.0f / 1024.f) - mean * mean, 0.f);
            if (lane == 0) { st[s * 2] = mean; st[s * 2 + 1] = rsqrtf(var + 1e-5f); }
        }
        __syncthreads();
        for (int idx = tid; idx < 128 * 16; idx += NTHREADS) {
            const int s = idx >> 4, dc = idx & 15;
            const u32x4 a = *(const u32x4*)(p.zg + (tok0 + s) * 2048 + 1024 + g * 128 + dc * 8);
            const float mean = st[s * 2], rstd = st[s * 2 + 1];
            const unsigned ww[4] = {a.x, a.y, a.z, a.w};
#pragma unroll
            for (int j = 0; j < 4; ++j) {
                const int c = g * 128 + dc * 8 + j * 2;
                vn[s * 128 + dc * 8 + j * 2]     = (bf_lo(ww[j]) - mean) * rstd * p.g_v_ln[c]     + p.b_v_ln[c];
                vn[s * 128 + dc * 8 + j * 2 + 1] = (bf_hi(ww[j]) - mean) * rstd * p.g_v_ln[c + 1] + p.b_v_ln[c + 1];
            }
        }
        __syncthreads();
        for (int rr = 0; rr < 16; ++rr) {
            const int t = wid * 16 + rr;
            const float* wrow = p.w_spatial + ((size_t)g * 128 + t) * 128;
            float a0 = 0.f, a1 = 0.f;
            for (int s = 0; s <= t; ++s) { const float w = wrow[s]; a0 += w * vn[s * 128 + lane]; a1 += w * vn[s * 128 + lane + 64]; }
            const float bs = p.b_spatial[g * 128 + t];
            const bf16_t* up = p.zg + (tok0 + t) * 2048 + g * 128;
            const float u0 = __uint_as_float((unsigned)up[lane] << 16), u1 = __uint_as_float((unsigned)up[lane + 64] << 16);
            bf16_t* op = p.sg + (tok0 + t) * GW + g * 128;
            op[lane] = (bf16_t)(cvt_pk_bf16(u0 * (a0 + bs), 0.f) & 0xffffu);
            op[lane + 64] = (bf16_t)(cvt_pk_bf16(u1 * (a1 + bs), 0.f) & 0xffffu);
        }
    }
    __syncthreads();
}

__device__ __forceinline__ void phase_gmlp(const Params& p, char* lds, int vb, int nvb) {
    float* st = (float*)lds;
    char* wimg = lds + 1024;
    char* vimg = lds + 1024 + 32768;
    const int tid = tid_opaque(), wid = tid >> 6, lane = tid & 63, fr = lane & 15, fq = lane >> 4;
    for (int u = vb; u < 512; u += nvb) {
        const int g = u & 7, bc = u >> 3;
        const size_t tok0 = (size_t)bc * 128;
        __syncthreads();
        if (tid < 128) {
            const float* pp = p.lnpart + (tok0 + tid) * 32;
            float sum = 0.f, sq = 0.f;
#pragma unroll
            for (int k = 0; k < 8; ++k) { const f32x4 t4 = *(const f32x4*)(pp + k * 4); sum += t4[0] + t4[2]; sq += t4[1] + t4[3]; }
            const float mean = sum * (1.0f / 1024.f); const float var = fmaxf(sq * (1.0f / 1024.f) - mean * mean, 0.f);
            st[tid * 2] = mean; st[tid * 2 + 1] = rsqrtf(var + 1e-5f);
        }
#pragma unroll
        for (int i = 0; i < 4; ++i) {
            const int q = tid + 512 * i, t = q >> 4, sc = q & 15;
            const float* wp = p.w_spatial + ((size_t)g * 128 + t) * 128 + sc * 8;
            const f32x4 w0 = *(const f32x4*)wp, w1 = *(const f32x4*)(wp + 4);
            float wv[8] = {w0[0], w0[1], w0[2], w0[3], w1[0], w1[1], w1[2], w1[3]};
#pragma unroll
            for (int j = 0; j < 8; ++j) wv[j] = (sc * 8 + j <= t) ? wv[j] : 0.f;
            u32x4 pk; pk.x = cvt_pk_bf16(wv[0], wv[1]); pk.y = cvt_pk_bf16(wv[2], wv[3]); pk.z = cvt_pk_bf16(wv[4], wv[5]); pk.w = cvt_pk_bf16(wv[6], wv[7]);
            *(u32x4*)(wimg + lds_byte_t<4>(t, sc * 8)) = pk;
        }
        __syncthreads();
        {
            const int vq4 = tid >> 4, vd8 = tid & 15;
            float vals[4][8];
            const f32x4 lg0 = *(const f32x4*)(p.g_v_ln + g * 128 + vd8 * 8), lg1 = *(const f32x4*)(p.g_v_ln + g * 128 + vd8 * 8 + 4);
            const f32x4 lb0 = *(const f32x4*)(p.b_v_ln + g * 128 + vd8 * 8), lb1 = *(const f32x4*)(p.b_v_ln + g * 128 + vd8 * 8 + 4);
            const float lgv[8] = {lg0[0], lg0[1], lg0[2], lg0[3], lg1[0], lg1[1], lg1[2], lg1[3]}, lbv[8] = {lb0[0], lb0[1], lb0[2], lb0[3], lb1[0], lb1[1], lb1[2], lb1[3]};
#pragma unroll
            for (int r = 0; r < 4; ++r) {
                const int s = 4 * vq4 + r;
                const u32x4 a = *(const u32x4*)(p.zg + (tok0 + s) * 2048 + 1024 + g * 128 + vd8 * 8);
                const float mean = st[s * 2], rstd = st[s * 2 + 1];
                const unsigned ww[4] = {a.x, a.y, a.z, a.w};
#pragma unroll
                for (int j = 0; j < 4; ++j) {
                    vals[r][2 * j] = (bf_lo(ww[j]) - mean) * rstd * lgv[2 * j] + lbv[2 * j];
                    vals[r][2 * j + 1] = (bf_hi(ww[j]) - mean) * rstd * lgv[2 * j + 1] + lbv[2 * j + 1];
                }
            }
#pragma unroll
            for (int dd = 0; dd < 8; ++dd) {
                u32x2 w_; w_.x = cvt_pk_bf16(vals[0][dd], vals[1][dd]); w_.y = cvt_pk_bf16(vals[2][dd], vals[3][dd]);
                *(u32x2*)(vimg + lds_byte_t<4>(vd8 * 8 + dd, 4 * vq4)) = w_;
            }
        }
        __syncthreads();
        f32x4 acc[8];
#pragma unroll
        for (int tt = 0; tt < 8; ++tt) acc[tt] = (f32x4){0.f, 0.f, 0.f, 0.f};
#pragma unroll
        for (int ks = 0; ks < 4; ++ks) {
            const bf16x8 Af = *(const bf16x8*)(vimg + lds_byte_t<4>(wid * 16 + fr, ks * 32 + fq * 8));
#pragma unroll
            for (int tt = 0; tt < 8; ++tt) {
                if (2 * ks <= tt) {
                    const bf16x8 Bf = *(const bf16x8*)(wimg + lds_byte_t<4>(tt * 16 + fr, ks * 32 + fq * 8));
                    acc[tt] = __builtin_amdgcn_mfma_f32_16x16x32_bf16(Af, Bf, acc[tt], 0, 0, 0);
                }
            }
        }
        u32x2 uu[8]; float bsv[8];
#pragma unroll
        for (int tt = 0; tt < 8; ++tt) { const int t = tt * 16 + fr; bsv[tt] = p.b_spatial[g * 128 + t]; uu[tt] = *(const u32x2*)(p.zg + (tok0 + t) * 2048 + g * 128 + wid * 16 + fq * 4); }
#pragma unroll
        for (int tt = 0; tt < 8; ++tt) {
            const int t = tt * 16 + fr; const float bs = bsv[tt];
            u32x2 w_; w_.x = cvt_pk_bf16(bf_lo(uu[tt].x) * (acc[tt][0] + bs), bf_hi(uu[tt].x) * (acc[tt][1] + bs)); w_.y = cvt_pk_bf16(bf_lo(uu[tt].y) * (acc[tt][2] + bs), bf_hi(uu[tt].y) * (acc[tt][3] + bs));
            *(u32x2*)(p.sg + (tok0 + t) * GW + g * 128 + wid * 16 + fq * 4) = w_;
        }
    }
    __syncthreads();
}

__device__ __forceinline__ void phase_branch(const Params& p, char* lds, int vb, int nvb) {
    for (int u = vb; u < 32 * 8; u += nvb) {
        const int pm = u >> 3, pn = u & 7;
        gemm_tile<D, false, false>(lds, p.attn, AW, nullptr, pm * 256, 256, p.w_ba + pn * 256, AW,
            [&](const f32x4 (&acc)[8][4], int wr, int wc, int fr, int fq) {
#pragma unroll
                for (int m = 0; m < 8; ++m) {
                    const size_t row = (size_t)pm * 256 + wr * 128 + m * 16 + fr;
#pragma unroll
                    for (int n = 0; n < 4; ++n) {
                        const int c = pn * 256 + wc * 64 + n * 16 + fq * 4;
                        const u32x2 gg = *(const u32x2*)(p.gates + row * 4096 + c);
                        f32x4 v = acc[m][n];
                        v[0] *= bf_lo(gg.x); v[1] *= bf_hi(gg.x); v[2] *= bf_lo(gg.y); v[3] *= bf_hi(gg.y);
                        *(f32x4*)(p.x1 + row * D + c) = v;
                    }
                }
            });
        gemm_tile<D, false, false>(lds, p.sg, GW, nullptr, pm * 256, 256, p.w_bg + pn * 256, GW,
            [&](const f32x4 (&acc)[8][4], int wr, int wc, int fr, int fq) {
#pragma unroll
                for (int m = 0; m < 8; ++m) {
                    const size_t row = (size_t)pm * 256 + wr * 128 + m * 16 + fr;
#pragma unroll
                    for (int n = 0; n < 4; ++n) {
                        const int c = pn * 256 + wc * 64 + n * 16 + fq * 4;
                        const u32x2 gg = *(const u32x2*)(p.gates + row * 4096 + 2048 + c);
                        const f32x4 prev = *(const f32x4*)(p.x1 + row * D + c);
                        f32x4 v = acc[m][n];
                        v[0] = prev[0] + v[0] * bf_lo(gg.x); v[1] = prev[1] + v[1] * bf_hi(gg.x); v[2] = prev[2] + v[2] * bf_lo(gg.y); v[3] = prev[3] + v[3] * bf_hi(gg.y);
                        u32x2 w; w.x = cvt_pk_bf16(v[0], v[1]); w.y = cvt_pk_bf16(v[2], v[3]);
                        *(u32x2*)(p.merged + row * D + c) = w;
                    }
                }
            });
    }
}

__device__ __forceinline__ void phase_outproj(const Params& p, char* lds, int vb, int nvb) {
    for (int u = vb; u < 32 * 8; u += nvb) {
        const int pm = u >> 3, pn = u & 7;
        gemm_tile<D, false, false>(lds, p.merged, D, nullptr, pm * 256, 256, p.w_out + pn * 256, D,
            [&](const f32x4 (&acc)[8][4], int wr, int wc, int fr, int fq) {
#pragma unroll
                for (int m = 0; m < 8; ++m) {
                    const size_t row = (size_t)pm * 256 + wr * 128 + m * 16 + fr;
#pragma unroll
                    for (int n = 0; n < 4; ++n) {
                        const int c = pn * 256 + wc * 64 + n * 16 + fq * 4;
                        const f32x4 xr = *(const f32x4*)(p.x + row * D + c);
                        *(f32x4*)(p.x1 + row * D + c) = xr + acc[m][n];
                    }
                }
            });
    }
}

__device__ __forceinline__ void phase_router(const Params& p, char* lds, int vb, int nvb) {
    constexpr int RS = 4112;
    char* img_hi = lds;
    char* img_lo = lds + 16 * RS;
    float* part = (float*)lds;
    float* logit = (float*)(lds + 32 * RS);
    int* cnt = (int*)(lds + 32 * RS + 16 * 32 * 4);
    const int tid = tid_opaque(), wid = tid >> 6, lane = tid & 63, fr = lane & 15, fq = lane >> 4;
    bf16x8 bh0[8], bl0[8], bh1[8], bl1[8];
#pragma unroll
    for (int ks = 0; ks < 8; ++ks) {
        const int k0 = wid * 256 + ks * 32 + fq * 8;
        bh0[ks] = *(const bf16x8*)(p.wr_hi + (size_t)fr * D + k0); bl0[ks] = *(const bf16x8*)(p.wr_lo + (size_t)fr * D + k0);
        bh1[ks] = *(const bf16x8*)(p.wr_hi + (size_t)(16 + fr) * D + k0); bl1[ks] = *(const bf16x8*)(p.wr_lo + (size_t)(16 + fr) * D + k0);
    }
    for (int c = vb; c < NCHUNK; c += nvb) {
        for (int pass = 0; pass < 2; ++pass) {
            __syncthreads();
#pragma unroll
            for (int i2 = 0; i2 < 2; ++i2) {
                const int tl = 2 * wid + i2, tok = c * 32 + pass * 16 + tl;
                const bf16_t* xr = p.x1b + (size_t)tok * D;
                f32x4 xv[8]; float ss = 0.f;
#pragma unroll
                for (int i = 0; i < 8; ++i) { const u32x2 xb = *(const u32x2*)(xr + i * 256 + lane * 4); xv[i] = (f32x4){bf_lo(xb.x), bf_hi(xb.x), bf_lo(xb.y), bf_hi(xb.y)};
                    ss += xv[i][0] * xv[i][0] + xv[i][1] * xv[i][1] + xv[i][2] * xv[i][2] + xv[i][3] * xv[i][3]; }
                ss = wave_sum(ss);
                const float rstd = rsqrtf(ss * (1.0f / D) + 1e-5f);
#pragma unroll
                for (int i = 0; i < 8; ++i) {
                    const f32x4 g = *(const f32x4*)(p.g_ffn + i * 256 + lane * 4);
                    const f32x4 hv = xv[i] * rstd * g;
                    u32x2 hi; hi.x = cvt_pk_bf16(hv[0], hv[1]); hi.y = cvt_pk_bf16(hv[2], hv[3]);
                    *(unsigned*)((unsigned char*)p.h2 + (size_t)tok * D + i * 256 + lane * 4) = pack_fp8x4(hv[0], hv[1], hv[2], hv[3]);
                    u32x2 lo; lo.x = cvt_pk_bf16(hv[0] - bf_lo(hi.x), hv[1] - bf_hi(hi.x)); lo.y = cvt_pk_bf16(hv[2] - bf_lo(hi.y), hv[3] - bf_hi(hi.y));
                    *(u32x2*)(img_hi + tl * RS + (i * 256 + lane * 4) * 2) = hi;
                    *(u32x2*)(img_lo + tl * RS + (i * 256 + lane * 4) * 2) = lo;
                }
            }
            __syncthreads();
            f32x4 acc0 = {0.f, 0.f, 0.f, 0.f}, acc1 = {0.f, 0.f, 0.f, 0.f};
#pragma unroll
            for (int ks = 0; ks < 8; ++ks) {
                const int k0 = wid * 256 + ks * 32 + fq * 8;
                const bf16x8 ah = *(const bf16x8*)(img_hi + fr * RS + k0 * 2), al = *(const bf16x8*)(img_lo + fr * RS + k0 * 2);
                acc0 = __builtin_amdgcn_mfma_f32_16x16x32_bf16(al, bh0[ks], acc0, 0, 0, 0); acc0 = __builtin_amdgcn_mfma_f32_16x16x32_bf16(ah, bl0[ks], acc0, 0, 0, 0); acc0 = __builtin_amdgcn_mfma_f32_16x16x32_bf16(ah, bh0[ks], acc0, 0, 0, 0);
                acc1 = __builtin_amdgcn_mfma_f32_16x16x32_bf16(al, bh1[ks], acc1, 0, 0, 0); acc1 = __builtin_amdgcn_mfma_f32_16x16x32_bf16(ah, bl1[ks], acc1, 0, 0, 0); acc1 = __builtin_amdgcn_mfma_f32_16x16x32_bf16(ah, bh1[ks], acc1, 0, 0, 0);
            }
            __syncthreads();
#pragma unroll
            for (int r = 0; r < 4; ++r) { part[(wid * 16 + 4 * fq + r) * 32 + fr] = acc0[r]; part[(wid * 16 + 4 * fq + r) * 32 + 16 + fr] = acc1[r]; }
            if (pass == 0 && tid < 32) cnt[tid] = 0;
            __syncthreads();
            { const int tk2 = tid >> 5, e = tid & 31; float sacc = p.b_router[e];
#pragma unroll
              for (int ww = 0; ww < 8; ++ww) sacc += part[(ww * 16 + tk2) * 32 + e];
              logit[tk2 * 32 + e] = sacc; }
            __syncthreads();
            {
                const int tl = 2 * wid + (lane >> 5), e = lane & 31, tok = c * 32 + pass * 16 + tl;
                float val = logit[tl * 32 + e];
                float sv[4]; int si[4];
#pragma unroll
                for (int r = 0; r < 4; ++r) {
                    float mx = val;
#pragma unroll
                    for (int o = 16; o; o >>= 1) mx = fmaxf(mx, __shfl_xor(mx, o));
                    const unsigned long long bal = __ballot(val == mx);
                    const unsigned half = (unsigned)(lane >> 5 ? (bal >> 32) : (bal & 0xffffffffull));
                    const int idx = __ffs((int)half) - 1;
                    sv[r] = mx; si[r] = idx;
                    if (e == idx) val = -INFINITY;
                }
                const float e1 = __expf(sv[1] - sv[0]), e2 = __expf(sv[2] - sv[0]), e3 = __expf(sv[3] - sv[0]);
                const float inv = 1.0f / (1.0f + e1 + e2 + e3);
                if (e < 4) {
                    const int myi = e == 0 ? si[0] : e == 1 ? si[1] : e == 2 ? si[2] : si[3];
                    const float myg = (e == 0 ? 1.0f : e == 1 ? e1 : e == 2 ? e2 : e3) * inv;
                    p.top_idx[tok * 4 + e] = myi; p.top_gate[tok * 4 + e] = myg;
                    atomicAdd(&cnt[myi], 1);
                }
            }
        }
        __syncthreads();
        if (tid < 32) p.blk_cnt[c * 32 + tid] = cnt[tid];
    }
    __syncthreads();
}

__device__ __forceinline__ void phase_dispatch(const Params& p, char* lds, int vb, int nvb) {
    int* base = (int*)lds;
    int* tot = base + 32;
    int* start = tot + 32;
    int* tb = start + 32;
    int* red = tb + 64;
    int* idx = red + 16 * 32 * 2;
    const int tid = tid_opaque();
    for (int c = vb; c < NCHUNK; c += nvb) {
        __syncthreads();
        {
            const int e = tid & 31, part = tid >> 5;
            int total = 0, before = 0;
#pragma unroll 4
            for (int k = 0; k < 16; ++k) { const int cc = part * 16 + k; const int v = p.blk_cnt[cc * 32 + e]; total += v; before += (cc < c) ? v : 0; }
            red[(part * 32 + e) * 2] = total; red[(part * 32 + e) * 2 + 1] = before;
        }
        if (tid < 128) idx[tid] = p.top_idx[c * 128 + tid];
        __syncthreads();
        if (tid < 32) {
            int total = 0, before = 0;
#pragma unroll
            for (int k = 0; k < 16; ++k) { total += red[(k * 32 + tid) * 2]; before += red[(k * 32 + tid) * 2 + 1]; }
            int incl = total;
#pragma unroll
            for (int o = 1; o < 32; o <<= 1) { const int t = __shfl_up(incl, o); if (tid >= o) incl += t; }
            const int st = incl - total;
            base[tid] = st + before; tot[tid] = total; start[tid] = st;
        }
        __syncthreads();
        if (c == vb) {
            if (tid == 0) {
                int n = 0;
                for (int e = 0; e < NE; ++e) { tb[e] = n; n += (tot[e] + 255) >> 8; }
                tb[NE] = n; if (vb == 0) p.ntiles[0] = n;
            }
            __syncthreads();
            const int ntl = tb[NE];
            for (int w = vb * NTHREADS + tid; w < ntl * 16; w += (nvb < NCHUNK ? nvb : NCHUNK) * NTHREADS) { int e = 0; while (16 * tb[e + 1] <= w) ++e; const int Te = tb[e + 1] - tb[e], r = w - 16 * tb[e]; const int mt = r % Te, cntv = tot[e]; p.unit_up[2 * w] = (e << 24) | ((r / Te) << 16) | (tb[e] + mt); p.unit_up[2 * w + 1] = (start[e] + mt * 256) | (min(256, cntv - mt * 256) << 16); }
            for (int w = vb * NTHREADS + tid; w < ntl * 8; w += (nvb < NCHUNK ? nvb : NCHUNK) * NTHREADS) { int e = 0; while (8 * tb[e + 1] <= w) ++e; const int Te = tb[e + 1] - tb[e], r = w - 8 * tb[e]; const int mt = r % Te, cntv = tot[e]; p.unit_down[2 * w] = (e << 24) | ((r / Te) << 16) | (tb[e] + mt); p.unit_down[2 * w + 1] = (start[e] + mt * 256) | (min(256, cntv - mt * 256) << 16); }
        }
        if (tid < 128) {
            const int e = idx[tid];
            int rank = 0;
            for (int j = 0; j < tid; ++j) rank += (idx[j] == e) ? 1 : 0;
            const int row = base[e] + rank, a = c * 128 + tid;
            p.row_tok[row] = a >> 2; p.row_dst[row] = a; p.row_gate[row] = p.top_gate[a];
        }
    }
    __syncthreads();
}

__device__ __forceinline__ void phase_moe_up(const Params& p, char* lds, int vb, int nvb) {
    const int nt = p.ntiles[0];
    for (int u = vb; u < nt * 16; u += nvb) {
        const int tile = u >> 4, pn = u & 15;
        const int e = p.tile_e[tile], row0 = p.tile_row0[tile], nv = p.tile_nrows[tile];
        gemm_tile<2 * DFF, true, true>(lds, p.h2, D, p.row_tok, row0, nv, p.w_up + (size_t)e * D * (2 * DFF) + pn * 256, D,
            [&](const f32x4 (&acc)[8][4], int wr, int wc, int fr, int fq) {
#pragma unroll
                for (int m = 0; m < 8; ++m) {
                    const int r = tile_row<true>(wr, m, fr);
                    if (r < nv) {
#pragma unroll
                        for (int n = 0; n < 4; ++n) {
                            const int c = pn * 256 + wc * 64 + n * 16 + fq * 4;
                            const f32x4 bb = *(const f32x4*)(p.b_up + (size_t)e * (2 * DFF) + c);
                            const f32x4 v = acc[m][n] + bb;
                            const float g0 = fminf(v[0], 7.f), l0 = fminf(fmaxf(v[1], -7.f), 7.f);
                            const float g1 = fminf(v[2], 7.f), l1 = fminf(fmaxf(v[3], -7.f), 7.f);
                            const float a0 = g0 * sigmoidf_(1.702f * g0) * (l0 + 1.0f), a1 = g1 * sigmoidf_(1.702f * g1) * (l1 + 1.0f);
                            *(unsigned*)(p.act + (size_t)(row0 + r) * DFF + (c >> 1)) = cvt_pk_bf16(a0, a1);
                        }
                    }
                }
            });
    }
}

__device__ __forceinline__ void phase_moe_down(const Params& p, char* lds, int vb, int nvb) {
    const int nt = p.ntiles[0];
    for (int u = vb; u < nt * 8; u += nvb) {
        const int tile = u >> 3, pn = u & 7;
        const int e = p.tile_e[tile], row0 = p.tile_row0[tile], nv = p.tile_nrows[tile];
        gemm_tile<D, false, true>(lds, p.act, DFF, nullptr, row0, nv, p.w_down + (size_t)e * DFF * D + pn * 256, DFF,
            [&](const f32x4 (&acc)[8][4], int wr, int wc, int fr, int fq) {
#pragma unroll
                for (int m = 0; m < 8; ++m) {
                    const int r = tile_row<true>(wr, m, fr);
                    if (r < nv) {
                        const float gate = p.row_gate[row0 + r];
                        const size_t dst = (size_t)p.row_dst[row0 + r] * D;
#pragma unroll
                        for (int n = 0; n < 4; ++n) {
                            const int c = pn * 256 + wc * 64 + n * 16 + fq * 4;
                            const f32x4 bb = *(const f32x4*)(p.b_down + (size_t)e * D + c);
                            const f32x4 v = (acc[m][n] + bb) * gate;
                            u32x2 w; w.x = cvt_pk_bf16(v[0], v[1]); w.y = cvt_pk_bf16(v[2], v[3]);
                            *(u32x2*)(p.y + dst + c) = w;
                        }
                    }
                }
            });
    }
}

__device__ __forceinline__ void phase_final(const Params& p, char* lds, int vb, int nvb) {
    const int tid = tid_opaque(), wid = tid >> 6, lane = tid & 63;
    for (int tok = vb * 8 + wid; tok < T; tok += nvb * 8) {
        f32x4 xv[8]; float ss = 0.f;
#pragma unroll
        for (int i = 0; i < 8; ++i) {
            const u32x2 xb = *(const u32x2*)(p.x1b + (size_t)tok * D + i * 256 + lane * 4);
            f32x4 v = {bf_lo(xb.x), bf_hi(xb.x), bf_lo(xb.y), bf_hi(xb.y)};
#pragma unroll
            for (int j = 0; j < 4; ++j) {
                const u32x2 yy = *(const u32x2*)(p.y + ((size_t)tok * 4 + j) * D + i * 256 + lane * 4);
                v[0] += bf_lo(yy.x); v[1] += bf_hi(yy.x); v[2] += bf_lo(yy.y); v[3] += bf_hi(yy.y);
            }
            xv[i] = v; ss += v[0] * v[0] + v[1] * v[1] + v[2] * v[2] + v[3] * v[3];
        }
        ss = wave_sum(ss);
        const float rstd = rsqrtf(ss * (1.0f / D) + 1e-5f);
#pragma unroll
        for (int i = 0; i < 8; ++i) {
            const f32x4 g = *(const f32x4*)(p.g_final + i * 256 + lane * 4);
            *(f32x4*)(p.out + (size_t)tok * D + i * 256 + lane * 4) = xv[i] * rstd * g;
        }
    }
}

template <int MODE>
__global__ void __launch_bounds__(NTHREADS, 2) k_fwd(Params p_kernarg) {
    extern __shared__ __attribute__((aligned(1024))) char lds[];
    const Params& p = *(const Params*)__builtin_amdgcn_kernarg_segment_ptr();
    const int vb = blockIdx.x, nvb = gridDim.x;
    XcdBarrier bar;
    if (MODE < 0) {
        volatile LAS unsigned* st = (volatile LAS unsigned*)(lds + LDS_BYTES - 16);
        if (threadIdx.x == 0) { st[0] = 0u; st[1] = 0u; st[2] = 0u; st[3] = 0u; }
        __syncthreads();
        bar = xcd_barrier_post(p.bar, st);
    }
#ifndef PROBE_MASK
#define PROBE_MASK 0
#endif
#define PHASE(i, call) if (MODE < 0 || MODE == (i)) { call; } if (MODE < 0) xcd_barrier(bar); if (MODE < 0 && ((PROBE_MASK >> (i)) & 1)) { call; xcd_barrier(bar); }
    PHASE(0, (phase_prologue(p, lds, vb, nvb), phase_convert_dense(p, lds, vb, nvb)))
    PHASE(1, phase_inproj_conv(p, lds, vb, nvb))
    PHASE(2, (phase_attn(p, lds, vb, nvb), phase_gmlp(p, lds, vb, nvb)))
    PHASE(3, phase_branch8(p, lds, vb, nvb))
    PHASE(4, phase_outproj8(p, lds, vb, nvb))
    PHASE(5, phase_router(p, lds, vb, nvb))
    PHASE(6, phase_dispatch(p, lds, vb, nvb))
    PHASE(7, phase_moe_up8(p, lds, vb, nvb))
    PHASE(8, phase_moe_down8(p, lds, vb, nvb))
    if (MODE < 0 || MODE == 9) phase_final(p, lds, vb, nvb);
}

template <int MODE> static void launch_phase(const Params& p, int grid, hipStream_t stream) {
    static bool attr = false;
    if (!attr) { (void)hipFuncSetAttribute((const void*)k_fwd<MODE>, hipFuncAttributeMaxDynamicSharedMemorySize, LDS_BYTES); attr = true; }
    hipLaunchKernelGGL(k_fwd<MODE>, dim3(grid), dim3(NTHREADS), LDS_BYTES, stream, p);
}

extern "C" void kernel_launch(void* const* d_in, const int* in_sizes, int n_in, void* d_out, int out_size, void* d_ws, size_t ws_size, hipStream_t stream) {
    Params p; memset(&p, 0, sizeof(p));
    const float* const* in = (const float* const*)d_in;
    p.x = in[0]; p.g_mix = in[1]; p.w_in = in[2]; p.b_forget = in[3]; p.g_v_ln = in[4]; p.b_v_ln = in[5]; p.w_spatial = in[6]; p.b_spatial = in[7];
    p.w_ba = in[8]; p.w_bg = in[9]; p.w_out = in[10]; p.g_ffn = in[11]; p.w_router = in[12]; p.b_router = in[13];
    p.w_up = in[14]; p.b_up = in[15]; p.w_down = in[16]; p.b_down = in[17]; p.g_final = in[18];
    p.out = (float*)d_out;
    char* w = (char*)d_ws; size_t off = 0;
    auto take = [&](size_t bytes) { char* r = w + off; off += (bytes + 255) & ~(size_t)255; return r; };
    p.bar = (unsigned*)take(XCD_BAR_WORDS * 4);
    p.h = (bf16_t*)take((size_t)T * D * 2);
    p.q = (bf16_t*)take((size_t)T * AW * 2); p.k = (bf16_t*)take((size_t)T * AW * 2); p.v = (bf16_t*)take((size_t)T * AW * 2);
    p.zg = (bf16_t*)take((size_t)T * 2048 * 2); p.gates = (bf16_t*)take((size_t)T * 4096 * 2);
    p.attn = (bf16_t*)take((size_t)T * AW * 2); p.sg = (bf16_t*)take((size_t)T * GW * 2);
    p.merged = (bf16_t*)take((size_t)T * D * 2); p.h2 = (bf16_t*)take((size_t)T * D * 2);
    p.h8 = (unsigned char*)take((size_t)T * D); p.wb_in8 = (unsigned char*)take((size_t)9216 * D);
    p.wr_hi = (bf16_t*)take((size_t)NE * D * 2); p.wr_lo = (bf16_t*)take((size_t)NE * D * 2);
    p.act = (bf16_t*)take((size_t)T * 4 * DFF * 2); p.y = (bf16_t*)take((size_t)T * 4 * D * 2);
    p.wb_in = (bf16_t*)take((size_t)9216 * D * 2); p.wb_ba = (bf16_t*)take((size_t)D * AW * 2); p.wb_bg = (bf16_t*)take((size_t)D * GW * 2); p.wb_out = (bf16_t*)take((size_t)D * D * 2);
    p.wb_up = (bf16_t*)take((size_t)NE * 2 * DFF * D * 2); p.wb_down = (bf16_t*)take((size_t)NE * D * DFF * 2);
    p.ls = (float*)take((size_t)T * 8 * 4); p.lnpart = (float*)take((size_t)T * 16 * 2 * 4); p.x1 = (float*)take((size_t)T * D * 4); p.x1b = (bf16_t*)p.x1;
    p.top_gate = (float*)take((size_t)T * 4 * 4); p.row_gate = (float*)take((size_t)T * 4 * 4);
    p.top_idx = (int*)take((size_t)T * 4 * 4); p.blk_cnt = (int*)take((size_t)NCHUNK * 32 * 4);
    p.row_tok = (int*)take((size_t)T * 4 * 4); p.row_dst = (int*)take((size_t)T * 4 * 4);
    p.tile_e = (int*)take(MAXTILES * 4); p.tile_row0 = (int*)take(MAXTILES * 4); p.tile_nrows = (int*)take(MAXTILES * 4); p.ntiles = (int*)take(256); p.unit_up = (int*)take(MAXTILES * 16 * 8); p.unit_down = (int*)take(MAXTILES * 8 * 8);
#if MK_SINGLE
    static int grid = 0;
    if (!grid) {
        int dev = 0, cus = 0, per_cu = 0;
        (void)hipGetDevice(&dev);
        (void)hipDeviceGetAttribute(&cus, hipDeviceAttributeMultiprocessorCount, dev);
        (void)hipFuncSetAttribute((const void*)k_fwd<-1>, hipFuncAttributeMaxDynamicSharedMemorySize, LDS_BYTES);
        (void)hipOccupancyMaxActiveBlocksPerMultiprocessor(&per_cu, k_fwd<-1>, NTHREADS, LDS_BYTES);
        if (cus <= 0) cus = 256;
        grid = cus * (per_cu < 1 ? 1 : 1);
    }
    (void)hipMemsetAsync(p.bar, 0, XCD_BAR_WORDS * 4, stream);
    launch_phase<-1>(p, grid, stream);
#else
    launch_phase<0>(p, 256, stream); launch_phase<1>(p, 256, stream); launch_phase<2>(p, 256, stream); launch_phase<3>(p, 256, stream);
    launch_phase<4>(p, 256, stream); launch_phase<5>(p, 256, stream); launch_phase<6>(p, 256, stream); launch_phase<7>(p, 256, stream);
    launch_phase<8>(p, 256, stream); launch_phase<9>(p, 256, stream);
#endif
}
```

```cpp
#include <hip/hip_runtime.h>
#include <type_traits>
#include <stdint.h>
#include <string.h>
#include <stdio.h>

#ifndef MK_SINGLE
#define MK_SINGLE 1
#endif

typedef unsigned short bf16_t;
typedef short bf16x8 __attribute__((ext_vector_type(8)));
typedef float f32x4 __attribute__((ext_vector_type(4)));
typedef float f32x2 __attribute__((ext_vector_type(2)));
typedef unsigned u32x4 __attribute__((ext_vector_type(4)));
typedef unsigned u32x2 __attribute__((ext_vector_type(2)));
typedef int i32x4 __attribute__((ext_vector_type(4)));
typedef int i32x8 __attribute__((ext_vector_type(8)));

constexpr int D = 2048, NB = 4, S = 2048, T = NB * S, H = 8, DH = 128, AW = 1024, GW = 1024, PW = 9224, NE = 32, DFF = 2048;
constexpr int PN_SPLIT = 20;
constexpr int NCHUNK = 256;
constexpr int MAXTILES = 192;
constexpr int NTHREADS = 512;
constexpr int LDS_BYTES = 144 * 1024;

#define XB_TMO      128
#define XB_XCNT(j)  (256  + 64 * (j))
#define XB_XSUB(j)  (1280 + 64 * (j))
#define XB_XGEN(j)  (2304 + 64 * (j))
#define XB_TOP      3328
#define XB_TOPGEN   3392
#define XCD_BAR_WORDS 3456
#define XB_SPIN_CAP (1u << 22)
#define LAS __attribute__((address_space(3)))

__device__ __forceinline__ unsigned xb_ld(unsigned* p)              { return __hip_atomic_load(p, __ATOMIC_RELAXED, __HIP_MEMORY_SCOPE_AGENT); }
__device__ __forceinline__ unsigned xb_add(unsigned* p, unsigned v) { return __hip_atomic_fetch_add(p, v, __ATOMIC_RELAXED, __HIP_MEMORY_SCOPE_AGENT); }
__device__ __forceinline__ unsigned xb_xcc_id() { return (unsigned)__builtin_amdgcn_s_getreg((3 << 11) | 20) & 0xFu; }
#define XB_SPIN(cond, bar) do { unsigned _sp = 0; while (cond) { __builtin_amdgcn_s_sleep(1); \
    if ((++_sp & 255u) == 0u) { if (xb_ld(&(bar)[XB_TMO])) break; if (_sp > XB_SPIN_CAP) { atomicAdd(&(bar)[XB_TMO], 1u); break; } } } } while (0)

struct XcdBarrier { unsigned* bar; unsigned x; volatile LAS unsigned* st; };

__device__ __forceinline__ XcdBarrier xcd_barrier_post(unsigned* bar, volatile LAS unsigned* st) {
    XcdBarrier b; b.bar = bar; b.x = xb_xcc_id(); b.st = st;
    if (threadIdx.x == 0) (void)xb_add(&bar[XB_XCNT(b.x)], 1u);
    return b;
}
__device__ __forceinline__ void xcd_barrier_complete(unsigned* bar, unsigned x, unsigned& nloc, unsigned& nx) {
    const unsigned G = gridDim.x * gridDim.y * gridDim.z;
    unsigned sum, cnt, mine, sp = 0u;
    for (;;) {
        sum = 0u; cnt = 0u; mine = 0u;
#pragma unroll
        for (unsigned j = 0; j < 16; ++j) { const unsigned c = xb_ld(&bar[XB_XCNT(j)]); sum += c; cnt += (c > 0u) ? 1u : 0u; mine = (j == x) ? c : mine; }
        if (sum == G) break;
        __builtin_amdgcn_s_sleep(1);
        if ((++sp & 255u) == 0u) { if (xb_ld(&bar[XB_TMO])) break; if (sp > XB_SPIN_CAP) { atomicAdd(&bar[XB_TMO], 1u); break; } }
    }
    nloc = mine > 0u ? mine : 1u; nx = cnt > 0u ? cnt : 1u;
}
__device__ __forceinline__ void xcd_barrier(const XcdBarrier& b) {
    asm volatile("s_waitcnt vmcnt(0)" ::: "memory");
    __syncthreads();
    if (threadIdx.x == 0) {
        unsigned* bar = b.bar;
        __builtin_amdgcn_s_waitcnt(0);
        unsigned nloc = b.st[0], nx = b.st[1];
        if (nloc == 0u) { xcd_barrier_complete(bar, b.x, nloc, nx); b.st[0] = nloc; b.st[1] = nx; }
        const unsigned old = xb_add(&bar[XB_XSUB(b.x)], 1u);
        const unsigned gen = old / nloc;
        if (old + 1u == (gen + 1u) * nloc) {
            __builtin_amdgcn_fence(__ATOMIC_RELEASE, "agent");
            asm volatile("s_waitcnt vmcnt(0)" ::: "memory");
            const unsigned og = xb_add(&bar[XB_TOP], 1u);
            const unsigned tg = og / nx;
            if (og + 1u == (tg + 1u) * nx) xb_add(&bar[XB_TOPGEN], 1u);
            else XB_SPIN(xb_ld(&bar[XB_TOPGEN]) == tg, bar);
            __builtin_amdgcn_fence(__ATOMIC_ACQUIRE, "agent");
            xb_add(&bar[XB_XGEN(b.x)], 1u);
            asm volatile("s_waitcnt vmcnt(0)" ::: "memory");
        } else {
            XB_SPIN(xb_ld(&bar[XB_XGEN(b.x)]) == gen, bar);
            __builtin_amdgcn_fence(__ATOMIC_ACQUIRE, "agent");
            asm volatile("s_waitcnt vmcnt(0)" ::: "memory");
        }
    }
    __syncthreads();
}

struct Params {
    const float *x, *g_mix, *w_in, *b_forget, *g_v_ln, *b_v_ln, *w_spatial, *b_spatial, *w_ba, *w_bg, *w_out, *g_ffn, *w_router, *b_router,
                *w_up, *b_up, *w_down, *b_down, *g_final;
    float* out;
    bf16_t *h, *q, *k, *v, *zg, *gates, *attn, *sg, *merged, *h2, *act, *y;
    bf16_t *wb_in, *wb_ba, *wb_bg, *wb_out, *wb_up, *wb_down, *wr_hi, *wr_lo;
    unsigned char *h8, *wb_in8;
    float *ls, *x1, *top_gate, *row_gate, *lnpart; bf16_t* x1b;
    int *top_idx, *blk_cnt, *row_tok, *row_dst, *tile_e, *tile_row0, *tile_nrows, *ntiles, *unit_up, *unit_down;
    unsigned* bar;
};

typedef __bf16 bf16x2_t __attribute__((ext_vector_type(2)));
__device__ __forceinline__ unsigned cvt_pk_bf16_mfma(float lo, float hi) { const f32x2 v = {lo, hi}; return __builtin_bit_cast(unsigned, __builtin_convertvector(v, bf16x2_t)); }
__device__ __forceinline__ unsigned cvt_pk_bf16(float lo, float hi) { unsigned r; asm("v_cvt_pk_bf16_f32 %0, %1, %2" : "=v"(r) : "v"(lo), "v"(hi)); return r; }
__device__ __forceinline__ int tid_opaque() { int t = threadIdx.x; asm volatile("" : "+v"(t)); return t; }
__device__ __forceinline__ float bf_lo(unsigned u) { return __uint_as_float(u << 16); }
__device__ __forceinline__ float bf_hi(unsigned u) { return __uint_as_float(u & 0xffff0000u); }
__device__ __forceinline__ float wave_sum(float v) {
#pragma unroll
    for (int o = 32; o; o >>= 1) v += __shfl_xor(v, o);
    return v; }
__device__ __forceinline__ float wave_max(float v) {
#pragma unroll
    for (int o = 32; o; o >>= 1) v = fmaxf(v, __shfl_xor(v, o));
    return v; }
__device__ __forceinline__ float sigmoidf_(float x) { return __builtin_amdgcn_rcpf(1.0f + __builtin_amdgcn_exp2f(-1.44269504f * x)); }
__device__ __forceinline__ float log_sigmoid(float x) { return fminf(x, 0.f) - log1pf(__expf(-fabsf(x))); }
__device__ __forceinline__ float gelu_erf(float v) { return 0.5f * v * (1.0f + erff(v * 0.70710678118654752f)); }

template <class Epi>
__device__ __forceinline__ void gemm_tile_naive(const bf16_t* __restrict__ A, int lda, const int* __restrict__ rowmap, int row0, int nvalid,
                                                const float* __restrict__ Bm, int ldb, int K, Epi&& epi) {
    const int tid = tid_opaque(), wid = tid >> 6, lane = tid & 63, wr = wid >> 2, wc = wid & 3, fr = lane & 15, fq = lane >> 4;
    const bf16_t* arow[8];
#pragma unroll
    for (int m = 0; m < 8; ++m) {
        int r = wr * 128 + m * 16 + fr; if (r >= nvalid) r = 0;
        const int gr = rowmap ? rowmap[row0 + r] : row0 + r;
        arow[m] = A + (size_t)gr * lda + fq * 8;
    }
    f32x4 acc[8][4];
#pragma unroll
    for (int m = 0; m < 8; ++m)
#pragma unroll
        for (int n = 0; n < 4; ++n) acc[m][n] = (f32x4){0.f, 0.f, 0.f, 0.f};
    for (int k0 = 0; k0 < K; k0 += 32) {
        bf16x8 At[8], Bf[4];
#pragma unroll
        for (int m = 0; m < 8; ++m) At[m] = *(const bf16x8*)(arow[m] + k0);
#pragma unroll
        for (int n = 0; n < 4; ++n) {
            const float* bp = Bm + (size_t)(k0 + fq * 8) * ldb + wc * 64 + n * 16 + fr;
            float v[8];
#pragma unroll
            for (int i = 0; i < 8; ++i) v[i] = bp[(size_t)i * ldb];
            u32x4 w; w.x = cvt_pk_bf16_mfma(v[0], v[1]); w.y = cvt_pk_bf16_mfma(v[2], v[3]); w.z = cvt_pk_bf16_mfma(v[4], v[5]); w.w = cvt_pk_bf16_mfma(v[6], v[7]);
            Bf[n] = __builtin_bit_cast(bf16x8, w);
        }
#pragma unroll
        for (int m = 0; m < 8; ++m)
#pragma unroll
            for (int n = 0; n < 4; ++n) acc[m][n] = __builtin_amdgcn_mfma_f32_16x16x32_bf16(Bf[n], At[m], acc[m][n], 0, 0, 0);
    }
    epi(acc, wr, wc, fr, fq);
}

template <bool MASKM> __device__ __forceinline__ int tile_row(int wr, int m, int fr) { return MASKM ? m * 32 + wr * 16 + fr : wr * 128 + m * 16 + fr; }
__device__ __forceinline__ int lds_byte(int r, int c) { const int st = (r >> 4) * 2 + (c >> 5), ob = (r & 15) * 64 + (c & 31) * 2; return st * 1024 + (ob ^ (((ob >> 9) & 1) << 5)); }
#define SCHED() __builtin_amdgcn_sched_barrier(0)

template <int LDB, bool GATHER, bool MASKM, class Epi>
__device__ __forceinline__ void gemm_tile(char* lds, const bf16_t* __restrict__ A, int lda, const int* __restrict__ rowmap, int row0, int nvalid,
                                          const float* __restrict__ Bm, int K, Epi&& epi) {
    constexpr int TILE_B = 256 * 64 * 2, STAGE_B = 2 * TILE_B;
    const int tid = tid_opaque(), wid = tid >> 6, lane = tid & 63, wr = wid >> 2, wc = wid & 3, fr = lane & 15, fq = lane >> 4;
    const int a_col = (wid & 1) * 32 + (((lane & 3) ^ ((lane >> 5) << 1)) << 3);
    unsigned aoff[4];
#pragma unroll
    for (int i = 0; i < 4; ++i) {
        const int R = ((wid >> 1) + 4 * i) * 16 + (lane >> 2);
        int r = MASKM ? ((R >> 4) & 7) * 32 + (R >> 7) * 16 + (R & 15) : R;
        if (MASKM && r >= nvalid) r = 0;
        const int gr = GATHER ? rowmap[row0 + r] : row0 + r;
        aoff[i] = (unsigned)gr * (unsigned)lda + (unsigned)a_col;
    }
    const int kq = lane & 3, nl = lane >> 2, kh = wid & 1, ng = wid >> 1;
    const unsigned bofs = (unsigned)((kh * 32 + kq * 8) * LDB + ng * 64 + nl * 4);
    const int boff0 = ((4 * ng + (nl >> 2)) * 2 + kh) * 1024 + ((((nl & 3) * 4) * 64 + kq * 16) ^ (((nl & 3) >> 1) << 5));
    const int mvalid = MASKM ? max(0, min(8, (nvalid - wr * 16 + 31) >> 5)) : 8;
    f32x4 acc[8][4];
#pragma unroll
    for (int m = 0; m < 8; ++m)
#pragma unroll
        for (int n = 0; n < 4; ++n) acc[m][n] = (f32x4){0.f, 0.f, 0.f, 0.f};
    u32x4 sa[4]; f32x4 sb[8];
#define G_ISSUE(kt) do { const bf16_t* Ak_ = A + (kt) * 64; const float* Bk_ = Bm + (size_t)(kt) * 64 * LDB; unsigned bo_ = bofs; asm volatile("" : "+v"(bo_)); \
        _Pragma("unroll") for (int i = 0; i < 4; ++i) sa[i] = *(const u32x4*)(Ak_ + aoff[i]); \
        _Pragma("unroll") for (int i = 0; i < 8; ++i) sb[i] = *(const f32x4*)(Bk_ + (bo_ + (unsigned)(i * LDB))); SCHED(); } while (0)
#define G_WRITE(buf) do { char* sA_ = lds + (buf) * STAGE_B; char* sB_ = sA_ + TILE_B; \
        _Pragma("unroll") for (int i = 0; i < 4; ++i) *(u32x4*)(sA_ + wid * 1024 + i * 8192 + lane * 16) = sa[i]; \
        _Pragma("unroll") for (int j = 0; j < 4; ++j) { u32x4 w_; w_.x = cvt_pk_bf16(sb[0][j], sb[1][j]); w_.y = cvt_pk_bf16(sb[2][j], sb[3][j]); \
            w_.z = cvt_pk_bf16(sb[4][j], sb[5][j]); w_.w = cvt_pk_bf16(sb[6][j], sb[7][j]); *(u32x4*)(sB_ + boff0 + j * 64) = w_; } } while (0)
#define G_KSTEP(buf, ks) do { const char* sA_ = lds + (buf) * STAGE_B; const char* sB_ = sA_ + TILE_B; bf16x8 Bf[4]; \
        _Pragma("unroll") for (int n = 0; n < 4; ++n) Bf[n] = *(const bf16x8*)(sB_ + lds_byte(wc * 64 + n * 16 + fr, (ks) * 32 + fq * 8)); \
        _Pragma("unroll") for (int mh = 0; mh < 2; ++mh) { if (!MASKM || mh * 4 < mvalid) { bf16x8 At[4]; \
            _Pragma("unroll") for (int m = 0; m < 4; ++m) At[m] = *(const bf16x8*)(sA_ + lds_byte(wr * 128 + (mh * 4 + m) * 16 + fr, (ks) * 32 + fq * 8)); \
            _Pragma("unroll") for (int m = 0; m < 4; ++m) { \
                _Pragma("unroll") for (int n = 0; n < 4; ++n) acc[mh * 4 + m][n] = __builtin_amdgcn_mfma_f32_16x16x32_bf16(Bf[n], At[m], acc[mh * 4 + m][n], 0, 0, 0); } } \
            SCHED(); } } while (0)
    const int nt = K / 64;
    G_ISSUE(0); G_WRITE(0); G_ISSUE(1); __syncthreads();
    for (int t = 0; t < nt; ++t) {
        const int cur = t & 1;
        if (t + 1 < nt) G_WRITE(cur ^ 1);
        if (t + 2 < nt) G_ISSUE(t + 2);
        G_KSTEP(cur, 0); G_KSTEP(cur, 1);
        __syncthreads();
    }
#undef G_ISSUE
#undef G_WRITE
#undef G_KSTEP
    epi(acc, wr, wc, fr, fq);
}

__device__ __forceinline__ void conv_tiles(char* lds, const float* __restrict__ src, int ldsrc, bf16_t* __restrict__ dst, int K, int nkt, int t_begin, int t_end, bool shift8, int vb, int nvb, int nnt = 1 << 30, size_t mstride = 0) {
    const int tid = tid_opaque(), w = tid >> 6, lane = tid & 63;
    f32x4 v0[8], v1[8], n0[8], n1[8], m0[8], m1[8];
    int t = t_begin + vb;
    if (t >= t_end) return;
#define CV_LOAD(dstv, tt) do { const int kt_ = (tt) % nkt, nt_ = (tt) / nkt, e_ = nt_ / nnt, ntl_ = nt_ % nnt; \
        const float* s_ = src + (size_t)e_ * mstride + (size_t)(kt_ * 64 + w * 8) * ldsrc + ntl_ * 256 + ((shift8 && nt_ >= 12) ? 8 : 0) + lane * 4; \
        _Pragma("unroll") for (int i = 0; i < 8; ++i) dstv[i] = __builtin_nontemporal_load((const f32x4*)(s_ + (size_t)i * ldsrc)); } while (0)
#define CV_PUT(srcv, buf) do { _Pragma("unroll") for (int j = 0; j < 4; ++j) { u32x4 pk; pk.x = cvt_pk_bf16(srcv[0][j], srcv[1][j]); pk.y = cvt_pk_bf16(srcv[2][j], srcv[3][j]); \
        pk.z = cvt_pk_bf16(srcv[4][j], srcv[5][j]); pk.w = cvt_pk_bf16(srcv[6][j], srcv[7][j]); *(u32x4*)(lds + (buf) * 32768 + (lane * 4 + j) * 128 + ((w ^ (lane & 7)) << 4)) = pk; } } while (0)
#define CV_OUT(tt, buf) do { const int kt_ = (tt) % nkt, nt_ = (tt) / nkt; bf16_t* d_ = dst + (size_t)nt_ * 256 * K + kt_ * 64; \
        _Pragma("unroll") for (int r = 0; r < 4; ++r) { const int c_ = r * 512 + tid, n_ = c_ >> 3, kc_ = c_ & 7; \
            __builtin_nontemporal_store(*(const u32x4*)(lds + (buf) * 32768 + n_ * 128 + ((kc_ ^ ((n_ >> 2) & 7)) << 4)), (u32x4*)(d_ + (size_t)n_ * K + kc_ * 8)); } } while (0)
    CV_LOAD(v0, t); if (t + nvb < t_end) CV_LOAD(v1, t + nvb);
    if (t + 2 * nvb < t_end) CV_LOAD(n0, t + 2 * nvb);
    if (t + 3 * nvb < t_end) CV_LOAD(n1, t + 3 * nvb);
    for (; t < t_end; t += 2 * nvb) {
        const bool two = t + nvb < t_end;
        if (t + 4 * nvb < t_end) CV_LOAD(m0, t + 4 * nvb);
        if (t + 5 * nvb < t_end) CV_LOAD(m1, t + 5 * nvb);
        __syncthreads();
        CV_PUT(v0, 0); if (two) CV_PUT(v1, 1);
        __syncthreads();
        CV_OUT(t, 0); if (two) CV_OUT(t + nvb, 1);
#pragma unroll
        for (int i = 0; i < 8; ++i) { v0[i] = n0[i]; v1[i] = n1[i]; n0[i] = m0[i]; n1[i] = m1[i]; }
    }
#undef CV_LOAD
#undef CV_PUT
#undef CV_OUT
    __syncthreads();
}

__device__ __forceinline__ unsigned pack_fp8x4(float a, float b, float c, float d) {
    a = fminf(fmaxf(a, -448.f), 448.f); b = fminf(fmaxf(b, -448.f), 448.f); c = fminf(fmaxf(c, -448.f), 448.f); d = fminf(fmaxf(d, -448.f), 448.f);
    int r = 0; r = __builtin_amdgcn_cvt_pk_fp8_f32(a, b, r, false); r = __builtin_amdgcn_cvt_pk_fp8_f32(c, d, r, true); return (unsigned)r;
}
__device__ __forceinline__ void conv_tiles_f8(char* lds, const float* __restrict__ src, int ldsrc, unsigned char* __restrict__ dst, int K, int nkt, int t_begin, int t_end, int vb, int nvb, int nnt, size_t mstride, bool shift8 = false) {
    const int tid = tid_opaque(), w = tid >> 6, lane = tid & 63, n4 = lane & 31, kg = w * 2 + (lane >> 5);
    f32x4 v0[8], v1[8], n0[8], n1[8], m0[8], m1[8];
    int t = t_begin + vb;
    if (t >= t_end) return;
#define C8_LOAD(dstv, tt) do { const int kt_ = (tt) % nkt, nt_ = (tt) / nkt, e_ = nt_ / nnt, ntl_ = nt_ % nnt; \
        const float* s_ = src + (size_t)e_ * mstride + (size_t)(kt_ * 128 + kg * 8) * ldsrc + ntl_ * 128 + ((shift8 && nt_ >= 24) ? 8 : 0) + n4 * 4; \
        _Pragma("unroll") for (int i = 0; i < 8; ++i) dstv[i] = __builtin_nontemporal_load((const f32x4*)(s_ + (size_t)i * ldsrc)); } while (0)
#define C8_PUT(srcv, buf) do { _Pragma("unroll") for (int j = 0; j < 4; ++j) { u32x2 pk; pk.x = pack_fp8x4(srcv[0][j] * 64.f, srcv[1][j] * 64.f, srcv[2][j] * 64.f, srcv[3][j] * 64.f); \
        pk.y = pack_fp8x4(srcv[4][j] * 64.f, srcv[5][j] * 64.f, srcv[6][j] * 64.f, srcv[7][j] * 64.f); \
        *(u32x2*)(lds + (buf) * 16384 + (n4 * 4 + j) * 128 + ((((kg >> 1) ^ (n4 & 7))) << 4) + (kg & 1) * 8) = pk; } } while (0)
#define C8_OUT(tt, buf) do { const int kt_ = (tt) % nkt, nt_ = (tt) / nkt; unsigned char* d_ = dst + (size_t)nt_ * 128 * K + kt_ * 128; \
        _Pragma("unroll") for (int r = 0; r < 2; ++r) { const int c_ = r * 512 + tid, n_ = c_ >> 3, ch_ = c_ & 7; \
            __builtin_nontemporal_store(*(const u32x4*)(lds + (buf) * 16384 + n_ * 128 + ((ch_ ^ ((n_ >> 2) & 7)) << 4)), (u32x4*)(d_ + (size_t)n_ * K + ch_ * 16)); } } while (0)
    C8_LOAD(v0, t); if (t + nvb < t_end) C8_LOAD(v1, t + nvb);
    if (t + 2 * nvb < t_end) C8_LOAD(n0, t + 2 * nvb);
    if (t + 3 * nvb < t_end) C8_LOAD(n1, t + 3 * nvb);
    for (; t < t_end; t += 2 * nvb) {
        const bool two = t + nvb < t_end;
        if (t + 4 * nvb < t_end) C8_LOAD(m0, t + 4 * nvb);
        if (t + 5 * nvb < t_end) C8_LOAD(m1, t + 5 * nvb);
        __syncthreads();
        C8_PUT(v0, 0); if (two) C8_PUT(v1, 1);
        __syncthreads();
        C8_OUT(t, 0); if (two) C8_OUT(t + nvb, 1);
#pragma unroll
        for (int i = 0; i < 8; ++i) { v0[i] = n0[i]; v1[i] = n1[i]; n0[i] = m0[i]; n1[i] = m1[i]; }
    }
#undef C8_LOAD
#undef C8_PUT
#undef C8_OUT
    __syncthreads();
}

namespace g8 {
constexpr int BK = 64, HALF = 128, HTB = HALF * BK * 2;
__device__ __forceinline__ int lds_byte8(int r, int c) { const int st = (r >> 4) * 2 + (c >> 5), rr = r & 15, cc = c & 31, ob = rr * 64 + cc * 2; return st * 1024 + (ob ^ (((ob >> 9) & 1) << 5)); }
__device__ __forceinline__ void stage_rc(int b, int& R, int& C) { const int st = b / 1024, sb = b % 1024, swz = sb ^ (((sb >> 9) & 1) << 5); R = (st >> 1) * 16 + swz / 64; C = (st & 1) * 32 + (swz % 64) / 2; }
__device__ __forceinline__ int perm32(int rho) { const int n = rho >> 4, i = rho & 15; return 8 * (i >> 2) + 4 * n + (i & 3); }
struct Unit { const char* A; const char* B; int row0, nv, pm, pn, e; };
__device__ __forceinline__ int xcd_remap(int L, int nwg) { const int q = nwg / 8, r = nwg % 8, xcd = L % 8, off = L / 8; return (xcd < r ? xcd * (q + 1) : r * (q + 1) + (xcd - r) * q) + off; }

template <bool GATHER, bool F8  , class Epi, class Sched>
__device__ __forceinline__ void gemm_phase8(char* lds_g, const int K, const int* __restrict__ rowmap, const Sched& S, const Epi& E) {
    LAS unsigned char* lds = (LAS unsigned char*)lds_g;
    const int tid = tid_opaque(), wid = __builtin_amdgcn_readfirstlane(tid >> 6), lane = tid & 63, wr = wid >> 2, wc = wid & 3, fr = lane & 15, fq = lane >> 4;
    constexpr int ESZ = F8 ? 1 : 2;
    const int nt = K * ESZ / 128;
    unsigned voffB[2], vaC[2][2], vaN[2][2];
#pragma unroll
    for (int i = 0; i < 2; ++i) { int sR_, sC_; stage_rc(tid * 16 + i * 8192, sR_, sC_); const int Rb = (sR_ & ~31) + perm32(sR_ & 31); voffB[i] = (unsigned)(Rb * K * ESZ + sC_ * 2); }
    const size_t kstep = (size_t)(BK * 2), hstep = (size_t)HALF * K * ESZ;
    const unsigned ldsw = (unsigned)wid * 1024u;
    const int aoff = lds_byte8(wr * 64 + fr, fq * 8), boff = lds_byte8(wc * 32 + fr, fq * 8);
#define G8_SA(b, h) (((b) * 2 + (h)) * HTB)
#define G8_SB(b, h) ((4 + (b) * 2 + (h)) * HTB)
#define G8_GLDS(bufoff, gptr, v0, v1) do { __builtin_amdgcn_global_load_lds((const unsigned*)((gptr) + (v0)), (LAS unsigned*)(lds + (bufoff) + ldsw), 16, 0, 0); \
        __builtin_amdgcn_global_load_lds((const unsigned*)((gptr) + (v1)), (LAS unsigned*)(lds + (bufoff) + ldsw + 8192), 16, 0, 0); } while (0)
#define G8_STB(bufoff, gptr) G8_GLDS(bufoff, gptr, voffB[0], voffB[1])
#define G8_STA(bufoff, gptr, va, h) G8_GLDS(bufoff, gptr, va[h][0], va[h][1])
#define G8_STA2(bufoff, gptr, h) G8_GLDS(bufoff, gptr, ((GATHER && last) ? vaN[h][0] : vaC[h][0]), ((GATHER && last) ? vaN[h][1] : vaC[h][1]))
#define G8_VA(va, u) do { int tv_ = tid; asm volatile("" : "+v"(tv_)); _Pragma("unroll") for (int i_ = 0; i_ < 2; ++i_) { int sR_, sC_; stage_rc(tv_ * 16 + i_ * 8192, sR_, sC_); _Pragma("unroll") for (int h_ = 0; h_ < 2; ++h_) { \
        if (GATHER) { int r_ = h_ * HALF + sR_; r_ = r_ < (u).nv ? r_ : (u).nv - 1; va[h_][i_] = (unsigned)rowmap[(u).row0 + r_] * (unsigned)(K * ESZ) + (unsigned)sC_ * 2u; } \
        else va[h_][i_] = (unsigned)((h_ * HALF + sR_) * K * ESZ + sC_ * 2); } } } while (0)
#define G8_LD8(dst, addr) do { const i32x4 lo_ = *(const LAS i32x4*)(lds + (addr)), hi_ = *(const LAS i32x4*)(lds + (addr) + 1024); dst = __builtin_shufflevector(lo_, hi_, 0, 1, 2, 3, 4, 5, 6, 7); } while (0)
#define G8_LDA(dst, b, h) do { if (F8) { _Pragma("unroll") for (int m = 0; m < 4; ++m) G8_LD8(dst##8[m], G8_SA(b, h) + aoff + m * 2048); } \
        else { _Pragma("unroll") for (int m = 0; m < 4; ++m) _Pragma("unroll") for (int k = 0; k < 2; ++k) dst[m][k] = *(const LAS bf16x8*)(lds + G8_SA(b, h) + aoff + m * 2048 + k * 1024); } } while (0)
#define G8_LDB(dst, b, h) do { if (F8) { _Pragma("unroll") for (int n = 0; n < 2; ++n) G8_LD8(dst##8[n], G8_SB(b, h) + boff + n * 2048); } \
        else { _Pragma("unroll") for (int n = 0; n < 2; ++n) _Pragma("unroll") for (int k = 0; k < 2; ++k) dst[n][k] = *(const LAS bf16x8*)(lds + G8_SB(b, h) + boff + n * 2048 + k * 1024); } } while (0)
#define G8_MMA(ai, bj, At, Bt) do { __builtin_amdgcn_s_setprio(1); _Pragma("unroll") for (int m = 0; m < 4; ++m) _Pragma("unroll") for (int n = 0; n < 2; ++n) { \
        if (F8) asm volatile("v_mfma_scale_f32_16x16x128_f8f6f4 %0, %1, %2, %0, %3, %4 op_sel_hi:[0,0,0]" : "+v"(acc[ai][bj][m][n]) : "v"(Bt##8[n]), "v"(At##8[m]), "v"(f8_sw), "v"(f8_sa)); \
        else { _Pragma("unroll") for (int k = 0; k < 2; ++k) acc[ai][bj][m][n] = __builtin_amdgcn_mfma_f32_16x16x32_bf16(Bt[n][k], At[m][k], acc[ai][bj][m][n], 0, 0, 0); } } \
        __builtin_amdgcn_s_setprio(0); } while (0)
#define G8_WAIT_V(n) asm volatile("s_waitcnt vmcnt(" #n ")" ::: "memory")
#define G8_WAIT_L(n) asm volatile("s_waitcnt lgkmcnt(" #n ")" ::: "memory")
#define G8_BAR __builtin_amdgcn_s_barrier()
#define G8_SCHED __builtin_amdgcn_sched_barrier(0)
    Unit cur, nxt; int ui = 0;
    if (!S.next(0, cur)) return;
    f32x4 acc[2][2][4][2];
#pragma unroll
    for (int a = 0; a < 2; ++a)
#pragma unroll
        for (int b = 0; b < 2; ++b)
#pragma unroll
            for (int m = 0; m < 4; ++m)
#pragma unroll
                for (int n = 0; n < 2; ++n) acc[a][b][m][n] = (f32x4){0.f, 0.f, 0.f, 0.f};
    bf16x8 At[4][2], B0[2][2], B1[2][2];
    const int f8_sw = 0x79797979, f8_sa = 0x7f7f7f7f;
    i32x8 At8[4], B08[2], B18[2];
    const char* cA = cur.A; const char* cB = cur.B;
    G8_VA(vaC, cur);
#pragma unroll
    for (int h = 0; h < 2; ++h) { vaN[h][0] = vaC[h][0]; vaN[h][1] = vaC[h][1]; }
    G8_STB(G8_SB(0, 0), cB); G8_STA(G8_SA(0, 0), cA, vaC, 0); G8_STB(G8_SB(0, 1), cB + hstep); G8_STA(G8_SA(0, 1), cA, vaC, 1);
    if (wr == 1) G8_BAR;
    G8_WAIT_V(4); G8_BAR;
    G8_STB(G8_SB(1, 0), cB + kstep); G8_STA(G8_SA(1, 0), cA + kstep, vaC, 0); G8_STB(G8_SB(1, 1), cB + hstep + kstep);
    G8_WAIT_V(6); G8_BAR;
    for (;;) {
        const bool has_next = S.next(ui + 1, nxt);
        const char* nA = has_next ? nxt.A : cA; const char* nB = has_next ? nxt.B : cB;
        if (GATHER && has_next) G8_VA(vaN, nxt);
        for (int t = 0; t < nt; t += 2) {
            const bool last = (t == nt - 2);
            const char* a1 = cA + (size_t)(t + 1) * kstep;
            const char* a2 = last ? nA : cA + (size_t)(t + 2) * kstep; const char* b2 = last ? nB : cB + (size_t)(t + 2) * kstep;
            const char* a3 = a2 + kstep; const char* b3 = b2 + kstep;
            G8_LDB(B0, 0, 0); G8_SCHED; G8_LDA(At, 0, 0); G8_STA(G8_SA(1, 1), a1, vaC, 1);
            G8_WAIT_L(8); G8_BAR; G8_WAIT_L(0); G8_MMA(0, 0, At, B0); G8_BAR; G8_SCHED;
            G8_LDB(B1, 0, 1); G8_STB(G8_SB(0, 0), b2);
            G8_BAR; G8_WAIT_L(0); G8_MMA(0, 1, At, B1); G8_BAR; if (F8) G8_SCHED;
            G8_LDA(At, 0, 1); G8_STA2(G8_SA(0, 0), a2, 0);
            G8_BAR; G8_WAIT_L(0); G8_MMA(1, 0, At, B0); G8_BAR; G8_SCHED;
            G8_STB(G8_SB(0, 1), b2 + hstep);
            G8_WAIT_V(6); G8_BAR; G8_MMA(1, 1, At, B1); G8_BAR; if (F8) G8_SCHED;
            G8_LDB(B0, 1, 0); G8_SCHED; G8_LDA(At, 1, 0); G8_STA2(G8_SA(0, 1), a2, 1);
            G8_WAIT_L(8); G8_BAR; G8_WAIT_L(0); G8_MMA(0, 0, At, B0); G8_BAR; G8_SCHED;
            G8_LDB(B1, 1, 1); G8_STB(G8_SB(1, 0), b3);
            G8_BAR; G8_WAIT_L(0); G8_MMA(0, 1, At, B1); G8_BAR; if (F8) G8_SCHED;
            G8_LDA(At, 1, 1); G8_STA2(G8_SA(1, 0), a3, 0);
            G8_BAR; G8_WAIT_L(0); G8_MMA(1, 0, At, B0); G8_BAR; G8_SCHED;
            G8_STB(G8_SB(1, 1), b3 + hstep);
            G8_WAIT_V(6); G8_BAR; G8_MMA(1, 1, At, B1); G8_BAR; if (F8) G8_SCHED;
        }
        bool keep_acc; { int te_ = tid; asm volatile("" : "+v"(te_)); const int le_ = te_ & 63; keep_acc = E(acc, cur, wr, wc, le_ & 15, le_ >> 4); }
        if (!has_next) break;
        if (!keep_acc) {
#pragma unroll
        for (int a = 0; a < 2; ++a)
#pragma unroll
            for (int b = 0; b < 2; ++b)
#pragma unroll
                for (int m = 0; m < 4; ++m)
#pragma unroll
                    for (int n = 0; n < 2; ++n) acc[a][b][m][n] = (f32x4){0.f, 0.f, 0.f, 0.f};
        }
        cur = nxt; cA = nA; cB = nB; ++ui;
        if (GATHER) {
#pragma unroll
            for (int h = 0; h < 2; ++h) { vaC[h][0] = vaN[h][0]; vaC[h][1] = vaN[h][1]; }
        }
    }
    G8_WAIT_V(0);
    if (wr == 0) G8_BAR;
    G8_BAR;
#undef G8_SA
#undef G8_SB
#undef G8_GLDS
#undef G8_STB
#undef G8_STA
#undef G8_STA2
#undef G8_VA
#undef G8_LDA
#undef G8_LDB
#undef G8_MMA
#undef G8_WAIT_V
#undef G8_WAIT_L
#undef G8_BAR
#undef G8_SCHED
}
__device__ __forceinline__ f32x2 gelu_pk(f32x2 v) {
    const f32x2 av = __builtin_elementwise_abs(v), d = av * 0.2316418882f + 1.0f;
    f32x2 t; t.x = __builtin_amdgcn_rcpf(d.x); t.y = __builtin_amdgcn_rcpf(d.y);
    f32x2 q = t * 0.5307027145f + (-0.7265760135f); q = q * t + 0.7107068705f; q = q * t + (-0.142248368f); q = q * t + 0.127414796f; q = q * t;
    const f32x2 s = (v * v) * (-0.72134752044f);
    f32x2 e; e.x = __builtin_amdgcn_exp2f(s.x); e.y = __builtin_amdgcn_exp2f(s.y);
    const f32x2 m = v * (q * e), r = v - m;
    f32x2 o; o.x = v.x < 0.f ? m.x : r.x; o.y = v.y < 0.f ? m.y : r.y; return o;
}
struct DenseOrder {
    const char* A; const char* B; int K, nM, nN, G, c, esz, pn0, gs = 8;
    __device__ __forceinline__ bool next(int i, Unit& u) const {
        const int nwg = nM * nN; const long L = (long)i * G + c; if (L >= nwg) return false;
        const int wgid = xcd_remap((int)L, nwg);
        const int nig = gs * nN, gid = wgid / nig, fm = gid * gs, gsz = (nM - fm) < gs ? (nM - fm) : gs;
        u.pm = fm + ((wgid % nig) % gsz); const int pnl = (wgid % nig) / gsz; u.pn = pn0 + pnl; u.row0 = u.pm * 256; u.nv = 256; u.e = 0;
        u.A = A + (size_t)u.pm * 256 * K * esz; u.B = B + (size_t)pnl * 256 * K * esz; return true;
    }
};
}

__device__ __forceinline__ void phase_prologue(const Params& p, char* lds, int vb, int nvb) {
    for (int i = vb * NTHREADS + tid_opaque(); i < NE * D; i += nvb * NTHREADS) {
        const int e = i >> 11, d = i & (D - 1); const float w = p.w_router[(size_t)d * NE + e];
        const unsigned hi = cvt_pk_bf16(w, 0.f) & 0xffffu; const float rem = w - __uint_as_float(hi << 16);
        p.wr_hi[i] = (bf16_t)hi; p.wr_lo[i] = (bf16_t)(cvt_pk_bf16(rem, 0.f) & 0xffffu);
    }
    float* wf = (float*)lds;
    for (int i = tid_opaque(); i < D * 2; i += NTHREADS) { const int d = i >> 1, hf = i & 1; const f32x4 wv = *(const f32x4*)(p.w_in + (size_t)d * PW + 3072 + hf * 4);
#pragma unroll
        for (int j = 0; j < 4; ++j) wf[(hf * 4 + j) * D + d] = wv[j]; }
    __syncthreads();
    const int tid = tid_opaque(), wid = tid >> 6, lane = tid & 63;
    f32x4 xn[8];
    { const float* xr0 = p.x + (size_t)min(vb * 8 + wid, T - 1) * D;
#pragma unroll
      for (int i = 0; i < 8; ++i) xn[i] = __builtin_nontemporal_load((const f32x4*)(xr0 + i * 256 + lane * 4)); }
    for (int tok = vb * 8 + wid; tok < T; tok += nvb * 8) {
        f32x4 xv[8]; float ss = 0.f;
#pragma unroll
        for (int i = 0; i < 8; ++i) xv[i] = xn[i];
        { const float* xr1 = p.x + (size_t)min(tok + nvb * 8, T - 1) * D;
#pragma unroll
          for (int i = 0; i < 8; ++i) xn[i] = __builtin_nontemporal_load((const f32x4*)(xr1 + i * 256 + lane * 4)); }
#pragma unroll
        for (int i = 0; i < 8; ++i) ss += xv[i][0] * xv[i][0] + xv[i][1] * xv[i][1] + xv[i][2] * xv[i][2] + xv[i][3] * xv[i][3];
        ss = wave_sum(ss);
        const float rstd = rsqrtf(ss * (1.0f / D) + 1e-5f);
        float fa[8];
#pragma unroll
        for (int j = 0; j < 8; ++j) fa[j] = 0.f;
#pragma unroll
        for (int i = 0; i < 8; ++i) {
            const f32x4 g = *(const f32x4*)(p.g_mix + i * 256 + lane * 4);
            const f32x4 hv = xv[i] * rstd * g;
            u32x2 w; w.x = cvt_pk_bf16(hv[0], hv[1]); w.y = cvt_pk_bf16(hv[2], hv[3]);
            *(u32x2*)(p.h + (size_t)tok * D + i * 256 + lane * 4) = w;
            *(unsigned*)(p.h8 + (size_t)tok * D + i * 256 + lane * 4) = pack_fp8x4(hv[0], hv[1], hv[2], hv[3]);
#pragma unroll
            for (int hh = 0; hh < 8; ++hh) { const f32x4 w4 = *(const f32x4*)(wf + hh * D + i * 256 + lane * 4); fa[hh] += hv[0] * w4[0] + hv[1] * w4[1] + hv[2] * w4[2] + hv[3] * w4[3]; }
        }
        float mine = 0.f;
#pragma unroll
        for (int j = 0; j < 8; ++j) { const float s = wave_sum(fa[j]); if (lane == j) mine = s; }
        if (lane < 8) p.ls[(size_t)tok * 8 + lane] = log_sigmoid(mine + p.b_forget[lane]);
    }
    __syncthreads();
}

__device__ __forceinline__ void phase_convert_dense(const Params& p, char* lds, int vb, int nvb) {
    conv_tiles(lds, p.w_in, PW, p.wb_in, D, 32, 0, 32 * PN_SPLIT, true, vb, nvb);
    conv_tiles_f8(lds, p.w_in, PW, p.wb_in8, D, 16, 16 * 2 * PN_SPLIT, 16 * 72, vb, nvb, 1 << 30, 0, true);
}
constexpr int UPSPLIT = 14592;
#ifndef DQ
#define DQ 1024
#endif
__device__ __forceinline__ void phase_convert_moe(const Params& p, char* lds, int part, int vb, int nvb) {
    unsigned char* up8 = (unsigned char*)p.wb_up; unsigned char* dn8 = (unsigned char*)p.wb_down;
    if (part == 0) {
        conv_tiles_f8(lds, p.w_up, 2 * DFF, up8, D, 16, 0, UPSPLIT, vb, nvb, 32, (size_t)D * 2 * DFF);
        conv_tiles(lds, p.w_ba, D, p.wb_ba, AW, 16, 0, 16 * 8, false, vb, nvb);
        conv_tiles(lds, p.w_bg, D, p.wb_bg, GW, 16, 0, 16 * 8, false, vb, nvb);
    } else {
        conv_tiles(lds, p.w_out, D, p.wb_out, D, 32, 0, 32 * 8, false, vb, nvb);
        conv_tiles_f8(lds, p.w_up, 2 * DFF, up8, D, 16, UPSPLIT, 16 * 32 * NE, vb, nvb, 32, (size_t)D * 2 * DFF);
        conv_tiles_f8(lds, p.w_down, D, dn8, DFF, 16, 0, 16 * 16 * NE - DQ, vb, nvb, 16, (size_t)DFF * D);
    }
}

struct EpiInproj {
    bf16_t *q, *k, *v, *zg, *gates; float* lnpart;
    __device__ __forceinline__ bool operator()(f32x4 (&acc)[2][2][4][2], const g8::Unit& u, int wr, int wc, int fr, int fq) const {
        const int pn = u.pn;
        bf16_t* base; int ld, colt, act;
        if (pn < 4) { base = q; ld = AW; colt = pn * 256; act = 0; }
        else if (pn < 8) { base = k; ld = AW; colt = (pn - 4) * 256; act = 0; }
        else if (pn < 12) { base = v; ld = AW; colt = (pn - 8) * 256; act = 0; }
        else if (pn < 20) { base = zg; ld = 2048; colt = (pn - 12) * 256; act = 1; }
        else { base = gates; ld = 4096; colt = (pn - 20) * 256; act = 2; }
        const bool lnp = pn >= 16 && pn < 20;
#pragma unroll
        for (int ai = 0; ai < 2; ++ai)
#pragma unroll
            for (int m = 0; m < 4; ++m) {
                const size_t row = (size_t)u.pm * 256 + ai * 128 + wr * 64 + m * 16 + fr;
                bf16_t* rowp = base + row * ld + colt + wc * 32 + fq * 8;
                float ps = 0.f, pq = 0.f;
#pragma unroll
                for (int bj = 0; bj < 2; ++bj) {
                    f32x4 v0 = acc[ai][bj][m][0], v1 = acc[ai][bj][m][1];
                    if (act == 1) {
                        const f32x2 a = g8::gelu_pk((f32x2){v0[0], v0[1]}), b = g8::gelu_pk((f32x2){v0[2], v0[3]}), c = g8::gelu_pk((f32x2){v1[0], v1[1]}), d = g8::gelu_pk((f32x2){v1[2], v1[3]});
                        v0 = (f32x4){a.x, a.y, b.x, b.y}; v1 = (f32x4){c.x, c.y, d.x, d.y};
                    } else if (act == 2) {
#pragma unroll
                        for (int j = 0; j < 4; ++j) { v0[j] = sigmoidf_(v0[j]); v1[j] = sigmoidf_(v1[j]); }
                    }
                    if (lnp) { ps += (v0[0] + v0[1]) + (v0[2] + v0[3]) + (v1[0] + v1[1]) + (v1[2] + v1[3]); pq += (v0[0] * v0[0] + v0[1] * v0[1]) + (v0[2] * v0[2] + v0[3] * v0[3]) + (v1[0] * v1[0] + v1[1] * v1[1]) + (v1[2] * v1[2] + v1[3] * v1[3]); }
                    u32x4 w; w.x = cvt_pk_bf16(v0[0], v0[1]); w.y = cvt_pk_bf16(v0[2], v0[3]); w.z = cvt_pk_bf16(v1[0], v1[1]); w.w = cvt_pk_bf16(v1[2], v1[3]);
                    *(u32x4*)(rowp + bj * 128) = w;
                }
                if (lnp) {
                    ps += __shfl_xor(ps, 16); ps += __shfl_xor(ps, 32); pq += __shfl_xor(pq, 16); pq += __shfl_xor(pq, 32);
                    if (fq == 0) *(f32x2*)(lnpart + (row * 16 + (pn - 16) * 4 + wc) * 2) = (f32x2){ps, pq};
                }
            }
        return false;
    }
};
__device__ __forceinline__ void phase_inproj8(const Params& p, char* lds, int vb, int nvb) {
    EpiInproj E; E.q = p.q; E.k = p.k; E.v = p.v; E.zg = p.zg; E.gates = p.gates; E.lnpart = p.lnpart;
    {
        g8::DenseOrder S; S.A = (const char*)p.h; S.B = (const char*)p.wb_in; S.K = D; S.nM = 32; S.nN = PN_SPLIT; S.G = nvb; S.c = vb; S.esz = 2; S.pn0 = 0; S.gs = 4;
        g8::gemm_phase8<false, false>(lds, D, nullptr, S, E);
    }
    {
        g8::DenseOrder S; S.A = (const char*)p.h8; S.B = (const char*)(p.wb_in8 + (size_t)PN_SPLIT * 256 * D); S.K = D; S.nM = 32; S.nN = 36 - PN_SPLIT; S.G = nvb; S.c = vb; S.esz = 1; S.pn0 = PN_SPLIT; S.gs = 4;
        g8::gemm_phase8<false, true>(lds, D, nullptr, S, E);
    }
}
__device__ __forceinline__ void phase_inproj_conv(const Params& p, char* lds, int vb, int nvb) {
    const int half = nvb >> 1; const bool first = vb >= half;
    if (first) phase_convert_moe(p, lds, 0, vb - half, nvb - half);
    phase_inproj8(p, lds, vb, nvb);
    if (!first) phase_convert_moe(p, lds, 1, vb, half);
}

__device__ __forceinline__ void phase_inproj(const Params& p, char* lds, int vb, int nvb) {
    for (int u = vb; u < 32 * 36; u += nvb) {
        const int pm = u / 36, pn = u % 36;
        const int bcol = pn < 12 ? pn * 256 : pn * 256 + 8;
        gemm_tile<PW, false, false>(lds, p.h, D, nullptr, pm * 256, 256, p.w_in + bcol, D,
            [&](const f32x4 (&acc)[8][4], int wr, int wc, int fr, int fq) {
#pragma unroll
                for (int m = 0; m < 8; ++m) {
                    const size_t row = (size_t)pm * 256 + wr * 128 + m * 16 + fr;
#pragma unroll
                    for (int n = 0; n < 4; ++n) {
                        const int c = wc * 64 + n * 16 + fq * 4;
                        f32x4 v = acc[m][n];
                        bf16_t* dst;
                        if (pn < 4) dst = p.q + row * AW + pn * 256 + c;
                        else if (pn < 8) dst = p.k + row * AW + (pn - 4) * 256 + c;
                        else if (pn < 12) dst = p.v + row * AW + (pn - 8) * 256 + c;
                        else if (pn < 20) { dst = p.zg + row * 2048 + (pn - 12) * 256 + c;
#pragma unroll
                            for (int j = 0; j < 4; ++j) v[j] = gelu_erf(v[j]); }
                        else { dst = p.gates + row * 4096 + (pn - 20) * 256 + c;
#pragma unroll
                            for (int j = 0; j < 4; ++j) v[j] = sigmoidf_(v[j]); }
                        u32x2 w; w.x = cvt_pk_bf16(v[0], v[1]); w.y = cvt_pk_bf16(v[2], v[3]);
                        *(u32x2*)dst = w;
                    }
                }
            });
    }
}

struct BranchOrder {
    const char *A0, *A1, *B0, *B1; int G, c;
    __device__ __forceinline__ bool next(int i, g8::Unit& u) const {
        const int nwg = 32 * 8; const long L = (long)(i >> 1) * G + c; if (L >= nwg) return false;
        const int wgid = g8::xcd_remap((int)L, nwg);
        const int nig = 8 * 8, gid = wgid / nig, fm = gid * 8;
        u.pm = fm + ((wgid % nig) % 8); u.pn = (wgid % nig) / 8; u.row0 = u.pm * 256; u.nv = 256; u.e = i & 1;
        u.A = ((i & 1) ? A1 : A0) + (size_t)u.pm * 256 * AW * 2; u.B = ((i & 1) ? B1 : B0) + (size_t)u.pn * 256 * AW * 2; return true;
    }
};
struct EpiBranch {
    const bf16_t* gates; bf16_t* merged;
    __device__ __forceinline__ bool operator()(f32x4 (&acc)[2][2][4][2], const g8::Unit& u, int wr, int wc, int fr, int fq) const {
#pragma unroll
        for (int aim = 0; aim < 4; ++aim) {
            const int ai = aim >> 1, m0 = (aim & 1) * 2;
            u32x4 ga[4][2], gb[4][2];
#pragma unroll
            for (int m = m0; m < m0 + 2; ++m) {
                const size_t row = (size_t)u.pm * 256 + ai * 128 + wr * 64 + m * 16 + fr;
#pragma unroll
                for (int bj = 0; bj < 2; ++bj) {
                    const int c = u.pn * 256 + bj * 128 + wc * 32 + fq * 8;
                    ga[m][bj] = *(const u32x4*)(gates + row * 4096 + c);
                    if (u.e == 0) gb[m][bj] = *(const u32x4*)(gates + row * 4096 + 2048 + c);
                }
            }
#pragma unroll
            for (int m = m0; m < m0 + 2; ++m) {
                const size_t row = (size_t)u.pm * 256 + ai * 128 + wr * 64 + m * 16 + fr;
#pragma unroll
                for (int bj = 0; bj < 2; ++bj) {
                    const int c = u.pn * 256 + bj * 128 + wc * 32 + fq * 8;
                    const u32x4 a_ = ga[m][bj];
                    const float gav[8] = {fmaxf(bf_lo(a_.x), 1e-6f), fmaxf(bf_hi(a_.x), 1e-6f), fmaxf(bf_lo(a_.y), 1e-6f), fmaxf(bf_hi(a_.y), 1e-6f),
                                          fmaxf(bf_lo(a_.z), 1e-6f), fmaxf(bf_hi(a_.z), 1e-6f), fmaxf(bf_lo(a_.w), 1e-6f), fmaxf(bf_hi(a_.w), 1e-6f)};
                    if (u.e == 0) {
                        const u32x4 b_ = gb[m][bj];
                        const float gbv[8] = {bf_lo(b_.x), bf_hi(b_.x), bf_lo(b_.y), bf_hi(b_.y), bf_lo(b_.z), bf_hi(b_.z), bf_lo(b_.w), bf_hi(b_.w)};
#pragma unroll
                        for (int j = 0; j < 4; ++j) { acc[ai][bj][m][0][j] *= gbv[j] * __builtin_amdgcn_rcpf(gav[j]); acc[ai][bj][m][1][j] *= gbv[4 + j] * __builtin_amdgcn_rcpf(gav[4 + j]); }
                    } else {
                        f32x4 v0 = acc[ai][bj][m][0], v1 = acc[ai][bj][m][1];
#pragma unroll
                        for (int j = 0; j < 4; ++j) { v0[j] *= gav[j]; v1[j] *= gav[4 + j]; }
                        u32x4 w; w.x = cvt_pk_bf16(v0[0], v0[1]); w.y = cvt_pk_bf16(v0[2], v0[3]); w.z = cvt_pk_bf16(v1[0], v1[1]); w.w = cvt_pk_bf16(v1[2], v1[3]);
                        *(u32x4*)(merged + row * D + c) = w;
                    }
                }
            }
        }
        return u.e == 0;
    }
};
__device__ __forceinline__ void phase_branch8(const Params& p, char* lds, int vb, int nvb) {
    BranchOrder S; S.A0 = (const char*)p.sg; S.A1 = (const char*)p.attn; S.B0 = (const char*)p.wb_bg; S.B1 = (const char*)p.wb_ba; S.G = nvb; S.c = vb;
    EpiBranch E; E.gates = p.gates; E.merged = p.merged;
    g8::gemm_phase8<false, false>(lds, AW, nullptr, S, E);
}
struct EpiOut {
    const float* x; bf16_t* x1;
    __device__ __forceinline__ bool operator()(f32x4 (&acc)[2][2][4][2], const g8::Unit& u, int wr, int wc, int fr, int fq) const {
        f32x4 xa[2][2][2], xb[2][2][2];
#define EO_LOAD(X, aim) do { const int ai_ = (aim) >> 1, m0_ = ((aim) & 1) * 2; _Pragma("unroll") for (int mm = 0; mm < 2; ++mm) _Pragma("unroll") for (int bj = 0; bj < 2; ++bj) { \
            const size_t o = ((size_t)u.pm * 256 + ai_ * 128 + wr * 64 + (m0_ + mm) * 16 + fr) * D + u.pn * 256 + bj * 128 + wc * 32 + fq * 8; \
            X[mm][bj][0] = *(const f32x4*)(x + o); X[mm][bj][1] = *(const f32x4*)(x + o + 4); } } while (0)
#define EO_STORE(X, aim) do { const int ai_ = (aim) >> 1, m0_ = ((aim) & 1) * 2; _Pragma("unroll") for (int mm = 0; mm < 2; ++mm) _Pragma("unroll") for (int bj = 0; bj < 2; ++bj) { \
            const size_t o = ((size_t)u.pm * 256 + ai_ * 128 + wr * 64 + (m0_ + mm) * 16 + fr) * D + u.pn * 256 + bj * 128 + wc * 32 + fq * 8; \
            const f32x4 r0 = X[mm][bj][0] + acc[ai_][bj][m0_ + mm][0], r1 = X[mm][bj][1] + acc[ai_][bj][m0_ + mm][1]; \
            u32x4 w; w.x = cvt_pk_bf16(r0[0], r0[1]); w.y = cvt_pk_bf16(r0[2], r0[3]); w.z = cvt_pk_bf16(r1[0], r1[1]); w.w = cvt_pk_bf16(r1[2], r1[3]); \
            *(u32x4*)(x1 + o) = w; } } while (0)
        EO_LOAD(xa, 0); EO_LOAD(xb, 1); EO_STORE(xa, 0); EO_LOAD(xa, 2); EO_STORE(xb, 1); EO_LOAD(xb, 3); EO_STORE(xa, 2); EO_STORE(xb, 3);
#undef EO_LOAD
#undef EO_STORE
        return false;
    }
};
__device__ __forceinline__ void phase_outproj8(const Params& p, char* lds, int vb, int nvb) {
    g8::DenseOrder S; S.A = (const char*)p.merged; S.B = (const char*)p.wb_out; S.K = D; S.nM = 32; S.nN = 8; S.G = nvb; S.c = vb; S.esz = 2; S.pn0 = 0; S.gs = 4;
    EpiOut E; E.x = p.x; E.x1 = p.x1b;
    g8::gemm_phase8<false, false>(lds, D, nullptr, S, E);
}
struct MoeOrder {
    const int *unit_tab, *tile_row0, *tile_nrows; const char *A, *B; int nunits, rows_per_e, gather, G, c;
    __device__ __forceinline__ bool next(int i, g8::Unit& u) const {
        const int L = i * G + c; if (L >= nunits) return false;
        const int w = g8::xcd_remap(L, nunits);
        const int2 dd = *(const int2*)(unit_tab + 2 * w); const int d = dd.x;
        u.e = (unsigned)d >> 24; u.pn = (d >> 16) & 0xff; u.pm = d & 0xffff; u.row0 = dd.y & 0xffff; u.nv = (unsigned)dd.y >> 16;
        u.A = gather ? A : A + (size_t)u.row0 * D;
        u.B = B + ((size_t)u.e * rows_per_e + (size_t)u.pn * 256) * D; return true;
    }
};
struct EpiUp {
    const float* b_up; bf16_t* act;
    __device__ __forceinline__ bool operator()(f32x4 (&acc)[2][2][4][2], const g8::Unit& u, int wr, int wc, int fr, int fq) const {
        f32x4 bb[2][2];
#pragma unroll
        for (int bj = 0; bj < 2; ++bj) { const float* bp = b_up + (size_t)u.e * (2 * DFF) + u.pn * 256 + bj * 128 + wc * 32 + fq * 8; bb[bj][0] = *(const f32x4*)bp; bb[bj][1] = *(const f32x4*)(bp + 4); }
#pragma unroll
        for (int ai = 0; ai < 2; ++ai) {
            if (ai * 128 + wr * 64 < u.nv) {
#pragma unroll
                for (int bj = 0; bj < 2; ++bj) {
                    unsigned P[4];
#pragma unroll
                    for (int m = 0; m < 4; ++m) {
                        const f32x4 v0 = acc[ai][bj][m][0] + bb[bj][0], v1 = acc[ai][bj][m][1] + bb[bj][1];
                        float a[4];
#pragma unroll
                        for (int j = 0; j < 2; ++j) {
                            const float g0 = fminf(v0[2 * j], 7.f), l0 = fminf(fmaxf(v0[2 * j + 1], -7.f), 7.f);
                            const float g1 = fminf(v1[2 * j], 7.f), l1 = fminf(fmaxf(v1[2 * j + 1], -7.f), 7.f);
                            const float t0 = g0 * __builtin_amdgcn_rcpf(1.0f + __builtin_amdgcn_exp2f(-2.45546696f * g0)), t1 = g1 * __builtin_amdgcn_rcpf(1.0f + __builtin_amdgcn_exp2f(-2.45546696f * g1));
                            a[j] = fmaf(t0, l0, t0); a[2 + j] = fmaf(t1, l1, t1);
                        }
                        int pk = 0; pk = __builtin_amdgcn_cvt_pk_fp8_f32(a[0], a[1], pk, false); pk = __builtin_amdgcn_cvt_pk_fp8_f32(a[2], a[3], pk, true);
                        P[m] = (unsigned)pk;
                    }
                    const auto s0 = __builtin_amdgcn_permlane32_swap(P[0], P[2], false, false), s1 = __builtin_amdgcn_permlane32_swap(P[1], P[3], false, false);
                    const auto t0 = __builtin_amdgcn_permlane16_swap(s0[0], s1[0], false, false), t1 = __builtin_amdgcn_permlane16_swap(s0[1], s1[1], false, false);
                    const int r = ai * 128 + wr * 64 + fq * 16 + fr;
                    if (r < u.nv) { u32x4 w; w.x = t0[0]; w.y = t0[1]; w.z = t1[0]; w.w = t1[1];
                        *(u32x4*)((unsigned char*)act + (size_t)(u.row0 + r) * DFF + u.pn * 128 + bj * 64 + wc * 16) = w; }
                }
            }
        }
        return false;
    }
};
__device__ __forceinline__ void phase_moe_up8(const Params& p, char* lds, int vb, int nvb) {
    MoeOrder S; S.unit_tab = p.unit_up; S.tile_row0 = p.tile_row0; S.tile_nrows = p.tile_nrows; S.A = (const char*)p.h2; S.B = (const char*)p.wb_up;
    S.nunits = __builtin_amdgcn_readfirstlane(p.ntiles[0]) * 16; S.rows_per_e = 2 * DFF; S.gather = 1; S.G = nvb; S.c = vb;
    EpiUp E; E.b_up = p.b_up; E.act = p.act;
    g8::gemm_phase8<true, true>(lds, D, p.row_tok, S, E);
    volatile int* slot = (volatile int*)(lds + 136 * 1024);
    for (;;) {
        __syncthreads();
        if (tid_opaque() == 0) *slot = (int)__hip_atomic_fetch_add(p.bar + XCD_BAR_WORDS, 4u, __ATOMIC_RELAXED, __HIP_MEMORY_SCOPE_AGENT);
        __syncthreads();
        const int t = __builtin_amdgcn_readfirstlane(*slot);
        if (t >= DQ) break;
        const int t0 = 16 * 16 * NE - DQ + t;
        conv_tiles_f8(lds, p.w_down, D, (unsigned char*)p.wb_down, DFF, 16, t0, t0 + 4, 0, 1, 16, (size_t)DFF * D);
    }
}
struct EpiDown {
    const float *b_down, *row_gate; const int* row_dst; bf16_t* y;
    __device__ __forceinline__ bool operator()(f32x4 (&acc)[2][2][4][2], const g8::Unit& u, int wr, int wc, int fr, int fq) const {
        f32x4 bb[2][2]; float gt[2][4]; int ds[2][4];
#pragma unroll
        for (int bj = 0; bj < 2; ++bj) { const float* bp = b_down + (size_t)u.e * D + u.pn * 256 + bj * 128 + wc * 32 + fq * 8; bb[bj][0] = *(const f32x4*)bp; bb[bj][1] = *(const f32x4*)(bp + 4); }
#pragma unroll
        for (int ai = 0; ai < 2; ++ai)
#pragma unroll
            for (int m = 0; m < 4; ++m) { int r = ai * 128 + wr * 64 + m * 16 + fr; r = r < u.nv ? r : u.nv - 1; gt[ai][m] = row_gate[u.row0 + r]; ds[ai][m] = row_dst[u.row0 + r]; }
#pragma unroll
        for (int ai = 0; ai < 2; ++ai)
#pragma unroll
            for (int m = 0; m < 4; ++m) {
                const int r = ai * 128 + wr * 64 + m * 16 + fr;
                if (r < u.nv) {
                    const float gate = gt[ai][m];
                    unsigned char* yp = (unsigned char*)y + (size_t)ds[ai][m] * D;
#pragma unroll
                    for (int bj = 0; bj < 2; ++bj) {
                        const int c = u.pn * 256 + bj * 128 + wc * 32 + fq * 8;
                        const f32x4 v0 = (acc[ai][bj][m][0] + bb[bj][0]) * gate, v1 = (acc[ai][bj][m][1] + bb[bj][1]) * gate;
                        u32x2 w; w.x = pack_fp8x4(v0[0], v0[1], v0[2], v0[3]); w.y = pack_fp8x4(v1[0], v1[1], v1[2], v1[3]);
                        *(u32x2*)(yp + c) = w;
                    }
                }
            }
        return false;
    }
};
__device__ __forceinline__ void phase_moe_down8(const Params& p, char* lds, int vb, int nvb) {
    MoeOrder S; S.unit_tab = p.unit_down; S.tile_row0 = p.tile_row0; S.tile_nrows = p.tile_nrows; S.A = (const char*)p.act; S.B = (const char*)p.wb_down;
    S.nunits = __builtin_amdgcn_readfirstlane(p.ntiles[0]) * 8; S.rows_per_e = D; S.gather = 0; S.G = nvb; S.c = vb;
    EpiDown E; E.b_down = p.b_down; E.row_gate = p.row_gate; E.row_dst = p.row_dst; E.y = p.y;
    g8::gemm_phase8<false, true>(lds, DFF, nullptr, S, E);
}

__device__ __forceinline__ void phase_attn_naive(const Params& p, char* lds, int vb, int nvb) {
    float* cs = (float*)lds;
    float* wtot = cs + 2048;
    float* qs = wtot + 64;
    const int tid = tid_opaque(), wid = tid >> 6, lane = tid & 63;
    for (int u = vb; u < 512; u += nvb) {
        const int qb = 15 - (u >> 5), bh = u & 31, b = bh >> 3, hh = bh & 7;
        const int nkeys = (qb + 1) * 128;
        __syncthreads();
        {
            float v[4];
#pragma unroll
            for (int j = 0; j < 4; ++j) { const int s = tid * 4 + j; v[j] = s < nkeys ? p.ls[((size_t)b * S + s) * 8 + hh] : 0.f; }
            v[1] += v[0]; v[2] += v[1]; v[3] += v[2];
            float incl = v[3];
#pragma unroll
            for (int o = 1; o < 64; o <<= 1) { const float t = __shfl_up(incl, o); if (lane >= o) incl += t; }
            if (lane == 63) wtot[wid] = incl;
            __syncthreads();
            float base = incl - v[3];
            for (int w = 0; w < wid; ++w) base += wtot[w];
#pragma unroll
            for (int j = 0; j < 4; ++j) cs[tid * 4 + j] = base + v[j];
            __syncthreads();
        }
        float* myq = qs + wid * 128;
        for (int rr = 0; rr < 16; ++rr) {
            const int t = qb * 128 + wid * 16 + rr;
            const size_t qoff = ((size_t)b * S + t) * AW + hh * 128;
            { const unsigned qq = *(const unsigned*)(p.q + qoff + lane * 2); myq[lane * 2] = bf_lo(qq) * 0.08838834764831845f; myq[lane * 2 + 1] = bf_hi(qq) * 0.08838834764831845f; }
            __builtin_amdgcn_wave_barrier();
            const float ct = cs[t];
            float mrun = -INFINITY, lrun = 0.f, o0 = 0.f, o1 = 0.f;
            for (int s0 = 0; s0 <= t; s0 += 64) {
                const int s = s0 + lane; const bool valid = s <= t; const int sl = valid ? s : t;
                const bf16_t* kp = p.k + ((size_t)b * S + sl) * AW + hh * 128;
                float acc = 0.f;
#pragma unroll
                for (int c = 0; c < 16; ++c) {
                    const u32x4 kk = *(const u32x4*)(kp + c * 8);
                    const f32x4 qa = *(const f32x4*)(myq + c * 8), qb4 = *(const f32x4*)(myq + c * 8 + 4);
                    acc += bf_lo(kk.x) * qa[0] + bf_hi(kk.x) * qa[1] + bf_lo(kk.y) * qa[2] + bf_hi(kk.y) * qa[3]
                         + bf_lo(kk.z) * qb4[0] + bf_hi(kk.z) * qb4[1] + bf_lo(kk.w) * qb4[2] + bf_hi(kk.w) * qb4[3];
                }
                const float sc = valid ? acc + (ct - cs[sl]) : -INFINITY;
                const float mnew = fmaxf(mrun, wave_max(sc));
                const float alpha = __expf(mrun - mnew);
                const float pj = valid ? __expf(sc - mnew) : 0.f;
                lrun = lrun * alpha + wave_sum(pj);
                o0 *= alpha; o1 *= alpha;
                const int nj = min(64, t - s0 + 1);
                const bf16_t* vp = p.v + ((size_t)b * S + s0) * AW + hh * 128 + lane * 2;
                for (int j = 0; j < nj; ++j) {
                    const float pjj = __shfl(pj, j);
                    const unsigned vv = *(const unsigned*)(vp + (size_t)j * AW);
                    o0 += pjj * bf_lo(vv); o1 += pjj * bf_hi(vv);
                }
                mrun = mnew;
            }
            const float inv = 1.0f / lrun;
            *(unsigned*)(p.attn + qoff + lane * 2) = cvt_pk_bf16(o0 * inv, o1 * inv);
            __builtin_amdgcn_wave_barrier();
        }
    }
    __syncthreads();
}

template <int KS> __device__ __forceinline__ int lds_byte_t(int r, int c) { const int st = (r >> 4) * KS + (c >> 5), ob = (r & 15) * 64 + (c & 31) * 2; return st * 1024 + (ob ^ (((ob >> 9) & 1) << 5)); }

__device__ __forceinline__ void attn_block(const Params& p, char* stg, const float* cs, int b, int hh, int qb) {
    const int tid = tid_opaque(), wid = tid >> 6, lane = tid & 63, fr = lane & 15, fq = lane >> 4, w = wid & 3, kh = wid >> 2;
    const int q0 = qb * 128;
    const float sc2 = 0.08838834764831845f * 1.4426950408889634f;
    const size_t tokb = (size_t)b * S;
    bf16x8 Qf[2][4];
#pragma unroll
    for (int qg = 0; qg < 2; ++qg)
#pragma unroll
        for (int ks = 0; ks < 4; ++ks) Qf[qg][ks] = *(const bf16x8*)(p.q + (tokb + q0 + 32 * w + 16 * qg + fr) * AW + hh * 128 + ks * 32 + fq * 8);
    f32x4 O[2][8];
#pragma unroll
    for (int qg = 0; qg < 2; ++qg)
#pragma unroll
        for (int dt = 0; dt < 8; ++dt) O[qg][dt] = (f32x4){0.f, 0.f, 0.f, 0.f};
    float mrun[2] = {-1e30f, -1e30f}, lrun[2] = {0.f, 0.f};
    const int kR = (wid >> 2) * 16 + (lane >> 2), kC = (wid & 3) * 32 + (((lane & 3) ^ ((lane >> 5) << 1)) << 3);
    const bf16_t* kg = p.k + (tokb + kR) * AW + hh * 128 + kC;
    const int widu = __builtin_amdgcn_readfirstlane(wid);
    const int vrow = 4 * widu + (lane >> 4), vch = (lane & 15) ^ (((lane >> 4) << 2) | (widu & 3));
    const bf16_t* vgv = p.v + (tokb + vrow) * AW + hh * 128 + vch * 8;
#define AT_ISSUE_K(j, kb) do { _Pragma("unroll") for (int i = 0; i < 4; ++i) \
            __builtin_amdgcn_global_load_lds((const unsigned*)(kg + (size_t)((j) * 128 + 32 * i) * AW), (LAS unsigned*)(stg + (kb) * 65536 + (i * 512 + widu * 64) * 16), 16, 0, 0); } while (0)
#define AT_ISSUE_V(j, vb) do { _Pragma("unroll") for (int i = 0; i < 4; ++i) \
            __builtin_amdgcn_global_load_lds((const unsigned*)(vgv + (size_t)((j) * 128 + 32 * i) * AW), (LAS unsigned*)(stg + (vb) * 65536 + 32768 + (i * 8 + widu) * 1024), 16, 0, 0); } while (0)
    AT_ISSUE_K(0, 0); AT_ISSUE_V(0, 0); if (qb >= 1) AT_ISSUE_K(1, 1);
    asm volatile("s_waitcnt vmcnt(0)" ::: "memory");
    unsigned vtb[2];
#pragma unroll
    for (int h = 0; h < 2; ++h) {
        const int q_ = fr >> 2, p_ = fr & 3, t_ = fq, r_ = (wid >> 2) * 64 + h * 16 + fq * 4 + q_;
        vtb[h] = (unsigned)(size_t)(LAS char*)(stg + 32768) + (unsigned)(256 * r_ + 16 * ((p_ >> 1) ^ (t_ & 1)) + 8 * (p_ & 1) + 32 * (2 * q_ + (t_ >> 1)));
    }
#pragma unroll
    for (int qg = 0; qg < 2; ++qg)
#pragma unroll
        for (int ks = 0; ks < 4; ++ks) asm volatile("" :: "v"(Qf[qg][ks]));
    __syncthreads();
#define AT_QK(S_, kb) do { const char* sk_ = stg + (kb) * 65536; \
        _Pragma("unroll") for (int kt = 0; kt < 4; ++kt) { S_[kt][0] = (f32x4){0.f, 0.f, 0.f, 0.f}; S_[kt][1] = (f32x4){0.f, 0.f, 0.f, 0.f}; } \
        _Pragma("unroll") for (int ks = 0; ks < 4; ++ks) _Pragma("unroll") for (int kt = 0; kt < 4; ++kt) { \
            const bf16x8 Kf = *(const bf16x8*)(sk_ + lds_byte_t<4>(kh * 64 + kt * 16 + fr, ks * 32 + fq * 8)); \
            S_[kt][0] = __builtin_amdgcn_mfma_f32_16x16x32_bf16(Kf, Qf[0][ks], S_[kt][0], 0, 0, 0); \
            S_[kt][1] = __builtin_amdgcn_mfma_f32_16x16x32_bf16(Kf, Qf[1][ks], S_[kt][1], 0, 0, 0); } } while (0)
    f32x4 Sn[4][2];
#pragma unroll
    for (int kt = 0; kt < 4; ++kt) { Sn[kt][0] = (f32x4){0.f, 0.f, 0.f, 0.f}; Sn[kt][1] = (f32x4){0.f, 0.f, 0.f, 0.f}; }
    if (!(qb == 0 && (kh * 64 > 32 * w + 31))) AT_QK(Sn, 0);
    __syncthreads();
    auto body = [&](const int j, auto mainc) __attribute__((always_inline)) {
        constexpr bool MAIN = decltype(mainc)::value;
        const int cur = j & 1;
        if (MAIN || j + 2 <= qb) AT_ISSUE_K(j + 2, cur);
        if (MAIN || j < qb) AT_ISSUE_V(j + 1, cur ^ 1);
        const bool diag = !MAIN && (j == qb);
        const bool skip = diag && (kh * 64 > 32 * w + 31);
        f32x4 Sx[4][2];
#pragma unroll
        for (int kt = 0; kt < 4; ++kt) { Sx[kt][0] = Sn[kt][0]; Sx[kt][1] = Sn[kt][1]; }
        if (MAIN) {
#pragma unroll
            for (int kt = 0; kt < 4; ++kt) { Sn[kt][0] = (f32x4){0.f, 0.f, 0.f, 0.f}; Sn[kt][1] = (f32x4){0.f, 0.f, 0.f, 0.f}; }
        } else if (j < qb && !((j + 1 == qb) && (kh * 64 > 32 * w + 31))) AT_QK(Sn, cur ^ 1);
        if (MAIN || !skip) {
            const int keyb = j * 128 + kh * 64 + 4 * fq;
            const bool mask = diag && (kh * 64 + 63 > 32 * w);
#pragma unroll
            for (int kt = 0; kt < 4; ++kt) {
                const f32x4 cb = *(const f32x4*)(cs + keyb + kt * 16);
#pragma unroll
                for (int qg = 0; qg < 2; ++qg) {
                    const int qi = q0 + 32 * w + 16 * qg + fr;
#pragma unroll
                    for (int r = 0; r < 4; ++r) {
                        float v = Sx[kt][qg][r] * sc2 - cb[r];
                        if (mask && (keyb + kt * 16 + r > qi)) v = -INFINITY;
                        Sx[kt][qg][r] = v;
                    }
                }
            }
#pragma unroll
            for (int qg = 0; qg < 2; ++qg) {
                float mx = -INFINITY;
#pragma unroll
                for (int kt = 0; kt < 4; ++kt) mx = fmaxf(mx, fmaxf(fmaxf(Sx[kt][qg][0], Sx[kt][qg][1]), fmaxf(Sx[kt][qg][2], Sx[kt][qg][3])));
                mx = fmaxf(mx, __shfl_xor(mx, 16)); mx = fmaxf(mx, __shfl_xor(mx, 32));
                const float mnew = fmaxf(mrun[qg], mx);
                const float alpha = __builtin_amdgcn_exp2f(mrun[qg] - mnew);
                mrun[qg] = mnew;
                float ls = 0.f;
                if (MAIN) {
                    const char* sk_ = stg + (cur ^ 1) * 65536;
#pragma unroll
                    for (int kk = 0; kk < 2; ++kk) {
                        const int ks = 2 * qg + kk;
                        bf16x8 Kf[4];
#pragma unroll
                        for (int k4 = 0; k4 < 4; ++k4) Kf[k4] = *(const bf16x8*)(sk_ + lds_byte_t<4>(kh * 64 + k4 * 16 + fr, ks * 32 + fq * 8));
#pragma unroll
                        for (int k4 = 0; k4 < 4; ++k4)
#pragma unroll
                            for (int q2 = 0; q2 < 2; ++q2) {
                                const int e = kk * 8 + k4 * 2 + q2, kt = e >> 2, r = e & 3;
                                Sn[k4][q2] = __builtin_amdgcn_mfma_f32_16x16x32_bf16(Kf[k4], Qf[q2][ks], Sn[k4][q2], 0, 0, 0);
                                const float pv = __builtin_amdgcn_exp2f(Sx[kt][qg][r] - mnew); ls += pv; Sx[kt][qg][r] = pv;
                                __builtin_amdgcn_sched_barrier(0);
                            }
                    }
                } else {
#pragma unroll
                for (int kt = 0; kt < 4; ++kt)
#pragma unroll
                    for (int r = 0; r < 4; ++r) { const float pv = __builtin_amdgcn_exp2f(Sx[kt][qg][r] - mnew); ls += pv; Sx[kt][qg][r] = pv; }
                }
                lrun[qg] = lrun[qg] * alpha + ls;
#pragma unroll
                for (int dt = 0; dt < 8; ++dt) O[qg][dt] *= alpha;
            }
#pragma unroll
            for (int ks2 = 0; ks2 < 2; ++ks2) {
                bf16x8 Pf[2];
#pragma unroll
                for (int qg = 0; qg < 2; ++qg) {
                    u32x4 pw; pw.x = cvt_pk_bf16_mfma(Sx[2 * ks2][qg][0], Sx[2 * ks2][qg][1]); pw.y = cvt_pk_bf16_mfma(Sx[2 * ks2][qg][2], Sx[2 * ks2][qg][3]);
                    pw.z = cvt_pk_bf16_mfma(Sx[2 * ks2 + 1][qg][0], Sx[2 * ks2 + 1][qg][1]); pw.w = cvt_pk_bf16_mfma(Sx[2 * ks2 + 1][qg][2], Sx[2 * ks2 + 1][qg][3]);
                    Pf[qg] = __builtin_bit_cast(bf16x8, pw);
                }
                unsigned vb0 = vtb[0] + (unsigned)(cur * 65536), vb1 = vtb[1] + (unsigned)(cur * 65536); asm volatile("" : "+v"(vb0), "+v"(vb1));
#pragma unroll
                for (int dh = 0; dh < 2; ++dh) {
                    u32x2 vlo[4], vhi[4];
#pragma unroll
                    for (int d4 = 0; d4 < 4; ++d4) {
                        const int dt = dh * 4 + d4;
                        const unsigned a0 = vb0 ^ (unsigned)(dt << 5), a1 = vb1 ^ (unsigned)(dt << 5);
                        if (ks2 == 0) { asm volatile("ds_read_b64_tr_b16 %0, %1" : "=v"(vlo[d4]) : "v"(a0) : "memory"); asm volatile("ds_read_b64_tr_b16 %0, %1" : "=v"(vhi[d4]) : "v"(a1) : "memory"); }
                        else { asm volatile("ds_read_b64_tr_b16 %0, %1 offset:8192" : "=v"(vlo[d4]) : "v"(a0) : "memory"); asm volatile("ds_read_b64_tr_b16 %0, %1 offset:8192" : "=v"(vhi[d4]) : "v"(a1) : "memory"); }
                    }
                    asm volatile("s_waitcnt lgkmcnt(0)" : "+v"(vlo[0]), "+v"(vlo[1]), "+v"(vlo[2]), "+v"(vlo[3]), "+v"(vhi[0]), "+v"(vhi[1]), "+v"(vhi[2]), "+v"(vhi[3]) :: "memory");
#pragma unroll
                    for (int d4 = 0; d4 < 4; ++d4) {
                        const int dt = dh * 4 + d4;
                        u32x4 vv; vv.x = vlo[d4].x; vv.y = vlo[d4].y; vv.z = vhi[d4].x; vv.w = vhi[d4].y;
                        const bf16x8 Vf = __builtin_bit_cast(bf16x8, vv);
                        O[0][dt] = __builtin_amdgcn_mfma_f32_16x16x32_bf16(Vf, Pf[0], O[0][dt], 0, 0, 0);
                        O[1][dt] = __builtin_amdgcn_mfma_f32_16x16x32_bf16(Vf, Pf[1], O[1][dt], 0, 0, 0);
                    }
                }
            }
        }
        asm volatile("s_waitcnt vmcnt(0)" ::: "memory");
        __syncthreads();
    };
    { int j = 0; for (; j + 2 <= qb; ++j) body(j, std::true_type{}); for (; j <= qb; ++j) body(j, std::false_type{}); }
#undef AT_ISSUE_K
#undef AT_ISSUE_V
#undef AT_QK
#pragma unroll
    for (int qg = 0; qg < 2; ++qg) { lrun[qg] += __shfl_xor(lrun[qg], 16); lrun[qg] += __shfl_xor(lrun[qg], 32); }
    f32x4* ob = (f32x4*)(stg + w * 16384);
    float* mlb = (float*)(stg + 65536 + w * 1024);
    if (kh == 1) {
#pragma unroll
        for (int qg = 0; qg < 2; ++qg) {
            mlb[(qg * 2 + 0) * 64 + lane] = mrun[qg]; mlb[(qg * 2 + 1) * 64 + lane] = lrun[qg];
#pragma unroll
            for (int dt = 0; dt < 8; ++dt) ob[(qg * 8 + dt) * 64 + lane] = O[qg][dt];
        }
    }
    __syncthreads();
    if (kh == 0) {
#pragma unroll
        for (int qg = 0; qg < 2; ++qg) {
            const float m2 = mlb[(qg * 2 + 0) * 64 + lane], l2 = mlb[(qg * 2 + 1) * 64 + lane];
            const float mt = fmaxf(mrun[qg], m2);
            const float e1 = __builtin_amdgcn_exp2f(mrun[qg] - mt), e2 = __builtin_amdgcn_exp2f(m2 - mt);
            const float inv = 1.0f / (lrun[qg] * e1 + l2 * e2);
            const float f1 = e1 * inv, f2 = e2 * inv;
            bf16_t* orow = p.attn + (tokb + q0 + 32 * w + 16 * qg + fr) * AW + hh * 128 + 4 * fq;
#pragma unroll
            for (int dt = 0; dt < 8; ++dt) {
                const f32x4 o2 = ob[(qg * 8 + dt) * 64 + lane];
                const f32x4 o = O[qg][dt] * f1 + o2 * f2;
                u32x2 ww; ww.x = cvt_pk_bf16(o[0], o[1]); ww.y = cvt_pk_bf16(o[2], o[3]);
                *(u32x2*)(orow + dt * 16) = ww;
            }
        }
    }
    __syncthreads();
}

__device__ __forceinline__ void phase_attn(const Params& p, char* lds, int vb, int nvb) {
    float* cs = (float*)lds;
    float* wtot = (float*)(lds + 8192);
    char* stg = lds + 8192 + 256;
    for (int u = vb; u < 256; u += nvb) {
        const int bh = u & 31, b = bh >> 3, hh = bh & 7, x = u >> 5;
        const int nkeys = (16 - x) * 128;
        {
            const int tid = tid_opaque(), wid = tid >> 6, lane = tid & 63;
            float v[4];
#pragma unroll
            for (int j = 0; j < 4; ++j) { const int s = tid * 4 + j; v[j] = s < nkeys ? p.ls[((size_t)b * S + s) * 8 + hh] : 0.f; }
            v[1] += v[0]; v[2] += v[1]; v[3] += v[2];
            float incl = v[3];
#pragma unroll
            for (int o = 1; o < 64; o <<= 1) { const float t = __shfl_up(incl, o); if (lane >= o) incl += t; }
            if (lane == 63) wtot[wid] = incl;
            __syncthreads();
            float base = incl - v[3];
            for (int ww = 0; ww < wid; ++ww) base += wtot[ww];
#pragma unroll
            for (int j = 0; j < 4; ++j) cs[tid * 4 + j] = (base + v[j]) * 1.4426950408889634f;
            __syncthreads();
        }
        attn_block(p, stg, cs, b, hh, 15 - x);
        attn_block(p, stg, cs, b, hh, x);
    }
}

__device__ __forceinline__ void phase_gmlp_naive(const Params& p, char* lds, int vb, int nvb) {
    float* vn = (float*)lds;
    float* st = vn + 128 * 128;
    const int tid = tid_opaque(), wid = tid >> 6, lane = tid & 63;
    for (int u = vb; u < 512; u += nvb) {
        const int g = u & 7, bc = u >> 3;
        const size_t tok0 = (size_t)bc * 128;
        __syncthreads();
        for (int rr = 0; rr < 16; ++rr) {
            const int s = wid * 16 + rr;
            const bf16_t* vp = p.zg + (tok0 + s) * 2048 + 1024 + lane * 16;
            const u32x4 a = *(const u32x4*)vp, b = *(const u32x4*)(vp + 8);
            float sum = 0.f, sq = 0.f;
            const unsigned ww[8] = {a.x, a.y, a.z, a.w, b.x, b.y, b.z, b.w};
#pragma unroll
            for (int j = 0; j < 8; ++j) { const float lo = bf_lo(ww[j]), hi = bf_hi(ww[j]); sum += lo + hi; sq += lo * lo + hi * hi; }
            sum = wave_sum(sum); sq = wave_sum(sq);
            const float mean = sum * (1.0f / 1024.f); const float var = fmaxf(sq * (1.0f / 1024.f) - mean * mean, 0.f);
            if (lane == 0) { st[s * 2] = mean; st[s * 2 + 1] = rsqrtf(var + 1e-5f); }
        }
        __syncthreads();
        for (int idx = tid; idx < 128 * 16; idx += NTHREADS) {
            const int s = idx >> 4, dc = idx & 15;
            const u32x4 a = *(const u32x4*)(p.zg + (tok0 + s) * 2048 + 1024 + g * 128 + dc * 8);
            const float mean = st[s * 2], rstd = st[s * 2 + 1];
            const unsigned ww[4] = {a.x, a.y, a.z, a.w};
#pragma unroll
            for (int j = 0; j < 4; ++j) {
                const int c = g * 128 + dc * 8 + j * 2;
                vn[s * 128 + dc * 8 + j * 2]     = (bf_lo(ww[j]) - mean) * rstd * p.g_v_ln[c]     + p.b_v_ln[c];
                vn[s * 128 + dc * 8 + j * 2 + 1] = (bf_hi(ww[j]) - mean) * rstd * p.g_v_ln[c + 1] + p.b_v_ln[c + 1];
            }
        }
        __syncthreads();
        for (int rr = 0; rr < 16; ++rr) {
            const int t = wid * 16 + rr;
            const float* wrow = p.w_spatial + ((size_t)g * 128 + t) * 128;
            float a0 = 0.f, a1 = 0.f;
            for (int s = 0; s <= t; ++s) { const float w = wrow[s]; a0 += w * vn[s * 128 + lane]; a1 += w * vn[s * 128 + lane + 64]; }
            const float bs = p.b_spatial[g * 128 + t];
            const bf16_t* up = p.zg + (tok0 + t) * 2048 + g * 128;
            const float u0 = __uint_as_float((unsigned)up[lane] << 16), u1 = __uint_as_float((unsigned)up[lane + 64] << 16);
            bf16_t* op = p.sg + (tok0 + t) * GW + g * 128;
            op[lane] = (bf16_t)(cvt_pk_bf16(u0 * (a0 + bs), 0.f) & 0xffffu);
            op[lane + 64] = (bf16_t)(cvt_pk_bf16(u1 * (a1 + bs), 0.f) & 0xffffu);
        }
    }
    __syncthreads();
}

__device__ __forceinline__ void phase_gmlp(const Params& p, char* lds, int vb, int nvb) {
    float* st = (float*)lds;
    char* wimg = lds + 1024;
    char* vimg = lds + 1024 + 32768;
    const int tid = tid_opaque(), wid = tid >> 6, lane = tid & 63, fr = lane & 15, fq = lane >> 4;
    for (int u = vb; u < 512; u += nvb) {
        const int g = u & 7, bc = u >> 3;
        const size_t tok0 = (size_t)bc * 128;
        __syncthreads();
        if (tid < 128) {
            const float* pp = p.lnpart + (tok0 + tid) * 32;
            float sum = 0.f, sq = 0.f;
#pragma unroll
            for (int k = 0; k < 8; ++k) { const f32x4 t4 = *(const f32x4*)(pp + k * 4); sum += t4[0] + t4[2]; sq += t4[1] + t4[3]; }
            const float mean = sum * (1.0f / 1024.f); const float var = fmaxf(sq * (1.0f / 1024.f) - mean * mean, 0.f);
            st[tid * 2] = mean; st[tid * 2 + 1] = rsqrtf(var + 1e-5f);
        }
#pragma unroll
        for (int i = 0; i < 4; ++i) {
            const int q = tid + 512 * i, t = q >> 4, sc = q & 15;
            const float* wp = p.w_spatial + ((size_t)g * 128 + t) * 128 + sc * 8;
            const f32x4 w0 = *(const f32x4*)wp, w1 = *(const f32x4*)(wp + 4);
            float wv[8] = {w0[0], w0[1], w0[2], w0[3], w1[0], w1[1], w1[2], w1[3]};
#pragma unroll
            for (int j = 0; j < 8; ++j) wv[j] = (sc * 8 + j <= t) ? wv[j] : 0.f;
            u32x4 pk; pk.x = cvt_pk_bf16(wv[0], wv[1]); pk.y = cvt_pk_bf16(wv[2], wv[3]); pk.z = cvt_pk_bf16(wv[4], wv[5]); pk.w = cvt_pk_bf16(wv[6], wv[7]);
            *(u32x4*)(wimg + lds_byte_t<4>(t, sc * 8)) = pk;
        }
        __syncthreads();
        {
            const int vq4 = tid >> 4, vd8 = tid & 15;
            float vals[4][8];
            const f32x4 lg0 = *(const f32x4*)(p.g_v_ln + g * 128 + vd8 * 8), lg1 = *(const f32x4*)(p.g_v_ln + g * 128 + vd8 * 8 + 4);
            const f32x4 lb0 = *(const f32x4*)(p.b_v_ln + g * 128 + vd8 * 8), lb1 = *(const f32x4*)(p.b_v_ln + g * 128 + vd8 * 8 + 4);
            const float lgv[8] = {lg0[0], lg0[1], lg0[2], lg0[3], lg1[0], lg1[1], lg1[2], lg1[3]}, lbv[8] = {lb0[0], lb0[1], lb0[2], lb0[3], lb1[0], lb1[1], lb1[2], lb1[3]};
#pragma unroll
            for (int r = 0; r < 4; ++r) {
                const int s = 4 * vq4 + r;
                const u32x4 a = *(const u32x4*)(p.zg + (tok0 + s) * 2048 + 1024 + g * 128 + vd8 * 8);
                const float mean = st[s * 2], rstd = st[s * 2 + 1];
                const unsigned ww[4] = {a.x, a.y, a.z, a.w};
#pragma unroll
                for (int j = 0; j < 4; ++j) {
                    vals[r][2 * j] = (bf_lo(ww[j]) - mean) * rstd * lgv[2 * j] + lbv[2 * j];
                    vals[r][2 * j + 1] = (bf_hi(ww[j]) - mean) * rstd * lgv[2 * j + 1] + lbv[2 * j + 1];
                }
            }
#pragma unroll
            for (int dd = 0; dd < 8; ++dd) {
                u32x2 w_; w_.x = cvt_pk_bf16(vals[0][dd], vals[1][dd]); w_.y = cvt_pk_bf16(vals[2][dd], vals[3][dd]);
                *(u32x2*)(vimg + lds_byte_t<4>(vd8 * 8 + dd, 4 * vq4)) = w_;
            }
        }
        __syncthreads();
        f32x4 acc[8];
#pragma unroll
        for (int tt = 0; tt < 8; ++tt) acc[tt] = (f32x4){0.f, 0.f, 0.f, 0.f};
#pragma unroll
        for (int ks = 0; ks < 4; ++ks) {
            const bf16x8 Af = *(const bf16x8*)(vimg + lds_byte_t<4>(wid * 16 + fr, ks * 32 + fq * 8));
#pragma unroll
            for (int tt = 0; tt < 8; ++tt) {
                if (2 * ks <= tt) {
                    const bf16x8 Bf = *(const bf16x8*)(wimg + lds_byte_t<4>(tt * 16 + fr, ks * 32 + fq * 8));
                    acc[tt] = __builtin_amdgcn_mfma_f32_16x16x32_bf16(Af, Bf, acc[tt], 0, 0, 0);
                }
            }
        }
        u32x2 uu[8]; float bsv[8];
#pragma unroll
        for (int tt = 0; tt < 8; ++tt) { const int t = tt * 16 + fr; bsv[tt] = p.b_spatial[g * 128 + t]; uu[tt] = *(const u32x2*)(p.zg + (tok0 + t) * 2048 + g * 128 + wid * 16 + fq * 4); }
#pragma unroll
        for (int tt = 0; tt < 8; ++tt) {
            const int t = tt * 16 + fr; const float bs = bsv[tt];
            u32x2 w_; w_.x = cvt_pk_bf16(bf_lo(uu[tt].x) * (acc[tt][0] + bs), bf_hi(uu[tt].x) * (acc[tt][1] + bs)); w_.y = cvt_pk_bf16(bf_lo(uu[tt].y) * (acc[tt][2] + bs), bf_hi(uu[tt].y) * (acc[tt][3] + bs));
            *(u32x2*)(p.sg + (tok0 + t) * GW + g * 128 + wid * 16 + fq * 4) = w_;
        }
    }
    __syncthreads();
}

__device__ __forceinline__ void phase_branch(const Params& p, char* lds, int vb, int nvb) {
    for (int u = vb; u < 32 * 8; u += nvb) {
        const int pm = u >> 3, pn = u & 7;
        gemm_tile<D, false, false>(lds, p.attn, AW, nullptr, pm * 256, 256, p.w_ba + pn * 256, AW,
            [&](const f32x4 (&acc)[8][4], int wr, int wc, int fr, int fq) {
#pragma unroll
                for (int m = 0; m < 8; ++m) {
                    const size_t row = (size_t)pm * 256 + wr * 128 + m * 16 + fr;
#pragma unroll
                    for (int n = 0; n < 4; ++n) {
                        const int c = pn * 256 + wc * 64 + n * 16 + fq * 4;
                        const u32x2 gg = *(const u32x2*)(p.gates + row * 4096 + c);
                        f32x4 v = acc[m][n];
                        v[0] *= bf_lo(gg.x); v[1] *= bf_hi(gg.x); v[2] *= bf_lo(gg.y); v[3] *= bf_hi(gg.y);
                        *(f32x4*)(p.x1 + row * D + c) = v;
                    }
                }
            });
        gemm_tile<D, false, false>(lds, p.sg, GW, nullptr, pm * 256, 256, p.w_bg + pn * 256, GW,
            [&](const f32x4 (&acc)[8][4], int wr, int wc, int fr, int fq) {
#pragma unroll
                for (int m = 0; m < 8; ++m) {
                    const size_t row = (size_t)pm * 256 + wr * 128 + m * 16 + fr;
#pragma unroll
                    for (int n = 0; n < 4; ++n) {
                        const int c = pn * 256 + wc * 64 + n * 16 + fq * 4;
                        const u32x2 gg = *(const u32x2*)(p.gates + row * 4096 + 2048 + c);
                        const f32x4 prev = *(const f32x4*)(p.x1 + row * D + c);
                        f32x4 v = acc[m][n];
                        v[0] = prev[0] + v[0] * bf_lo(gg.x); v[1] = prev[1] + v[1] * bf_hi(gg.x); v[2] = prev[2] + v[2] * bf_lo(gg.y); v[3] = prev[3] + v[3] * bf_hi(gg.y);
                        u32x2 w; w.x = cvt_pk_bf16(v[0], v[1]); w.y = cvt_pk_bf16(v[2], v[3]);
                        *(u32x2*)(p.merged + row * D + c) = w;
                    }
                }
            });
    }
}

__device__ __forceinline__ void phase_outproj(const Params& p, char* lds, int vb, int nvb) {
    for (int u = vb; u < 32 * 8; u += nvb) {
        const int pm = u >> 3, pn = u & 7;
        gemm_tile<D, false, false>(lds, p.merged, D, nullptr, pm * 256, 256, p.w_out + pn * 256, D,
            [&](const f32x4 (&acc)[8][4], int wr, int wc, int fr, int fq) {
#pragma unroll
                for (int m = 0; m < 8; ++m) {
                    const size_t row = (size_t)pm * 256 + wr * 128 + m * 16 + fr;
#pragma unroll
                    for (int n = 0; n < 4; ++n) {
                        const int c = pn * 256 + wc * 64 + n * 16 + fq * 4;
                        const f32x4 xr = *(const f32x4*)(p.x + row * D + c);
                        *(f32x4*)(p.x1 + row * D + c) = xr + acc[m][n];
                    }
                }
            });
    }
}

__device__ __forceinline__ void phase_router(const Params& p, char* lds, int vb, int nvb) {
    constexpr int RS = 4112;
    char* img_hi = lds;
    char* img_lo = lds + 16 * RS;
    float* part = (float*)lds;
    float* logit = (float*)(lds + 32 * RS);
    int* cnt = (int*)(lds + 32 * RS + 16 * 32 * 4);
    const int tid = tid_opaque(), wid = tid >> 6, lane = tid & 63, fr = lane & 15, fq = lane >> 4;
    bf16x8 bh0[8], bl0[8], bh1[8], bl1[8];
#pragma unroll
    for (int ks = 0; ks < 8; ++ks) {
        const int k0 = wid * 256 + ks * 32 + fq * 8;
        bh0[ks] = *(const bf16x8*)(p.wr_hi + (size_t)fr * D + k0); bl0[ks] = *(const bf16x8*)(p.wr_lo + (size_t)fr * D + k0);
        bh1[ks] = *(const bf16x8*)(p.wr_hi + (size_t)(16 + fr) * D + k0); bl1[ks] = *(const bf16x8*)(p.wr_lo + (size_t)(16 + fr) * D + k0);
    }
    for (int c = vb; c < NCHUNK; c += nvb) {
        for (int pass = 0; pass < 2; ++pass) {
            __syncthreads();
#pragma unroll
            for (int i2 = 0; i2 < 2; ++i2) {
                const int tl = 2 * wid + i2, tok = c * 32 + pass * 16 + tl;
                const bf16_t* xr = p.x1b + (size_t)tok * D;
                f32x4 xv[8]; float ss = 0.f;
#pragma unroll
                for (int i = 0; i < 8; ++i) { const u32x2 xb = *(const u32x2*)(xr + i * 256 + lane * 4); xv[i] = (f32x4){bf_lo(xb.x), bf_hi(xb.x), bf_lo(xb.y), bf_hi(xb.y)};
                    ss += xv[i][0] * xv[i][0] + xv[i][1] * xv[i][1] + xv[i][2] * xv[i][2] + xv[i][3] * xv[i][3]; }
                ss = wave_sum(ss);
                const float rstd = rsqrtf(ss * (1.0f / D) + 1e-5f);
#pragma unroll
                for (int i = 0; i < 8; ++i) {
                    const f32x4 g = *(const f32x4*)(p.g_ffn + i * 256 + lane * 4);
                    const f32x4 hv = xv[i] * rstd * g;
                    u32x2 hi; hi.x = cvt_pk_bf16(hv[0], hv[1]); hi.y = cvt_pk_bf16(hv[2], hv[3]);
                    *(unsigned*)((unsigned char*)p.h2 + (size_t)tok * D + i * 256 + lane * 4) = pack_fp8x4(hv[0], hv[1], hv[2], hv[3]);
                    u32x2 lo; lo.x = cvt_pk_bf16(hv[0] - bf_lo(hi.x), hv[1] - bf_hi(hi.x)); lo.y = cvt_pk_bf16(hv[2] - bf_lo(hi.y), hv[3] - bf_hi(hi.y));
                    *(u32x2*)(img_hi + tl * RS + (i * 256 + lane * 4) * 2) = hi;
                    *(u32x2*)(img_lo + tl * RS + (i * 256 + lane * 4) * 2) = lo;
                }
            }
            __syncthreads();
            f32x4 acc0 = {0.f, 0.f, 0.f, 0.f}, acc1 = {0.f, 0.f, 0.f, 0.f};
#pragma unroll
            for (int ks = 0; ks < 8; ++ks) {
                const int k0 = wid * 256 + ks * 32 + fq * 8;
                const bf16x8 ah = *(const bf16x8*)(img_hi + fr * RS + k0 * 2), al = *(const bf16x8*)(img_lo + fr * RS + k0 * 2);
                acc0 = __builtin_amdgcn_mfma_f32_16x16x32_bf16(al, bh0[ks], acc0, 0, 0, 0); acc0 = __builtin_amdgcn_mfma_f32_16x16x32_bf16(ah, bl0[ks], acc0, 0, 0, 0); acc0 = __builtin_amdgcn_mfma_f32_16x16x32_bf16(ah, bh0[ks], acc0, 0, 0, 0);
                acc1 = __builtin_amdgcn_mfma_f32_16x16x32_bf16(al, bh1[ks], acc1, 0, 0, 0); acc1 = __builtin_amdgcn_mfma_f32_16x16x32_bf16(ah, bl1[ks], acc1, 0, 0, 0); acc1 = __builtin_amdgcn_mfma_f32_16x16x32_bf16(ah, bh1[ks], acc1, 0, 0, 0);
            }
            __syncthreads();
#pragma unroll
            for (int r = 0; r < 4; ++r) { part[(wid * 16 + 4 * fq + r) * 32 + fr] = acc0[r]; part[(wid * 16 + 4 * fq + r) * 32 + 16 + fr] = acc1[r]; }
            if (pass == 0 && tid < 32) cnt[tid] = 0;
            __syncthreads();
            { const int tk2 = tid >> 5, e = tid & 31; float sacc = p.b_router[e];
#pragma unroll
              for (int ww = 0; ww < 8; ++ww) sacc += part[(ww * 16 + tk2) * 32 + e];
              logit[tk2 * 32 + e] = sacc; }
            __syncthreads();
            {
                const int tl = 2 * wid + (lane >> 5), e = lane & 31, tok = c * 32 + pass * 16 + tl;
                float val = logit[tl * 32 + e];
                float sv[4]; int si[4];
#pragma unroll
                for (int r = 0; r < 4; ++r) {
                    float mx = val;
#pragma unroll
                    for (int o = 16; o; o >>= 1) mx = fmaxf(mx, __shfl_xor(mx, o));
                    const unsigned long long bal = __ballot(val == mx);
                    const unsigned half = (unsigned)(lane >> 5 ? (bal >> 32) : (bal & 0xffffffffull));
                    const int idx = __ffs((int)half) - 1;
                    sv[r] = mx; si[r] = idx;
                    if (e == idx) val = -INFINITY;
                }
                const float e1 = __expf(sv[1] - sv[0]), e2 = __expf(sv[2] - sv[0]), e3 = __expf(sv[3] - sv[0]);
                const float inv = 1.0f / (1.0f + e1 + e2 + e3);
                if (e < 4) {
                    const int myi = e == 0 ? si[0] : e == 1 ? si[1] : e == 2 ? si[2] : si[3];
                    const float myg = (e == 0 ? 1.0f : e == 1 ? e1 : e == 2 ? e2 : e3) * inv;
                    p.top_idx[tok * 4 + e] = myi; p.top_gate[tok * 4 + e] = myg;
                    atomicAdd(&cnt[myi], 1);
                }
            }
        }
        __syncthreads();
        if (tid < 32) p.blk_cnt[c * 32 + tid] = cnt[tid];
    }
    __syncthreads();
}

__device__ __forceinline__ void phase_dispatch(const Params& p, char* lds, int vb, int nvb) {
    int* base = (int*)lds;
    int* tot = base + 32;
    int* start = tot + 32;
    int* tb = start + 32;
    int* red = tb + 64;
    int* idx = red + 16 * 32 * 2;
    const int tid = tid_opaque();
    for (int c = vb; c < NCHUNK; c += nvb) {
        __syncthreads();
        {
            const int e = tid & 31, part = tid >> 5;
            int total = 0, before = 0;
            int cv[16];
#pragma unroll
            for (int k = 0; k < 16; ++k) cv[k] = p.blk_cnt[(part * 16 + k) * 32 + e];
#pragma unroll
            for (int k = 0; k < 16; ++k) { total += cv[k]; before += (part * 16 + k < c) ? cv[k] : 0; }
            red[(part * 32 + e) * 2] = total; red[(part * 32 + e) * 2 + 1] = before;
        }
        int e0 = 0, e1 = 0; float tg0 = 0.f, tg1 = 0.f;
        if (tid < 64) { e0 = p.top_idx[c * 128 + tid]; e1 = p.top_idx[c * 128 + 64 + tid]; tg0 = p.top_gate[c * 128 + tid]; tg1 = p.top_gate[c * 128 + 64 + tid]; }
        __syncthreads();
        if (tid < 32) {
            int total = 0, before = 0;
#pragma unroll
            for (int k = 0; k < 16; ++k) { total += red[(k * 32 + tid) * 2]; before += red[(k * 32 + tid) * 2 + 1]; }
            int incl = total;
#pragma unroll
            for (int o = 1; o < 32; o <<= 1) { const int t = __shfl_up(incl, o); if (tid >= o) incl += t; }
            const int st = incl - total;
            base[tid] = st + before; tot[tid] = total; start[tid] = st;
        }
        __syncthreads();
        if (c == vb) {
            if (tid == 0) {
                int n = 0;
                for (int e = 0; e < NE; ++e) { tb[e] = n; n += (tot[e] + 255) >> 8; }
                tb[NE] = n; if (vb == 0) p.ntiles[0] = n;
            }
            __syncthreads();
            const int ntl = tb[NE];
            for (int w = vb * NTHREADS + tid; w < ntl * 16; w += (nvb < NCHUNK ? nvb : NCHUNK) * NTHREADS) { int e = 0; while (16 * tb[e + 1] <= w) ++e; const int Te = tb[e + 1] - tb[e], r = w - 16 * tb[e]; const int mt = r % Te, cntv = tot[e]; p.unit_up[2 * w] = (e << 24) | ((r / Te) << 16) | (tb[e] + mt); p.unit_up[2 * w + 1] = (start[e] + mt * 256) | (min(256, cntv - mt * 256) << 16); }
            for (int w = vb * NTHREADS + tid; w < ntl * 8; w += (nvb < NCHUNK ? nvb : NCHUNK) * NTHREADS) { int e = 0; while (8 * tb[e + 1] <= w) ++e; const int Te = tb[e + 1] - tb[e], r = w - 8 * tb[e]; const int mt = r % Te, cntv = tot[e]; p.unit_down[2 * w] = (e << 24) | ((r / Te) << 16) | (tb[e] + mt); p.unit_down[2 * w + 1] = (start[e] + mt * 256) | (min(256, cntv - mt * 256) << 16); }
        }
        if (tid < 64) {
            int r0 = 0, r1 = 0;
            const unsigned long long lt = (1ull << tid) - 1ull;
            for (int k = 0; k < NE; ++k) {
                const unsigned long long b0 = __ballot(e0 == k), b1 = __ballot(e1 == k);
                if (e0 == k) r0 = __popcll(b0 & lt);
                if (e1 == k) r1 = __popcll(b0) + __popcll(b1 & lt);
            }
            const int row0 = base[e0] + r0, a0 = c * 128 + tid, row1 = base[e1] + r1, a1 = a0 + 64;
            p.row_tok[row0] = a0 >> 2; p.row_dst[row0] = a0; p.row_gate[row0] = tg0;
            p.row_tok[row1] = a1 >> 2; p.row_dst[row1] = a1; p.row_gate[row1] = tg1;
        }
    }
    __syncthreads();
}

__device__ __forceinline__ void phase_moe_up(const Params& p, char* lds, int vb, int nvb) {
    const int nt = p.ntiles[0];
    for (int u = vb; u < nt * 16; u += nvb) {
        const int tile = u >> 4, pn = u & 15;
        const int e = p.tile_e[tile], row0 = p.tile_row0[tile], nv = p.tile_nrows[tile];
        gemm_tile<2 * DFF, true, true>(lds, p.h2, D, p.row_tok, row0, nv, p.w_up + (size_t)e * D * (2 * DFF) + pn * 256, D,
            [&](const f32x4 (&acc)[8][4], int wr, int wc, int fr, int fq) {
#pragma unroll
                for (int m = 0; m < 8; ++m) {
                    const int r = tile_row<true>(wr, m, fr);
                    if (r < nv) {
#pragma unroll
                        for (int n = 0; n < 4; ++n) {
                            const int c = pn * 256 + wc * 64 + n * 16 + fq * 4;
                            const f32x4 bb = *(const f32x4*)(p.b_up + (size_t)e * (2 * DFF) + c);
                            const f32x4 v = acc[m][n] + bb;
                            const float g0 = fminf(v[0], 7.f), l0 = fminf(fmaxf(v[1], -7.f), 7.f);
                            const float g1 = fminf(v[2], 7.f), l1 = fminf(fmaxf(v[3], -7.f), 7.f);
                            const float a0 = g0 * sigmoidf_(1.702f * g0) * (l0 + 1.0f), a1 = g1 * sigmoidf_(1.702f * g1) * (l1 + 1.0f);
                            *(unsigned*)(p.act + (size_t)(row0 + r) * DFF + (c >> 1)) = cvt_pk_bf16(a0, a1);
                        }
                    }
                }
            });
    }
}

__device__ __forceinline__ void phase_moe_down(const Params& p, char* lds, int vb, int nvb) {
    const int nt = p.ntiles[0];
    for (int u = vb; u < nt * 8; u += nvb) {
        const int tile = u >> 3, pn = u & 7;
        const int e = p.tile_e[tile], row0 = p.tile_row0[tile], nv = p.tile_nrows[tile];
        gemm_tile<D, false, true>(lds, p.act, DFF, nullptr, row0, nv, p.w_down + (size_t)e * DFF * D + pn * 256, DFF,
            [&](const f32x4 (&acc)[8][4], int wr, int wc, int fr, int fq) {
#pragma unroll
                for (int m = 0; m < 8; ++m) {
                    const int r = tile_row<true>(wr, m, fr);
                    if (r < nv) {
                        const float gate = p.row_gate[row0 + r];
                        const size_t dst = (size_t)p.row_dst[row0 + r] * D;
#pragma unroll
                        for (int n = 0; n < 4; ++n) {
                            const int c = pn * 256 + wc * 64 + n * 16 + fq * 4;
                            const f32x4 bb = *(const f32x4*)(p.b_down + (size_t)e * D + c);
                            const f32x4 v = (acc[m][n] + bb) * gate;
                            u32x2 w; w.x = cvt_pk_bf16(v[0], v[1]); w.y = cvt_pk_bf16(v[2], v[3]);
                            *(u32x2*)(p.y + dst + c) = w;
                        }
                    }
                }
            });
    }
}

__device__ __forceinline__ void phase_final(const Params& p, char* lds, int vb, int nvb) {
    const int tid = tid_opaque(), wid = tid >> 6, lane = tid & 63;
    for (int tok = vb * 8 + wid; tok < T; tok += nvb * 8) {
        f32x4 xv[8]; float ss = 0.f;
#pragma unroll
        for (int i = 0; i < 8; ++i) {
            const u32x2 xb = *(const u32x2*)(p.x1b + (size_t)tok * D + i * 256 + lane * 4);
            f32x4 v = {bf_lo(xb.x), bf_hi(xb.x), bf_lo(xb.y), bf_hi(xb.y)};
#pragma unroll
            for (int j = 0; j < 4; ++j) {
                const unsigned yy = *(const unsigned*)((const unsigned char*)p.y + ((size_t)tok * 4 + j) * D + i * 256 + lane * 4);
                const f32x2 lo = __builtin_amdgcn_cvt_pk_f32_fp8(yy, false), hi = __builtin_amdgcn_cvt_pk_f32_fp8(yy, true);
                v[0] += lo.x; v[1] += lo.y; v[2] += hi.x; v[3] += hi.y;
            }
            xv[i] = v; ss += v[0] * v[0] + v[1] * v[1] + v[2] * v[2] + v[3] * v[3];
        }
        ss = wave_sum(ss);
        const float rstd = rsqrtf(ss * (1.0f / D) + 1e-5f);
#pragma unroll
        for (int i = 0; i < 8; ++i) {
            const f32x4 g = *(const f32x4*)(p.g_final + i * 256 + lane * 4);
            *(f32x4*)(p.out + (size_t)tok * D + i * 256 + lane * 4) = xv[i] * rstd * g;
        }
    }
}

template <int MODE>
__global__ void __launch_bounds__(NTHREADS, 2) k_fwd(Params p_kernarg) {
    extern __shared__ __attribute__((aligned(1024))) char lds[];
    const Params& p = *(const Params*)__builtin_amdgcn_kernarg_segment_ptr();
    const int vb = blockIdx.x, nvb = gridDim.x;
    XcdBarrier bar;
    if (MODE < 0) {
        volatile LAS unsigned* st = (volatile LAS unsigned*)(lds + LDS_BYTES - 16);
        if (threadIdx.x == 0) { st[0] = 0u; st[1] = 0u; st[2] = 0u; st[3] = 0u; }
        __syncthreads();
        bar = xcd_barrier_post(p.bar, st);
    }
#ifndef PROBE_MASK
#define PROBE_MASK 0
#endif
#define PHASE(i, call) if (MODE < 0 || MODE == (i)) { call; } if (MODE < 0) xcd_barrier(bar); if (MODE < 0 && ((PROBE_MASK >> (i)) & 1)) { call; xcd_barrier(bar); }
    PHASE(0, (phase_prologue(p, lds, vb, nvb), phase_convert_dense(p, lds, vb, nvb)))
    PHASE(1, phase_inproj_conv(p, lds, vb, nvb))
    PHASE(2, (phase_attn(p, lds, vb, nvb), phase_gmlp(p, lds, vb, nvb)))
    PHASE(3, phase_branch8(p, lds, vb, nvb))
    PHASE(4, phase_outproj8(p, lds, vb, nvb))
    PHASE(5, phase_router(p, lds, vb, nvb))
    PHASE(6, phase_dispatch(p, lds, vb, nvb))
    PHASE(7, phase_moe_up8(p, lds, vb, nvb))
    PHASE(8, phase_moe_down8(p, lds, vb, nvb))
    if (MODE < 0 || MODE == 9) phase_final(p, lds, vb, nvb);
}

template <int MODE> static void launch_phase(const Params& p, int grid, hipStream_t stream) {
    static bool attr = false;
    if (!attr) { (void)hipFuncSetAttribute((const void*)k_fwd<MODE>, hipFuncAttributeMaxDynamicSharedMemorySize, LDS_BYTES); attr = true; }
    hipLaunchKernelGGL(k_fwd<MODE>, dim3(grid), dim3(NTHREADS), LDS_BYTES, stream, p);
}

extern "C" void kernel_launch(void* const* d_in, const int* in_sizes, int n_in, void* d_out, int out_size, void* d_ws, size_t ws_size, hipStream_t stream) {
    Params p; memset(&p, 0, sizeof(p));
    const float* const* in = (const float* const*)d_in;
    p.x = in[0]; p.g_mix = in[1]; p.w_in = in[2]; p.b_forget = in[3]; p.g_v_ln = in[4]; p.b_v_ln = in[5]; p.w_spatial = in[6]; p.b_spatial = in[7];
    p.w_ba = in[8]; p.w_bg = in[9]; p.w_out = in[10]; p.g_ffn = in[11]; p.w_router = in[12]; p.b_router = in[13];
    p.w_up = in[14]; p.b_up = in[15]; p.w_down = in[16]; p.b_down = in[17]; p.g_final = in[18];
    p.out = (float*)d_out;
    char* w = (char*)d_ws; size_t off = 0;
    auto take = [&](size_t bytes) { char* r = w + off; off += (bytes + 255) & ~(size_t)255; return r; };
    p.bar = (unsigned*)take((XCD_BAR_WORDS + 64) * 4);
    p.h = (bf16_t*)take((size_t)T * D * 2);
    p.q = (bf16_t*)take((size_t)T * AW * 2); p.k = (bf16_t*)take((size_t)T * AW * 2); p.v = (bf16_t*)take((size_t)T * AW * 2);
    p.zg = (bf16_t*)take((size_t)T * 2048 * 2); p.gates = (bf16_t*)take((size_t)T * 4096 * 2);
    p.attn = (bf16_t*)take((size_t)T * AW * 2); p.sg = (bf16_t*)take((size_t)T * GW * 2);
    p.merged = (bf16_t*)take((size_t)T * D * 2); p.h2 = (bf16_t*)take((size_t)T * D * 2);
    p.h8 = (unsigned char*)take((size_t)T * D); p.wb_in8 = (unsigned char*)take((size_t)9216 * D);
    p.wr_hi = (bf16_t*)take((size_t)NE * D * 2); p.wr_lo = (bf16_t*)take((size_t)NE * D * 2);
    p.act = (bf16_t*)take((size_t)T * 4 * DFF * 2); p.y = (bf16_t*)take((size_t)T * 4 * D * 2);
    p.wb_in = (bf16_t*)take((size_t)9216 * D * 2); p.wb_ba = (bf16_t*)take((size_t)D * AW * 2); p.wb_bg = (bf16_t*)take((size_t)D * GW * 2); p.wb_out = (bf16_t*)take((size_t)D * D * 2);
    p.wb_up = (bf16_t*)take((size_t)NE * 2 * DFF * D * 2); p.wb_down = (bf16_t*)take((size_t)NE * D * DFF * 2);
    p.ls = (float*)take((size_t)T * 8 * 4); p.lnpart = (float*)take((size_t)T * 16 * 2 * 4); p.x1 = (float*)take((size_t)T * D * 4); p.x1b = (bf16_t*)p.x1;
    p.top_gate = (float*)take((size_t)T * 4 * 4); p.row_gate = (float*)take((size_t)T * 4 * 4);
    p.top_idx = (int*)take((size_t)T * 4 * 4); p.blk_cnt = (int*)take((size_t)NCHUNK * 32 * 4);
    p.row_tok = (int*)take((size_t)T * 4 * 4); p.row_dst = (int*)take((size_t)T * 4 * 4);
    p.tile_e = (int*)take(MAXTILES * 4); p.tile_row0 = (int*)take(MAXTILES * 4); p.tile_nrows = (int*)take(MAXTILES * 4); p.ntiles = (int*)take(256); p.unit_up = (int*)take(MAXTILES * 16 * 8); p.unit_down = (int*)take(MAXTILES * 8 * 8);
#if MK_SINGLE
    static int grid = 0;
    if (!grid) {
        int dev = 0, cus = 0, per_cu = 0;
        (void)hipGetDevice(&dev);
        (void)hipDeviceGetAttribute(&cus, hipDeviceAttributeMultiprocessorCount, dev);
        (void)hipFuncSetAttribute((const void*)k_fwd<-1>, hipFuncAttributeMaxDynamicSharedMemorySize, LDS_BYTES);
        (void)hipOccupancyMaxActiveBlocksPerMultiprocessor(&per_cu, k_fwd<-1>, NTHREADS, LDS_BYTES);
        if (cus <= 0) cus = 256;
        grid = cus * (per_cu < 1 ? 1 : 1);
    }
    (void)hipMemsetAsync(p.bar, 0, (XCD_BAR_WORDS + 64) * 4, stream);
    launch_phase<-1>(p, grid, stream);
#else
    launch_phase<0>(p, 256, stream); launch_phase<1>(p, 256, stream); launch_phase<2>(p, 256, stream); launch_phase<3>(p, 256, stream);
    launch_phase<4>(p, 256, stream); launch_phase<5>(p, 256, stream); launch_phase<6>(p, 256, stream); launch_phase<7>(p, 256, stream);
    launch_phase<8>(p, 256, stream); launch_phase<9>(p, 256, stream);
#endif
}
```
